# Optimizing an MI355X kernel written in HIP

```python
import jax, jax.numpy as jnp
from jax import lax
import numpy as np

D_MODEL = 1024
BATCH = 2
SEQ = 16384
DEPTH = 2

CHUNK = 64
N_MIXERS = 4
HEAD_DIM = 64
D_MIX = D_MODEL
D_BRANCH = D_MIX // N_MIXERS
N_HEADS = D_BRANCH // HEAD_DIM
LOOKBACK_CHUNKS = 8
BAND = (LOOKBACK_CHUNKS + 1) * CHUNK
MAX_REL = 128
SG_CHUNK = 128
Q_BLOCK = 128
EPS = 1e-6
IN_SIZES = ([D_BRANCH] * 4
            + [D_BRANCH] * 3
            + [D_BRANCH] * 4
            + [N_HEADS]
            + [D_BRANCH] * 4)
N_IN = sum(IN_SIZES)

kernel_name = "hybrid_chunk_stream_heads"


def rms_norm(x, g):
    xf = x.astype(jnp.float32)
    y = xf * lax.rsqrt(jnp.mean(xf * xf, axis=-1, keepdims=True) + EPS)
    return (y * g.astype(jnp.float32)).astype(x.dtype)


def layer_norm(x, g):
    xf = x.astype(jnp.float32)
    mu = jnp.mean(xf, axis=-1, keepdims=True)
    xc = xf - mu
    y = xc * lax.rsqrt(jnp.mean(xc * xc, axis=-1, keepdims=True) + EPS)
    return (y * g.astype(jnp.float32)).astype(x.dtype)


def heads(t):
    b, s, _ = t.shape
    return t.reshape(b, s, N_HEADS, HEAD_DIM)


def chunk_band(t):
    b, s, h, dh = t.shape
    nc = s // CHUNK
    tp = jnp.pad(t, ((0, 0), (LOOKBACK_CHUNKS * CHUNK, 0), (0, 0), (0, 0)))
    tc = tp.reshape(b, nc + LOOKBACK_CHUNKS, CHUNK, h, dh)
    return jnp.concatenate([tc[:, m:m + nc] for m in range(LOOKBACK_CHUNKS + 1)], axis=2)


def chunk_relbias_attention(q, k, v, rel_bias):
    b, s, h, dh = q.shape
    nc = s // CHUNK
    qc = q.reshape(b, nc, CHUNK, h, dh)
    kb = chunk_band(k)
    vb = chunk_band(v)
    i = np.arange(CHUNK)[:, None]
    j = np.arange(BAND)[None, :]
    rel = np.clip(i - j + LOOKBACK_CHUNKS * CHUNK, -MAX_REL, MAX_REL) + MAX_REL
    bias = rel_bias[:, rel].astype(jnp.float32)
    key_chunk = jnp.arange(nc)[:, None] - LOOKBACK_CHUNKS + jnp.arange(BAND)[None, :] // CHUNK
    valid = key_chunk >= 0
    sc = jnp.einsum('bnihd,bnjhd->bnhij', qc, kb).astype(jnp.float32) * (dh ** -0.5)
    sc = sc + bias[None, None]
    sc = jnp.where(valid[None, :, None, None, :], sc, -jnp.inf)
    p = jax.nn.softmax(sc, axis=-1).astype(v.dtype)
    out = jnp.einsum('bnhij,bnjhd->bnihd', p, vb)
    return out.reshape(b, s, h * dh)


def spatial_gating(u, v, v_gain, w_s, b_s):
    b, s, _ = u.shape
    c = D_BRANCH // N_HEADS
    vn = layer_norm(v, v_gain).reshape(b, s // SG_CHUNK, SG_CHUNK, N_HEADS, c)
    w = w_s * jnp.tril(jnp.ones((SG_CHUNK, SG_CHUNK), w_s.dtype))[None]
    mixed = jnp.einsum('gts,bnsgc->bntgc', w, vn) + jnp.transpose(b_s)[None, None, :, :, None]
    return u * mixed.reshape(b, s, D_BRANCH)


def query_blocks(t):
    b, s = t.shape[:2]
    return jnp.moveaxis(t.reshape((b, s // Q_BLOCK, Q_BLOCK) + t.shape[2:]), 1, 0)


def forgetting_attention(q, k, v, f_logit):
    b, s, h, dh = q.shape
    nb = s // Q_BLOCK
    c = jnp.cumsum(jax.nn.log_sigmoid(f_logit.astype(jnp.float32)), axis=1)
    c_k = jnp.transpose(c, (0, 2, 1))[:, :, None, :]
    k_pos = jnp.arange(s)
    scale = dh ** -0.5

    def block(args):
        q_i, c_i, s0 = args
        sc = jnp.einsum('bqhd,bkhd->bhqk', q_i, k).astype(jnp.float32) * scale
        sc = sc + jnp.transpose(c_i, (0, 2, 1))[..., None] - c_k
        q_pos = s0 + jnp.arange(Q_BLOCK)
        mask = k_pos[None, :] <= q_pos[:, None]
        sc = jnp.where(mask, sc, -jnp.inf)
        p = jax.nn.softmax(sc, axis=-1).astype(v.dtype)
        return jnp.einsum('bhqk,bkhd->bqhd', p, v)

    out = lax.map(block, (query_blocks(q), query_blocks(c), jnp.arange(nb) * Q_BLOCK))
    return jnp.moveaxis(out, 0, 1).reshape(b, s, h * dh)


def stick_breaking_attention(q, k, v):
    b, s, h, dh = q.shape
    nb = s // Q_BLOCK
    k_pos = jnp.arange(s)
    scale = dh ** -0.5

    def block(args):
        q_i, s0 = args
        z = jnp.einsum('bqhd,bkhd->bhqk', q_i, k).astype(jnp.float32) * scale
        q_pos = s0 + jnp.arange(Q_BLOCK)
        mask = k_pos[None, :] < q_pos[:, None]
        log_1m = jnp.where(mask, jax.nn.log_sigmoid(-z), 0.0)
        between = lax.cumsum(log_1m, axis=3, reverse=True) - log_1m
        a = jnp.where(mask, jnp.exp(jax.nn.log_sigmoid(z) + between), 0.0)
        return jnp.einsum('bhqk,bkhd->bqhd', a.astype(v.dtype), v)

    out = lax.map(block, (query_blocks(q), jnp.arange(nb) * Q_BLOCK))
    return jnp.moveaxis(out, 0, 1).reshape(b, s, h * dh)


def hybrid_layer(x, norm_g, w_in, b_f, rel_bias, w_s, b_s, v_gain, branch_gain, w_out):
    h = rms_norm(x, norm_g)
    p = jnp.einsum('bsd,dn->bsn', h, w_in)
    (qa, ka, va, ga,
     ub, vbr, gb,
     qc, kc, vc, gc, fc,
     qd, kd, vd, gd) = jnp.split(p, [int(o) for o in np.cumsum(IN_SIZES)[:-1]], axis=-1)
    y_a = chunk_relbias_attention(heads(qa), heads(ka), heads(va), rel_bias)
    y_b = spatial_gating(ub, vbr, v_gain, w_s, b_s)
    y_c = forgetting_attention(heads(qc), heads(kc), heads(vc), fc + b_f)
    y_d = stick_breaking_attention(heads(qd), heads(kd), heads(vd))
    merged = jnp.concatenate([
        rms_norm(y_a, branch_gain[0]) * jax.nn.silu(ga),
        rms_norm(y_b, branch_gain[1]) * jax.nn.silu(gb),
        rms_norm(y_c, branch_gain[2]) * jax.nn.silu(gc),
        rms_norm(y_d, branch_gain[3]) * jax.nn.silu(gd),
    ], axis=-1)
    return x + jnp.einsum('bsm,md->bsd', merged, w_out)


def setup_inputs(seed: int = 0) -> dict:
    key = jax.random.key(seed)
    ks = jax.random.split(key, 12)
    f32 = jnp.float32
    x = jax.random.normal(ks[0], (BATCH, SEQ, D_MODEL), f32)
    norm_g = 1.0 + 0.02 * jax.random.normal(ks[1], (DEPTH, D_MODEL), f32)
    w_in = jax.random.normal(ks[2], (DEPTH, D_MODEL, N_IN), f32) * D_MODEL ** -0.5
    b_f = 4.0 + 0.5 * jax.random.normal(ks[3], (DEPTH, N_HEADS), f32)
    rel_bias = 0.5 * jax.random.normal(ks[4], (DEPTH, N_HEADS, 2 * MAX_REL + 1), f32)
    w_s = jax.random.normal(ks[5], (DEPTH, N_HEADS, SG_CHUNK, SG_CHUNK), f32) * SG_CHUNK ** -0.5
    b_s = 1.0 + 0.1 * jax.random.normal(ks[6], (DEPTH, N_HEADS, SG_CHUNK), f32)
    v_gain = 1.0 + 0.02 * jax.random.normal(ks[7], (DEPTH, D_BRANCH), f32)
    branch_gain = 1.0 + 0.02 * jax.random.normal(ks[8], (DEPTH, N_MIXERS, D_BRANCH), f32)
    w_out = jax.random.normal(ks[9], (DEPTH, D_MIX, D_MODEL), f32) * (0.5 * D_MIX ** -0.5)
    final_g = 1.0 + 0.02 * jax.random.normal(ks[10], (D_MODEL,), f32)
    return {"x": x, "norm_g": norm_g, "w_in": w_in, "b_f": b_f, "rel_bias": rel_bias,
            "w_s": w_s, "b_s": b_s, "v_gain": v_gain, "branch_gain": branch_gain,
            "w_out": w_out, "final_g": final_g}


def reference(x, norm_g, w_in, b_f, rel_bias, w_s, b_s, v_gain, branch_gain, w_out, final_g):
    for l in range(DEPTH):
        x = hybrid_layer(x, norm_g[l], w_in[l], b_f[l], rel_bias[l], w_s[l], b_s[l],
                         v_gain[l], branch_gain[l], w_out[l])
    return rms_norm(x, final_g)
```

```cpp
#include <hip/hip_runtime.h>
#include <hip/hip_cooperative_groups.h>
#include <cstdio>
namespace cg = cooperative_groups;

#ifndef COOP
#define COOP 0
#endif

#define DI __device__ __forceinline__
typedef unsigned short u16;
typedef __attribute__((ext_vector_type(8))) short bf16x8;
typedef __attribute__((ext_vector_type(16))) float f32x16;
typedef __attribute__((ext_vector_type(2))) __bf16 bf16v2;
#define MFMA(a, b, c) __builtin_amdgcn_mfma_f32_32x32x16_bf16((a), (b), (c), 0, 0, 0)

constexpr int SEQ = 16384, TT = 32768, DM = 1024, NIN = 3844, NW = 3840, PC = 2816;
constexpr float EPS = 1e-6f, LOG2E = 1.4426950408889634f;
constexpr float QSCALE = 0.125f * LOG2E;
constexpr int AQ = 0, AK = 256, AG = 512, BU = 768, BG = 1024, CQ = 1280, CK = 1536, CG = 1792, DQ = 2048, DK = 2304, DG = 2560;
constexpr int SMEM_BYTES = 73728;

struct Params {
  const float *x, *norm_g, *w_in, *b_f, *rel_bias, *w_s, *b_s, *v_gain, *branch_gain, *w_out, *final_g;
  float* out;
  u16 *WtIn, *WtOut, *Ws16, *H, *P, *Vt, *Z;
  float *lsf, *csum, *ssq;
  unsigned* ctr;
};

DI unsigned pk2(float a, float b) { bf16v2 v; v[0] = (__bf16)a; v[1] = (__bf16)b; return __builtin_bit_cast(unsigned, v); }
DI u16 f2bf(float a) { return __builtin_bit_cast(u16, (__bf16)a); }
DI float bf2f(u16 h) { return __uint_as_float(((unsigned)h) << 16); }
DI float bflo(unsigned u) { return __uint_as_float(u << 16); }
DI float bfhi(unsigned u) { return __uint_as_float(u & 0xffff0000u); }
DI float wave_sum(float v) { for (int o = 32; o > 0; o >>= 1) v += __shfl_xor(v, o); return v; }

__device__ void phase_pre(const Params& p, unsigned char* smem) {
  float (*tile)[65] = (float (*)[65])smem;
  const int tid = threadIdx.x, tx = tid & 63, ty = tid >> 6;
  const int nA = 2 * 60 * 16, nB = 2 * 16 * 16;
  for (int it = blockIdx.x; it < nA + nB; it += gridDim.x) {
    const float* src; u16* dst; int ld_src, n0, k0, srcoff;
    if (it < nA) {
      int l = it / 960, rem = it % 960, ntile = rem / 16, ktile = rem % 16;
      n0 = ntile * 64; k0 = ktile * 64;
      src = p.w_in + (size_t)l * 1024 * NIN; ld_src = NIN; dst = p.WtIn + (size_t)l * NW * 1024; srcoff = (n0 >= 2816) ? 4 : 0;
    } else {
      int j = it - nA; int l = j / 256, rem = j % 256, ntile = rem / 16, ktile = rem % 16;
      n0 = ntile * 64; k0 = ktile * 64;
      src = p.w_out + (size_t)l * 1024 * 1024; ld_src = 1024; dst = p.WtOut + (size_t)l * 1024 * 1024; srcoff = 0;
    }
    __syncthreads();
#pragma unroll 4
    for (int i = 0; i < 16; ++i) { int k = ty + 4 * i; tile[k][tx] = src[(size_t)(k0 + k) * ld_src + n0 + srcoff + tx]; }
    __syncthreads();
#pragma unroll 4
    for (int i = 0; i < 16; ++i) { int n = ty + 4 * i; dst[(size_t)(n0 + n) * 1024 + k0 + tx] = f2bf(tile[tx][n]); }
  }
  for (int idx = blockIdx.x * 256 + tid; idx < 2 * 4 * 128 * 128; idx += gridDim.x * 256) {
    int t = (idx >> 7) & 127, s = idx & 127;
    p.Ws16[idx] = (s <= t) ? f2bf(p.w_s[idx]) : (u16)0;
  }
  if (blockIdx.x == 0 && tid < 64) p.ctr[tid] = 0u;
}

__device__ void phase_norm(const Params& p, int l) {
  const float* src = (l == 0) ? p.x : p.out;
  const int lane = threadIdx.x & 63;
  const int gw = blockIdx.x * 4 + (threadIdx.x >> 6), nw = gridDim.x * 4;
  const float4* g4 = (const float4*)(p.norm_g + l * 1024);
  const float* wf = p.w_in + (size_t)l * 1024 * NIN + 2816;
  for (int row = gw; row < TT; row += nw) {
    const float4* xr = (const float4*)(src + (size_t)row * 1024);
    float4 v[4]; float ss = 0.f;
#pragma unroll
    for (int j = 0; j < 4; ++j) { v[j] = xr[lane + 64 * j]; ss += v[j].x * v[j].x + v[j].y * v[j].y + v[j].z * v[j].z + v[j].w * v[j].w; }
    ss = wave_sum(ss);
    const float rinv = rsqrtf(ss * (1.f / 1024.f) + EPS);
    float f0 = 0.f, f1 = 0.f, f2 = 0.f, f3 = 0.f;
#pragma unroll
    for (int j = 0; j < 4; ++j) {
      float4 g = g4[lane + 64 * j];
      float h0 = v[j].x * rinv * g.x, h1 = v[j].y * rinv * g.y, h2 = v[j].z * rinv * g.z, h3 = v[j].w * rinv * g.w;
      uint2 o; o.x = pk2(h0, h1); o.y = pk2(h2, h3);
      *(uint2*)(p.H + (size_t)row * 1024 + 4 * (lane + 64 * j)) = o;
      const int k = 4 * (lane + 64 * j);
      float4 w0 = *(const float4*)(wf + (size_t)(k + 0) * NIN), w1 = *(const float4*)(wf + (size_t)(k + 1) * NIN);
      float4 w2 = *(const float4*)(wf + (size_t)(k + 2) * NIN), w3 = *(const float4*)(wf + (size_t)(k + 3) * NIN);
      f0 += h0 * w0.x + h1 * w1.x + h2 * w2.x + h3 * w3.x;
      f1 += h0 * w0.y + h1 * w1.y + h2 * w2.y + h3 * w3.y;
      f2 += h0 * w0.z + h1 * w1.z + h2 * w2.z + h3 * w3.z;
      f3 += h0 * w0.w + h1 * w1.w + h2 * w2.w + h3 * w3.w;
    }
    f0 = wave_sum(f0); f1 = wave_sum(f1); f2 = wave_sum(f2); f3 = wave_sum(f3);
    if (lane == 0) {
      const float* bf = p.b_f + l * 4;
      float f[4] = {f0 + bf[0], f1 + bf[1], f2 + bf[2], f3 + bf[3]};
      float4 o;
      float* op = (float*)&o;
#pragma unroll
      for (int e = 0; e < 4; ++e) op[e] = (fminf(f[e], 0.f) - log1pf(expf(-fabsf(f[e])))) * LOG2E;
      *(float4*)(p.lsf + (size_t)row * 4) = o;
    }
  }
}

__device__ void scan_batch(const Params& p, int b, unsigned char* smem) {
  float4* tot = (float4*)smem;
  const int tid = threadIdx.x;
  const float4* in = (const float4*)p.lsf + (size_t)b * SEQ + tid * 64;
  float4 s = make_float4(0.f, 0.f, 0.f, 0.f);
  for (int i = 0; i < 64; ++i) { float4 v = in[i]; s.x += v.x; s.y += v.y; s.z += v.z; s.w += v.w; }
  __syncthreads();
  tot[tid] = s;
  __syncthreads();
  float4 pre = make_float4(0.f, 0.f, 0.f, 0.f);
  for (int i = 0; i < tid; ++i) { float4 v = tot[i]; pre.x += v.x; pre.y += v.y; pre.z += v.z; pre.w += v.w; }
  float4* outp = (float4*)p.csum + (size_t)b * SEQ + tid * 64;
  for (int i = 0; i < 64; ++i) { float4 v = in[i]; pre.x += v.x; pre.y += v.y; pre.z += v.z; pre.w += v.w; outp[i] = pre; }
  __syncthreads();
}

typedef u16 (*lds_tile_t)[72];
DI void g_load(const u16* A, size_t lda, int m0, int kt, int tid, uint4 (&r)[4]) {
  const int ch = tid & 7, row = tid >> 3;
#pragma unroll
  for (int j = 0; j < 4; ++j) r[j] = *(const uint4*)(A + (size_t)(m0 + row + 32 * j) * lda + kt * 64 + ch * 8);
}
DI void s_store(lds_tile_t S, int tid, const uint4 (&r)[4]) {
  const int ch = tid & 7, row = tid >> 3;
#pragma unroll
  for (int j = 0; j < 4; ++j) *(uint4*)&S[row + 32 * j][ch * 8] = r[j];
}
template <bool SWAP>
DI void gemm_ktile(lds_tile_t As, lds_tile_t Bs, f32x16 (&acc)[2][2], int wm, int wn, int r, int h) {
#pragma unroll
  for (int ks = 0; ks < 4; ++ks) {
    bf16x8 af[2], bfr[2];
#pragma unroll
    for (int mi = 0; mi < 2; ++mi) af[mi] = *(const bf16x8*)&As[wm * 64 + mi * 32 + r][ks * 16 + h * 8];
#pragma unroll
    for (int ni = 0; ni < 2; ++ni) bfr[ni] = *(const bf16x8*)&Bs[wn * 64 + ni * 32 + r][ks * 16 + h * 8];
#pragma unroll
    for (int mi = 0; mi < 2; ++mi)
#pragma unroll
      for (int ni = 0; ni < 2; ++ni)
        acc[mi][ni] = SWAP ? MFMA(bfr[ni], af[mi], acc[mi][ni]) : MFMA(af[mi], bfr[ni], acc[mi][ni]);
  }
}
DI int sec_pcol(int s) { int nv = (s > 2) + (s > 5) + (s > 9) + (s > 13); return (s - nv) * 256; }
DI int sec_branch(int s) { return (s < 4) ? 0 : (s < 7) ? 1 : (s < 11) ? 2 : 3; }

template <bool SWAP>
DI void gemm_mainloop16(const u16* A, const u16* B, int m0, int n0, unsigned char* smem, f32x16 (&acc)[2][2]) {
  lds_tile_t As0 = (lds_tile_t)smem, As1 = (lds_tile_t)(smem + 18432), Bs0 = (lds_tile_t)(smem + 36864), Bs1 = (lds_tile_t)(smem + 55296);
  const int tid = threadIdx.x, lane = tid & 63, w = tid >> 6, wm = w >> 1, wn = w & 1, r = lane & 31, h = lane >> 5;
  uint4 ra[4], rb[4];
  g_load(A, 1024, m0, 0, tid, ra); g_load(B, 1024, n0, 0, tid, rb);
  s_store(As0, tid, ra); s_store(Bs0, tid, rb);
  __syncthreads();
#pragma unroll 1
  for (int kt = 0; kt < 15; ++kt) {
    g_load(A, 1024, m0, kt + 1, tid, ra); g_load(B, 1024, n0, kt + 1, tid, rb);
    gemm_ktile<SWAP>((kt & 1) ? As1 : As0, (kt & 1) ? Bs1 : Bs0, acc, wm, wn, r, h);
    s_store((kt & 1) ? As0 : As1, tid, ra); s_store((kt & 1) ? Bs0 : Bs1, tid, rb);
    __syncthreads();
  }
  gemm_ktile<SWAP>(As1, Bs1, acc, wm, wn, r, h);
  __syncthreads();
}

__device__ void gemm_in_tile(const Params& p, int l, int mt, int nt, unsigned char* smem) {
  const int m0 = mt * 128, n0 = nt * 128, sec = nt >> 1, nloc0 = (nt & 1) * 128;
  const bool is_vt = (sec == 2 || sec == 5 || sec == 9 || sec == 13);
  const bool is_q = (sec == 0 || sec == 7 || sec == 11);
  const bool is_gate = (sec == 3 || sec == 6 || sec == 10 || sec == 14);
  const int br = sec_branch(sec);
  const int tid = threadIdx.x, lane = tid & 63, w = tid >> 6, wm = w >> 1, wn = w & 1, r = lane & 31, h = lane >> 5;
  const u16* A = p.H;
  const u16* B = p.WtIn + (size_t)l * NW * 1024;
  f32x16 acc[2][2];
#pragma unroll
  for (int mi = 0; mi < 2; ++mi)
#pragma unroll
    for (int ni = 0; ni < 2; ++ni)
#pragma unroll
      for (int i = 0; i < 16; ++i) acc[mi][ni][i] = 0.f;
  if (is_vt) {
    gemm_mainloop16<false>(A, B, m0, n0, smem, acc);
#pragma unroll
    for (int mi = 0; mi < 2; ++mi)
#pragma unroll
      for (int ni = 0; ni < 2; ++ni) {
        const int c = nloc0 + wn * 64 + ni * 32 + r;
#pragma unroll
        for (int gi = 0; gi < 4; ++gi) {
          const int t0 = m0 + wm * 64 + mi * 32 + 8 * gi + 4 * h;
          const int b = t0 >> 14, s = t0 & (SEQ - 1);
          uint2 o; o.x = pk2(acc[mi][ni][4 * gi], acc[mi][ni][4 * gi + 1]); o.y = pk2(acc[mi][ni][4 * gi + 2], acc[mi][ni][4 * gi + 3]);
          *(uint2*)(p.Vt + ((size_t)(br * 2 + b) * 256 + c) * SEQ + s) = o;
        }
      }
  } else {
    gemm_mainloop16<true>(A, B, m0, n0, smem, acc);
    const int pcol = sec_pcol(sec);
    const float* gain = p.branch_gain + (size_t)(l * 4 + br) * 256;
#pragma unroll
    for (int mi = 0; mi < 2; ++mi)
#pragma unroll
      for (int ni = 0; ni < 2; ++ni) {
        const int t = m0 + wm * 64 + mi * 32 + r;
#pragma unroll
        for (int gi = 0; gi < 4; ++gi) {
          const int nl = nloc0 + wn * 64 + ni * 32 + 8 * gi + 4 * h;
          float v[4];
#pragma unroll
          for (int e = 0; e < 4; ++e) v[e] = acc[mi][ni][4 * gi + e];
          if (is_q) {
#pragma unroll
            for (int e = 0; e < 4; ++e) v[e] *= QSCALE;
          } else if (is_gate) {
            float4 gg = *(const float4*)(gain + nl);
            const float* gp = (const float*)&gg;
#pragma unroll
            for (int e = 0; e < 4; ++e) v[e] = gp[e] * v[e] / (1.f + __expf(-v[e]));
          }
          uint2 o; o.x = pk2(v[0], v[1]); o.y = pk2(v[2], v[3]);
          *(uint2*)(p.P + (size_t)t * PC + pcol + nl) = o;
        }
      }
  }
}

__device__ void phase_gemm_in(const Params& p, int l, unsigned char* smem) {
  for (int b = blockIdx.x; b < 2; b += gridDim.x) scan_batch(p, b, smem);
  const int ntiles = 256 * 30;
  for (int it = blockIdx.x; it < ntiles; it += gridDim.x) {
    const int mt = it / 30, nt = it % 30;
    gemm_in_tile(p, l, mt, nt, smem);
  }
}

__device__ void gemm_out_tile(const Params& p, int l, int mt, int nt, unsigned char* smem) {
  lds_tile_t As0 = (lds_tile_t)smem, As1 = (lds_tile_t)(smem + 18432), Bs0 = (lds_tile_t)(smem + 36864), Bs1 = (lds_tile_t)(smem + 55296);
  const int m0 = mt * 128, n0 = nt * 128;
  const int tid = threadIdx.x, lane = tid & 63, w = tid >> 6, wm = w >> 1, wn = w & 1, r = lane & 31, h = lane >> 5;
  const u16* A = p.Z;
  const u16* B = p.WtOut + (size_t)l * 1024 * 1024;
  const float* resid = (l == 0) ? p.x : p.out;
  float fold[2][4];
#pragma unroll
  for (int mi = 0; mi < 2; ++mi) {
    const int t = m0 + wm * 64 + mi * 32 + r;
    float rv[4];
#pragma unroll
    for (int br = 0; br < 4; ++br) {
      float4 s = *(const float4*)(p.ssq + (size_t)t * 16 + br * 4);
      rv[br] = rsqrtf((s.x + s.y + s.z + s.w) * (1.f / 256.f) + EPS);
    }
    fold[mi][0] = rv[0] / rv[1]; fold[mi][1] = rv[1] / rv[2]; fold[mi][2] = rv[2] / rv[3]; fold[mi][3] = rv[3];
  }
  f32x16 acc[2][2];
#pragma unroll
  for (int mi = 0; mi < 2; ++mi)
#pragma unroll
    for (int ni = 0; ni < 2; ++ni)
#pragma unroll
      for (int i = 0; i < 16; ++i) acc[mi][ni][i] = 0.f;
  uint4 ra[4], rb[4];
  g_load(A, 1024, m0, 0, tid, ra); g_load(B, 1024, n0, 0, tid, rb);
  s_store(As0, tid, ra); s_store(Bs0, tid, rb);
  __syncthreads();
#pragma unroll 1
  for (int kt = 0; kt < 15; ++kt) {
    g_load(A, 1024, m0, kt + 1, tid, ra); g_load(B, 1024, n0, kt + 1, tid, rb);
    gemm_ktile<true>((kt & 1) ? As1 : As0, (kt & 1) ? Bs1 : Bs0, acc, wm, wn, r, h);
    s_store((kt & 1) ? As0 : As1, tid, ra); s_store((kt & 1) ? Bs0 : Bs1, tid, rb);
    __syncthreads();
    if ((kt & 3) == 3) {
      const int br = kt >> 2;
#pragma unroll
      for (int mi = 0; mi < 2; ++mi) {
        const float f = (br == 0) ? fold[mi][0] : (br == 1) ? fold[mi][1] : fold[mi][2];
#pragma unroll
        for (int ni = 0; ni < 2; ++ni)
#pragma unroll
          for (int i = 0; i < 16; ++i) acc[mi][ni][i] *= f;
      }
    }
  }
  gemm_ktile<true>(As1, Bs1, acc, wm, wn, r, h);
  __syncthreads();
#pragma unroll
  for (int mi = 0; mi < 2; ++mi)
#pragma unroll
    for (int ni = 0; ni < 2; ++ni)
#pragma unroll
      for (int i = 0; i < 16; ++i) acc[mi][ni][i] *= fold[mi][3];
#pragma unroll
  for (int mi = 0; mi < 2; ++mi)
#pragma unroll
    for (int ni = 0; ni < 2; ++ni) {
      const int t = m0 + wm * 64 + mi * 32 + r;
#pragma unroll
      for (int gi = 0; gi < 4; ++gi) {
        const int d = n0 + wn * 64 + ni * 32 + 8 * gi + 4 * h;
        float4 rs = *(const float4*)(resid + (size_t)t * 1024 + d);
        rs.x += acc[mi][ni][4 * gi]; rs.y += acc[mi][ni][4 * gi + 1]; rs.z += acc[mi][ni][4 * gi + 2]; rs.w += acc[mi][ni][4 * gi + 3];
        *(float4*)(p.out + (size_t)t * 1024 + d) = rs;
      }
    }
}

__device__ void phase_gemm_out(const Params& p, int l, unsigned char* smem) {
  const int ntiles = 256 * 8;
  for (int it = blockIdx.x; it < ntiles; it += gridDim.x) gemm_out_tile(p, l, it >> 3, it & 7, smem);
}

__device__ void phase_final(const Params& p) {
  const int lane = threadIdx.x & 63;
  const int gw = blockIdx.x * 4 + (threadIdx.x >> 6), nw = gridDim.x * 4;
  const float4* g4 = (const float4*)p.final_g;
  for (int row = gw; row < TT; row += nw) {
    float4* xr = (float4*)(p.out + (size_t)row * 1024);
    float4 v[4]; float ss = 0.f;
#pragma unroll
    for (int j = 0; j < 4; ++j) { v[j] = xr[lane + 64 * j]; ss += v[j].x * v[j].x + v[j].y * v[j].y + v[j].z * v[j].z + v[j].w * v[j].w; }
    ss = wave_sum(ss);
    const float rinv = rsqrtf(ss * (1.f / 1024.f) + EPS);
#pragma unroll
    for (int j = 0; j < 4; ++j) {
      float4 g = g4[lane + 64 * j];
      float4 o; o.x = v[j].x * rinv * g.x; o.y = v[j].y * rinv * g.y; o.z = v[j].z * rinv * g.z; o.w = v[j].w * rinv * g.w;
      xr[lane + 64 * j] = o;
    }
  }
}

template <int MODE>
__device__ void naive_attn_item(const Params& p, int l, int bh, int qb, unsigned char* smem) {
  float (*Ks)[64] = (float (*)[64])smem;
  float (*Vs)[64] = (float (*)[64])(smem + 16384);
  const int tid = threadIdx.x, b = bh >> 2, hh = bh & 3;
  const int qcol = MODE == 0 ? AQ : MODE == 1 ? CQ : DQ, kcol = MODE == 0 ? AK : MODE == 1 ? CK : DK, gcol = MODE == 0 ? AG : MODE == 1 ? CG : DG;
  const int br = MODE == 0 ? 0 : MODE == 1 ? 2 : 3;
  const int t = qb * 256 + tid;
  const size_t tok = (size_t)b * SEQ + t;
  unsigned q2[32]; float o[64];
#pragma unroll
  for (int d8 = 0; d8 < 8; ++d8) {
    uint4 u = *(const uint4*)(p.P + tok * PC + qcol + hh * 64 + d8 * 8);
    q2[d8 * 4 + 0] = u.x; q2[d8 * 4 + 1] = u.y; q2[d8 * 4 + 2] = u.z; q2[d8 * 4 + 3] = u.w;
  }
#pragma unroll
  for (int d = 0; d < 64; ++d) o[d] = 0.f;
  float m = -INFINITY, lsum = 0.f, carry = 0.f;
  const int hi = qb * 4 + 3;
  const int lo = (MODE == 0) ? max(0, qb * 4 - 8) : 0;
  const int c = t >> 6;
  const float* bias = p.rel_bias + (size_t)(l * 4 + hh) * 257;
  for (int kt = hi; kt >= lo; --kt) {
    __syncthreads();
#pragma unroll 4
    for (int i = 0; i < 16; ++i) {
      const int idx = tid + 256 * i, a = idx >> 6, bb = idx & 63;
      Ks[a][bb] = bf2f(p.P[((size_t)b * SEQ + kt * 64 + a) * PC + kcol + hh * 64 + bb]);
      Vs[bb][a] = bf2f(p.Vt[((size_t)(br * 2 + b) * 256 + hh * 64 + a) * SEQ + kt * 64 + bb]);
    }
    __syncthreads();
    bool tile_ok = true;
    if (MODE == 0) tile_ok = (kt >= c - 8) && (kt <= c);
    if (MODE != 0) tile_ok = (kt * 64 <= t);
    if (!tile_ok) continue;
    for (int j = 63; j >= 0; --j) {
      const int kpos = kt * 64 + j;
      if (MODE == 1 && kpos > t) continue;
      if (MODE == 2 && kpos >= t) continue;
      float dot = 0.f;
#pragma unroll
      for (int d = 0; d < 32; ++d) dot += bflo(q2[d]) * Ks[j][2 * d] + bfhi(q2[d]) * Ks[j][2 * d + 1];
      float pw;
      if (MODE == 2) {
        const float sp = __log2f(1.f + exp2f(dot));
        pw = exp2f(dot - sp - carry);
        carry += sp;
      } else {
        float u;
        if (MODE == 0) { int rel = min(max(t - kpos, -128), 128) + 128; u = dot + bias[rel] * LOG2E; }
        else u = dot - p.csum[((size_t)b * SEQ + kpos) * 4 + hh];
        if (u > m) {
          const float sc = exp2f(m - u);
          lsum *= sc;
#pragma unroll
          for (int d = 0; d < 64; ++d) o[d] *= sc;
          m = u;
        }
        pw = exp2f(u - m);
        lsum += pw;
      }
#pragma unroll
      for (int d = 0; d < 64; ++d) o[d] += pw * Vs[j][d];
    }
  }
  if (MODE != 2) {
    const float inv = 1.f / lsum;
#pragma unroll
    for (int d = 0; d < 64; ++d) o[d] *= inv;
  }
  float ss = 0.f;
#pragma unroll
  for (int d = 0; d < 64; ++d) ss += o[d] * o[d];
  p.ssq[tok * 16 + br * 4 + hh] = ss;
#pragma unroll
  for (int d8 = 0; d8 < 8; ++d8) {
    uint4 g = *(const uint4*)(p.P + tok * PC + gcol + hh * 64 + d8 * 8);
    uint4 z;
    z.x = pk2(o[d8 * 8 + 0] * bflo(g.x), o[d8 * 8 + 1] * bfhi(g.x));
    z.y = pk2(o[d8 * 8 + 2] * bflo(g.y), o[d8 * 8 + 3] * bfhi(g.y));
    z.z = pk2(o[d8 * 8 + 4] * bflo(g.z), o[d8 * 8 + 5] * bfhi(g.z));
    z.w = pk2(o[d8 * 8 + 6] * bflo(g.w), o[d8 * 8 + 7] * bfhi(g.w));
    *(uint4*)(p.Z + tok * 1024 + br * 256 + hh * 64 + d8 * 8) = z;
  }
}

__device__ void naive_gmlp_item(const Params& p, int l, int item, unsigned char* smem) {
  float (*vn)[64] = (float (*)[64])smem;
  float* mu = (float*)(smem + 32768);
  float* rstd = mu + 128;
  float* red = rstd + 128;
  const int tid = threadIdx.x, b = item >> 7, ch = item & 127, s0 = ch * 128;
  const u16* vt = p.Vt + (size_t)(1 * 2 + b) * 256 * SEQ;
  {
    const int tkn = tid & 127, half = tid >> 7;
    float s1 = 0.f, s2 = 0.f;
    for (int cc = 0; cc < 128; ++cc) { float v = bf2f(vt[(size_t)(half * 128 + cc) * SEQ + s0 + tkn]); s1 += v; s2 += v * v; }
    __syncthreads();
    red[tid] = s1; red[256 + tid] = s2;
    __syncthreads();
    if (tid < 128) {
      float a1 = red[tid] + red[tid + 128], a2 = red[256 + tid] + red[256 + tid + 128];
      float mean = a1 * (1.f / 256.f);
      float var = a2 * (1.f / 256.f) - mean * mean;
      mu[tid] = mean; rstd[tid] = rsqrtf(fmaxf(var, 0.f) + EPS);
    }
    __syncthreads();
  }
  const int tkn = tid >> 1, c0 = (tid & 1) * 32;
  const size_t tok = (size_t)b * SEQ + s0 + tkn;
  for (int g = 0; g < 4; ++g) {
    __syncthreads();
    for (int i = 0; i < 32; ++i) {
      const int idx = tid + 256 * i, cc = idx >> 7, s = idx & 127;
      float v = bf2f(vt[(size_t)(g * 64 + cc) * SEQ + s0 + s]);
      vn[s][cc] = (v - mu[s]) * rstd[s] * p.v_gain[l * 256 + g * 64 + cc];
    }
    __syncthreads();
    float acc[32];
#pragma unroll
    for (int i = 0; i < 32; ++i) acc[i] = 0.f;
    const float* wrow = p.w_s + ((size_t)(l * 4 + g) * 128 + tkn) * 128;
    for (int s = 0; s <= tkn; ++s) {
      const float wv = wrow[s];
#pragma unroll
      for (int i = 0; i < 32; ++i) acc[i] += wv * vn[s][c0 + i];
    }
    const float bs = p.b_s[(size_t)(l * 4 + g) * 128 + tkn];
    float ss = 0.f;
#pragma unroll
    for (int i8 = 0; i8 < 4; ++i8) {
      uint4 uu = *(const uint4*)(p.P + tok * PC + BU + g * 64 + c0 + i8 * 8);
      uint4 gg = *(const uint4*)(p.P + tok * PC + BG + g * 64 + c0 + i8 * 8);
      float y[8];
      y[0] = bflo(uu.x) * (acc[i8 * 8 + 0] + bs); y[1] = bfhi(uu.x) * (acc[i8 * 8 + 1] + bs);
      y[2] = bflo(uu.y) * (acc[i8 * 8 + 2] + bs); y[3] = bfhi(uu.y) * (acc[i8 * 8 + 3] + bs);
      y[4] = bflo(uu.z) * (acc[i8 * 8 + 4] + bs); y[5] = bfhi(uu.z) * (acc[i8 * 8 + 5] + bs);
      y[6] = bflo(uu.w) * (acc[i8 * 8 + 6] + bs); y[7] = bfhi(uu.w) * (acc[i8 * 8 + 7] + bs);
#pragma unroll
      for (int e = 0; e < 8; ++e) ss += y[e] * y[e];
      uint4 z;
      z.x = pk2(y[0] * bflo(gg.x), y[1] * bfhi(gg.x)); z.y = pk2(y[2] * bflo(gg.y), y[3] * bfhi(gg.y));
      z.z = pk2(y[4] * bflo(gg.z), y[5] * bfhi(gg.z)); z.w = pk2(y[6] * bflo(gg.w), y[7] * bfhi(gg.w));
      *(uint4*)(p.Z + tok * 1024 + 256 + g * 64 + c0 + i8 * 8) = z;
    }
    ss += __shfl_xor(ss, 1);
    if ((tid & 1) == 0) p.ssq[tok * 16 + 4 + g] = ss;
  }
}

__device__ void phase_mix(const Params& p, int l, unsigned char* smem) {
  __shared__ int s_item;
  constexpr int NITEMS = 1024 + 512 + 256;
  for (;;) {
    if (threadIdx.x == 0) s_item = (int)atomicAdd(p.ctr + l, 1u);
    __syncthreads();
    const int item = s_item;
    __syncthreads();
    if (item >= NITEMS) break;
    if (item < 1024) {
      const int qb = 63 - (item >> 4), sub = item & 15, bh = sub & 7;
      if (sub < 8) naive_attn_item<2>(p, l, bh, qb, smem); else naive_attn_item<1>(p, l, bh, qb, smem);
    } else if (item < 1536) {
      const int j = item - 1024;
      naive_attn_item<0>(p, l, j & 7, j >> 3, smem);
    } else {
      naive_gmlp_item(p, l, item - 1536, smem);
    }
  }
}

DI void run_phase(const Params& p, int ph, unsigned char* smem) {
  if (ph == 0) { phase_pre(p, smem); return; }
  if (ph == 9) { phase_final(p); return; }
  const int l = (ph - 1) >> 2, s = (ph - 1) & 3;
  if (s == 0) phase_norm(p, l);
  else if (s == 1) phase_gemm_in(p, l, smem);
  else if (s == 2) phase_mix(p, l, smem);
  else phase_gemm_out(p, l, smem);
}

template <int KIND>
__global__ void __launch_bounds__(256, (KIND == 3) ? 1 : 2) mk_phase(Params p, int l) {
  __shared__ __attribute__((aligned(16))) unsigned char smem[SMEM_BYTES];
  if (KIND == 0) phase_pre(p, smem);
  else if (KIND == 1) phase_norm(p, l);
  else if (KIND == 2) phase_gemm_in(p, l, smem);
  else if (KIND == 3) phase_mix(p, l, smem);
  else if (KIND == 4) phase_gemm_out(p, l, smem);
  else phase_final(p);
}

#if COOP
__global__ void __launch_bounds__(256, 2) mk_coop(Params p) {
  __shared__ __attribute__((aligned(16))) unsigned char smem[SMEM_BYTES];
  cg::grid_group grid = cg::this_grid();
  for (int ph = 0; ph < 10; ++ph) {
    run_phase(p, ph, smem);
    if (ph < 9) grid.sync();
  }
}
#endif

extern "C" void kernel_launch(void* const* d_in, const int* in_sizes, int n_in, void* d_out, int out_size, void* d_ws,
                              size_t ws_size, hipStream_t stream) {
  Params p{};
  p.x = (const float*)d_in[0]; p.norm_g = (const float*)d_in[1]; p.w_in = (const float*)d_in[2]; p.b_f = (const float*)d_in[3];
  p.rel_bias = (const float*)d_in[4]; p.w_s = (const float*)d_in[5]; p.b_s = (const float*)d_in[6]; p.v_gain = (const float*)d_in[7];
  p.branch_gain = (const float*)d_in[8]; p.w_out = (const float*)d_in[9]; p.final_g = (const float*)d_in[10];
  p.out = (float*)d_out;
  unsigned char* ws = (unsigned char*)d_ws;
  size_t off = 0;
  auto carve = [&](size_t bytes) { unsigned char* q = ws + off; off += (bytes + 255) & ~(size_t)255; return q; };
  p.WtIn = (u16*)carve((size_t)2 * NW * 1024 * 2);
  p.WtOut = (u16*)carve((size_t)2 * 1024 * 1024 * 2);
  p.Ws16 = (u16*)carve((size_t)2 * 4 * 128 * 128 * 2);
  p.H = (u16*)carve((size_t)TT * 1024 * 2);
  p.P = (u16*)carve((size_t)TT * PC * 2);
  p.Vt = (u16*)carve((size_t)4 * 2 * 256 * SEQ * 2);
  p.Z = (u16*)carve((size_t)TT * 1024 * 2);
  p.lsf = (float*)carve((size_t)TT * 4 * 4);
  p.csum = (float*)carve((size_t)TT * 4 * 4);
  p.ssq = (float*)carve((size_t)TT * 16 * 4);
  p.ctr = (unsigned*)carve(256);
  static int grid_blocks = 0;
  if (!grid_blocks) {
    int dev = 0, cus = 0, per_cu = 0;
    hipGetDevice(&dev);
    hipDeviceGetAttribute(&cus, hipDeviceAttributeMultiprocessorCount, dev);
#if COOP
    hipOccupancyMaxActiveBlocksPerMultiprocessor(&per_cu, mk_coop, 256, 0);
#else
    hipOccupancyMaxActiveBlocksPerMultiprocessor(&per_cu, mk_phase<3>, 256, 0);
#endif
    if (per_cu < 1) per_cu = 1;
    if (per_cu > 2) per_cu = 2;
    grid_blocks = cus * per_cu;
  }
#if COOP
  void* args[] = {&p};
  hipError_t e = hipLaunchCooperativeKernel((void*)mk_coop, dim3(grid_blocks), dim3(256), args, 0, stream);
  if (e != hipSuccess) fprintf(stderr, "cooperative launch failed: %s (grid %d)\n", hipGetErrorString(e), grid_blocks);
#else
  mk_phase<0><<<grid_blocks, 256, 0, stream>>>(p, 0);
  for (int l = 0; l < 2; ++l) {
    mk_phase<1><<<grid_blocks, 256, 0, stream>>>(p, l);
    mk_phase<2><<<grid_blocks, 256, 0, stream>>>(p, l);
    mk_phase<3><<<grid_blocks, 256, 0, stream>>>(p, l);
    mk_phase<4><<<grid_blocks, 256, 0, stream>>>(p, l);
  }
  mk_phase<5><<<grid_blocks, 256, 0, stream>>>(p, 0);
#endif
}
```

```cpp
#include <hip/hip_runtime.h>
#include <hip/hip_cooperative_groups.h>
#include <cstdio>
namespace cg = cooperative_groups;

#ifndef COOP
#define COOP 1
#endif
#ifndef PROBE_ONLY
#define PROBE_ONLY 2
#endif
#ifndef PROBE_DUP
#define PROBE_DUP 0
#endif
#ifndef COOP_MINB
#define COOP_MINB 2
#endif

#define DI __device__ __forceinline__
typedef unsigned short u16;
typedef __attribute__((ext_vector_type(8))) short bf16x8;
typedef __attribute__((ext_vector_type(16))) float f32x16;
typedef __attribute__((ext_vector_type(2))) __bf16 bf16v2;
#define MFMA(a, b, c) __builtin_amdgcn_mfma_f32_32x32x16_bf16((a), (b), (c), 0, 0, 0)

constexpr int SEQ = 16384, TT = 32768, DM = 1024, NIN = 3844, NW = 3840, PC = 2816;
constexpr float EPS = 1e-6f, LOG2E = 1.4426950408889634f;
constexpr float QSCALE = 0.125f * LOG2E;
constexpr int AQ = 0, AK = 256, AG = 512, BU = 768, BG = 1024, CQ = 1280, CK = 1536, CG = 1792, DQ = 2048, DK = 2304, DG = 2560;
constexpr int SMEM_BYTES = 131072;
constexpr int NTHR = 512;
constexpr int VTLD = SEQ + 64;

struct Params {
  const float *x, *norm_g, *w_in, *b_f, *rel_bias, *w_s, *b_s, *v_gain, *branch_gain, *w_out, *final_g;
  float* out;
  u16 *WtIn, *WtOut, *Ws16, *H, *P, *Vt, *Z;
  float *lsf, *csum, *ssq, *ctot, *Wf;
  unsigned* ctr;
  unsigned* bar;
};

DI unsigned pk2(float a, float b) { bf16v2 v; v[0] = (__bf16)a; v[1] = (__bf16)b; return __builtin_bit_cast(unsigned, v); }
DI u16 f2bf(float a) { return __builtin_bit_cast(u16, (__bf16)a); }
DI float bf2f(u16 h) { return __uint_as_float(((unsigned)h) << 16); }
DI float bflo(unsigned u) { return __uint_as_float(u << 16); }
DI float bfhi(unsigned u) { return __uint_as_float(u & 0xffff0000u); }
DI int otid() { int t = threadIdx.x; asm volatile("" : "+v"(t)); return t; }
DI float wave_sum(float v) { for (int o = 32; o > 0; o >>= 1) v += __shfl_xor(v, o); return v; }

__device__ void phase_pre(const Params& p, unsigned char* smem) {
  float (*tile)[65] = (float (*)[65])smem;
  const int tid = otid(), tx = tid & 63, ty = tid >> 6;
  const int nA = 2 * 60 * 16, nB = 2 * 16 * 16;
  for (int it = blockIdx.x; it < nA + nB; it += gridDim.x) {
    const float* src; u16* dst; int ld_src, n0, k0, srcoff, nrows;
    if (it < nA) {
      int l = it / 960, rem = it % 960, ntile = rem / 16, ktile = rem % 16;
      n0 = ntile * 64; k0 = ktile * 64;
      src = p.w_in + (size_t)l * 1024 * NIN; ld_src = NIN; dst = p.WtIn + (size_t)l * NW * 1024; srcoff = (n0 >= 2816) ? 4 : 0; nrows = NW;
    } else {
      int j = it - nA; int l = j / 256, rem = j % 256, ntile = rem / 16, ktile = rem % 16;
      n0 = ntile * 64; k0 = ktile * 64;
      src = p.w_out + (size_t)l * 1024 * 1024; ld_src = 1024; dst = p.WtOut + (size_t)l * 1024 * 1024; srcoff = 0; nrows = 1024;
    }
    __syncthreads();
#pragma unroll 4
    for (int i = 0; i < 8; ++i) { int k = ty + 8 * i; tile[k][tx] = src[(size_t)(k0 + k) * ld_src + n0 + srcoff + tx]; }
    __syncthreads();
#pragma unroll 4
    for (int i = 0; i < 8; ++i) { int n = ty + 8 * i; dst[((size_t)(k0 >> 6) * nrows + n0 + n) * 64 + tx] = f2bf(tile[tx][n]); }
  }
  for (int idx = blockIdx.x * NTHR + tid; idx < 2 * 4 * 128 * 128; idx += gridDim.x * NTHR) {
    int t = (idx >> 7) & 127, s = idx & 127;
    p.Ws16[idx] = (s <= t) ? f2bf(p.w_s[idx]) : (u16)0;
  }
  for (int idx = blockIdx.x * NTHR + tid; idx < 2 * 1024; idx += gridDim.x * NTHR) {
    const int l = idx >> 10, k = idx & 1023;
    *(float4*)(p.Wf + (size_t)idx * 4) = *(const float4*)(p.w_in + ((size_t)l * 1024 + k) * NIN + 2816);
  }
  if (blockIdx.x == 0 && tid < 64) p.ctr[tid] = 0u;
}

__device__ void phase_norm(const Params& p, int l) {
  const float* src = (l == 0) ? p.x : p.out;
  const int tid_ = otid();
  const int lane = tid_ & 63;
  const int gw = blockIdx.x * 8 + (tid_ >> 6), nw = gridDim.x * 8;
  const float4* g4 = (const float4*)(p.norm_g + l * 1024);
  const float4* wf4 = (const float4*)(p.Wf + (size_t)l * 4096);
  float4 gr[4], w0[4], w1[4], w2[4], w3[4];
#pragma unroll
  for (int j = 0; j < 4; ++j) {
    const int k = 4 * (lane + 64 * j);
    gr[j] = g4[lane + 64 * j];
    w0[j] = wf4[k]; w1[j] = wf4[k + 1]; w2[j] = wf4[k + 2]; w3[j] = wf4[k + 3];
  }
  const float bf0 = p.b_f[l * 4 + 0], bf1 = p.b_f[l * 4 + 1], bf2 = p.b_f[l * 4 + 2], bf3 = p.b_f[l * 4 + 3];
  for (int row0 = gw * 4; row0 < TT; row0 += nw * 4) {
    float4 v[4][4]; float ss[4] = {0.f, 0.f, 0.f, 0.f};
#pragma unroll
    for (int q = 0; q < 4; ++q) {
      const float4* xr = (const float4*)(src + (size_t)(row0 + q) * 1024);
#pragma unroll
      for (int j = 0; j < 4; ++j) v[q][j] = xr[lane + 64 * j];
    }
#pragma unroll
    for (int q = 0; q < 4; ++q)
#pragma unroll
      for (int j = 0; j < 4; ++j) ss[q] += v[q][j].x * v[q][j].x + v[q][j].y * v[q][j].y + v[q][j].z * v[q][j].z + v[q][j].w * v[q][j].w;
    ss[0] = wave_sum(ss[0]); ss[1] = wave_sum(ss[1]); ss[2] = wave_sum(ss[2]); ss[3] = wave_sum(ss[3]);
#pragma unroll
    for (int q = 0; q < 4; ++q) {
      const int row = row0 + q;
      const float rinv = rsqrtf(ss[q] * (1.f / 1024.f) + EPS);
      float f0 = 0.f, f1 = 0.f, f2 = 0.f, f3 = 0.f;
#pragma unroll
      for (int j = 0; j < 4; ++j) {
        const float h0 = v[q][j].x * rinv * gr[j].x, h1 = v[q][j].y * rinv * gr[j].y, h2 = v[q][j].z * rinv * gr[j].z, h3 = v[q][j].w * rinv * gr[j].w;
        uint2 o; o.x = pk2(h0, h1); o.y = pk2(h2, h3);
        { const int col = 4 * (lane + 64 * j); *(uint2*)(p.H + ((size_t)(col >> 6) * TT + row) * 64 + (col & 63)) = o; }
        f0 += h0 * w0[j].x + h1 * w1[j].x + h2 * w2[j].x + h3 * w3[j].x;
        f1 += h0 * w0[j].y + h1 * w1[j].y + h2 * w2[j].y + h3 * w3[j].y;
        f2 += h0 * w0[j].z + h1 * w1[j].z + h2 * w2[j].z + h3 * w3[j].z;
        f3 += h0 * w0[j].w + h1 * w1[j].w + h2 * w2[j].w + h3 * w3[j].w;
      }
      f0 = wave_sum(f0); f1 = wave_sum(f1); f2 = wave_sum(f2); f3 = wave_sum(f3);
      if (lane == 0) {
        float4 o;
        o.x = f0 + bf0; o.y = f1 + bf1; o.z = f2 + bf2; o.w = f3 + bf3;
        o.x = (fminf(o.x, 0.f) - log1pf(expf(-fabsf(o.x)))) * LOG2E;
        o.y = (fminf(o.y, 0.f) - log1pf(expf(-fabsf(o.y)))) * LOG2E;
        o.z = (fminf(o.z, 0.f) - log1pf(expf(-fabsf(o.z)))) * LOG2E;
        o.w = (fminf(o.w, 0.f) - log1pf(expf(-fabsf(o.w)))) * LOG2E;
        *(float4*)(p.lsf + (size_t)row * 4) = o;
      }
    }
  }
}

__device__ void scan_chunk(const Params& p, int chunk, unsigned char* smem) {
  float4* wtot = (float4*)smem;
  const int tid = otid(), lane = tid & 63, w = tid >> 6;
  const bool act = tid < 256;
  const int ti = act ? tid : 0;
  const float4* in = (const float4*)p.lsf + (size_t)chunk * 1024 + ti * 4;
  float4 v0 = in[0], v1 = in[1], v2 = in[2], v3 = in[3];
  v1.x += v0.x; v1.y += v0.y; v1.z += v0.z; v1.w += v0.w;
  v2.x += v1.x; v2.y += v1.y; v2.z += v1.z; v2.w += v1.w;
  v3.x += v2.x; v3.y += v2.y; v3.z += v2.z; v3.w += v2.w;
  float4 inc = v3;
#pragma unroll
  for (int o = 1; o < 64; o <<= 1) {
    float4 n;
    n.x = __shfl_up(inc.x, o); n.y = __shfl_up(inc.y, o); n.z = __shfl_up(inc.z, o); n.w = __shfl_up(inc.w, o);
    if (lane >= o) { inc.x += n.x; inc.y += n.y; inc.z += n.z; inc.w += n.w; }
  }
  __syncthreads();
  if (act && lane == 63) wtot[w] = inc;
  __syncthreads();
  float4 pre = make_float4(inc.x - v3.x, inc.y - v3.y, inc.z - v3.z, inc.w - v3.w);
  float4 all = make_float4(0.f, 0.f, 0.f, 0.f);
#pragma unroll
  for (int i = 0; i < 4; ++i) {
    float4 t = wtot[i];
    if (i < w) { pre.x += t.x; pre.y += t.y; pre.z += t.z; pre.w += t.w; }
    all.x += t.x; all.y += t.y; all.z += t.z; all.w += t.w;
  }
  if (act) {
    float4* outp = (float4*)p.csum + (size_t)chunk * 1024 + tid * 4;
    outp[0] = make_float4(v0.x + pre.x, v0.y + pre.y, v0.z + pre.z, v0.w + pre.w);
    outp[1] = make_float4(v1.x + pre.x, v1.y + pre.y, v1.z + pre.z, v1.w + pre.w);
    outp[2] = make_float4(v2.x + pre.x, v2.y + pre.y, v2.z + pre.z, v2.w + pre.w);
    outp[3] = make_float4(v3.x + pre.x, v3.y + pre.y, v3.z + pre.z, v3.w + pre.w);
    if (tid == 0) ((float4*)p.ctot)[chunk] = all;
  }
  __syncthreads();
}

typedef u16 (*lds_tile_t)[72];
#define G_LOAD(A_, NR_, m0_, kt_, R_) do { const u16* gp_ = (A_) + ((size_t)(kt_) * (NR_) + (m0_) + (tid >> 3)) * 64 + (tid & 7) * 8; \
    R_##0 = *(const uint4*)gp_; R_##1 = *(const uint4*)(gp_ + 32 * 64); R_##2 = *(const uint4*)(gp_ + 64 * 64); R_##3 = *(const uint4*)(gp_ + 96 * 64); } while (0)
#define S_STORE(S_, R_) do { u16* sp_ = &(S_)[tid >> 3][(tid & 7) * 8]; \
    *(uint4*)sp_ = R_##0; *(uint4*)(sp_ + 32 * 72) = R_##1; *(uint4*)(sp_ + 64 * 72) = R_##2; *(uint4*)(sp_ + 96 * 72) = R_##3; } while (0)
template <bool SWAP>
DI void gemm_ktile(lds_tile_t As, lds_tile_t Bs, f32x16 (&acc)[2][2], int wm, int wn, int r, int h) {
  bf16x8 af[4][2], bfr[4][2];
  const u16* ap = &As[wm * 64 + r][h * 8];
  const u16* bp = &Bs[wn * 64 + r][h * 8];
#pragma unroll
  for (int ks = 0; ks < 4; ++ks) {
    af[ks][0] = *(const bf16x8*)(ap + ks * 16); af[ks][1] = *(const bf16x8*)(ap + 32 * 72 + ks * 16);
    bfr[ks][0] = *(const bf16x8*)(bp + ks * 16); bfr[ks][1] = *(const bf16x8*)(bp + 32 * 72 + ks * 16);
  }
  __builtin_amdgcn_sched_barrier(0);
#pragma unroll
  for (int ks = 0; ks < 4; ++ks)
#pragma unroll
    for (int mi = 0; mi < 2; ++mi)
#pragma unroll
      for (int ni = 0; ni < 2; ++ni)
        acc[mi][ni] = SWAP ? MFMA(bfr[ks][ni], af[ks][mi], acc[mi][ni]) : MFMA(af[ks][mi], bfr[ks][ni], acc[mi][ni]);
}

#define GL_STAGE(GA_, NRA_, m0_, GB_, NRB_, n0_, T32_, SBASE_) do { _Pragma("unroll") for (int j_ = 0; j_ < 2; ++j_) { \
    const int q_ = j_ * 512 + tid, rw_ = q_ >> 2, kc_ = (q_ & 3) ^ ((rw_ >> 2) & 3); \
    __builtin_amdgcn_global_load_lds((const unsigned*)((GA_) + ((size_t)((T32_) >> 1) * (NRA_) + (m0_) + rw_) * 64 + ((T32_) & 1) * 32 + kc_ * 8), \
        (__attribute__((address_space(3))) unsigned*)((SBASE_) + q_ * 16), 16, 0, 0); \
    __builtin_amdgcn_global_load_lds((const unsigned*)((GB_) + ((size_t)((T32_) >> 1) * (NRB_) + (n0_) + rw_) * 64 + ((T32_) & 1) * 32 + kc_ * 8), \
        (__attribute__((address_space(3))) unsigned*)((SBASE_) + 16384 + q_ * 16), 16, 0, 0); } } while (0)
#define GL_WAIT_BAR() do { asm volatile("s_waitcnt vmcnt(8)" ::: "memory"); __builtin_amdgcn_s_barrier(); asm volatile("" ::: "memory"); } while (0)
DI unsigned frag_addr(unsigned base, int row, int kc) { return base + row * 64 + ((kc ^ ((row >> 2) & 3)) << 4); }
template <bool SWAP>
DI void gemm_ktile32(const unsigned char* St, f32x16 (&acc)[4][2], int wm, int wn, int r, int h) {
  const unsigned sa = (unsigned)(size_t)St, sbb = sa + 16384;
  const int ra = wm * 128 + r, rb = wn * 64 + r;
  bf16x8 a0[4], a1[4], b0[2], b1[2];
  asm volatile(
      "ds_read_b128 %0, %6\n\tds_read_b128 %1, %7\n\tds_read_b128 %4, %10\n\tds_read_b128 %5, %11\n\t"
      "ds_read_b128 %2, %8\n\tds_read_b128 %3, %9\n\t"
      "s_waitcnt lgkmcnt(0)"
      : "=&v"(a0[0]), "=&v"(a0[1]), "=&v"(a0[2]), "=&v"(a0[3]), "=&v"(b0[0]), "=&v"(b0[1])
      : "v"(frag_addr(sa, ra, h)), "v"(frag_addr(sa, ra + 32, h)), "v"(frag_addr(sa, ra + 64, h)), "v"(frag_addr(sa, ra + 96, h)),
        "v"(frag_addr(sbb, rb, h)), "v"(frag_addr(sbb, rb + 32, h))
      : "memory");
  asm volatile(
      "ds_read_b128 %0, %6\n\tds_read_b128 %1, %7\n\tds_read_b128 %4, %10\n\tds_read_b128 %5, %11\n\t"
      "ds_read_b128 %2, %8\n\tds_read_b128 %3, %9"
      : "=&v"(a1[0]), "=&v"(a1[1]), "=&v"(a1[2]), "=&v"(a1[3]), "=&v"(b1[0]), "=&v"(b1[1])
      : "v"(frag_addr(sa, ra, 2 + h)), "v"(frag_addr(sa, ra + 32, 2 + h)), "v"(frag_addr(sa, ra + 64, 2 + h)), "v"(frag_addr(sa, ra + 96, 2 + h)),
        "v"(frag_addr(sbb, rb, 2 + h)), "v"(frag_addr(sbb, rb + 32, 2 + h))
      : "memory");
  __builtin_amdgcn_sched_barrier(0);
#pragma unroll
  for (int mi = 0; mi < 4; ++mi)
#pragma unroll
    for (int ni = 0; ni < 2; ++ni) acc[mi][ni] = SWAP ? MFMA(b0[ni], a0[mi], acc[mi][ni]) : MFMA(a0[mi], b0[ni], acc[mi][ni]);
  __builtin_amdgcn_sched_barrier(0);
  asm volatile("s_waitcnt lgkmcnt(0)"
               : "+v"(a1[0]), "+v"(a1[1]), "+v"(a1[2]), "+v"(a1[3]), "+v"(b1[0]), "+v"(b1[1]) : : "memory");
#pragma unroll
  for (int mi = 0; mi < 4; ++mi)
#pragma unroll
    for (int ni = 0; ni < 2; ++ni) acc[mi][ni] = SWAP ? MFMA(b1[ni], a1[mi], acc[mi][ni]) : MFMA(a1[mi], b1[ni], acc[mi][ni]);
}
DI int sec_pcol(int s) { int nv = (s > 2) + (s > 5) + (s > 9) + (s > 13); return (s - nv) * 256; }
DI int sec_branch(int s) { return (s < 4) ? 0 : (s < 7) ? 1 : (s < 11) ? 2 : 3; }

template <bool SWAP>
DI void gemm_mainloop(const u16* A, const u16* B, int nrb, int m0, int n0, unsigned char* smem, f32x16 (&acc)[4][2]) {
  const int tid = otid(), lane = tid & 63, w = tid >> 6, wm = w >> 2, wn = w & 3, r = lane & 31, h = lane >> 5;
  GL_STAGE(A, TT, m0, B, nrb, n0, 0, smem);
  GL_STAGE(A, TT, m0, B, nrb, n0, 1, smem + 32768);
  GL_STAGE(A, TT, m0, B, nrb, n0, 2, smem + 65536);
#pragma unroll 1
  for (int t = 0; t < 32; ++t) {
    GL_WAIT_BAR();
    { const int t3 = min(t + 3, 31); GL_STAGE(A, TT, m0, B, nrb, n0, t3, smem + ((t + 3) & 3) * 32768); }
    gemm_ktile32<SWAP>(smem + (t & 3) * 32768, acc, wm, wn, r, h);
  }
  asm volatile("s_waitcnt vmcnt(0)" ::: "memory");
  __syncthreads();
}

__device__ void gemm_in_tile(const Params& p, int l, int mt, int sec, unsigned char* smem) {
  const int m0 = mt * 256, n0 = sec * 256;
  const bool is_vt = (sec == 2 || sec == 5 || sec == 9 || sec == 13);
  const bool is_q = (sec == 0 || sec == 7 || sec == 11);
  const bool is_gate = (sec == 3 || sec == 6 || sec == 10 || sec == 14);
  const int br = sec_branch(sec);
  const int tid = otid(), lane = tid & 63, w = tid >> 6, wm = w >> 2, wn = w & 3, r = lane & 31, h = lane >> 5;
  const u16* A = p.H;
  const u16* B = p.WtIn + (size_t)l * NW * 1024;
  f32x16 acc[4][2];
#pragma unroll
  for (int mi = 0; mi < 4; ++mi)
#pragma unroll
    for (int ni = 0; ni < 2; ++ni)
#pragma unroll
      for (int i = 0; i < 16; ++i) acc[mi][ni][i] = 0.f;
  if (is_vt) {
    gemm_mainloop<false>(A, B, NW, m0, n0, smem, acc);
#pragma unroll
    for (int mi = 0; mi < 4; ++mi)
#pragma unroll
      for (int ni = 0; ni < 2; ++ni) {
        const int c = wn * 64 + ni * 32 + r;
#pragma unroll
        for (int gi = 0; gi < 4; ++gi) {
          const int t0 = m0 + wm * 128 + mi * 32 + 8 * gi + 4 * h;
          const int b = t0 >> 14, sq = t0 & (SEQ - 1);
          uint2 o; o.x = pk2(acc[mi][ni][4 * gi], acc[mi][ni][4 * gi + 1]); o.y = pk2(acc[mi][ni][4 * gi + 2], acc[mi][ni][4 * gi + 3]);
          *(uint2*)(p.Vt + ((size_t)(br * 2 + b) * 256 + c) * VTLD + sq) = o;
        }
      }
  } else {
    gemm_mainloop<true>(A, B, NW, m0, n0, smem, acc);
    const int pcol = sec_pcol(sec);
    const float* gain = p.branch_gain + (size_t)(l * 4 + br) * 256;
    if (sec == 8) {
      float mx2 = 0.f;
#pragma unroll
      for (int mi = 0; mi < 4; ++mi) {
        float n2 = 0.f;
#pragma unroll
        for (int ni = 0; ni < 2; ++ni)
#pragma unroll
          for (int i = 0; i < 16; ++i) n2 += acc[mi][ni][i] * acc[mi][ni][i];
        n2 += __shfl_xor(n2, 32);
        mx2 = fmaxf(mx2, n2);
      }
#pragma unroll
      for (int o = 16; o > 0; o >>= 1) mx2 = fmaxf(mx2, __shfl_xor(mx2, o));
      if (lane == 0) atomicMax(p.ctr + 48 + l * 8 + (m0 >> 14) * 4 + wn, __float_as_uint(mx2));
    }
#pragma unroll
    for (int mi = 0; mi < 4; ++mi)
#pragma unroll
      for (int ni = 0; ni < 2; ++ni) {
        const int t = m0 + wm * 128 + mi * 32 + r;
#pragma unroll
        for (int gi = 0; gi < 4; ++gi) {
          const int nl = wn * 64 + ni * 32 + 8 * gi + 4 * h;
          float v[4];
#pragma unroll
          for (int e = 0; e < 4; ++e) v[e] = acc[mi][ni][4 * gi + e];
          if (is_q) {
#pragma unroll
            for (int e = 0; e < 4; ++e) v[e] *= QSCALE;
          } else if (is_gate) {
            float4 gg = *(const float4*)(gain + nl);
            const float* gp = (const float*)&gg;
#pragma unroll
            for (int e = 0; e < 4; ++e) v[e] = gp[e] * v[e] / (1.f + __expf(-v[e]));
          }
          uint2 o; o.x = pk2(v[0], v[1]); o.y = pk2(v[2], v[3]);
          *(uint2*)(p.P + (size_t)t * PC + pcol + nl) = o;
        }
      }
  }
}

__device__ void phase_gemm_in(const Params& p, int l, unsigned char* smem) {
  for (int c = (int)gridDim.x - 1 - (int)blockIdx.x; c < 32; c += gridDim.x) scan_chunk(p, c, smem);
  const int xcd = blockIdx.x & 7, slot = blockIdx.x >> 3, nslot = gridDim.x >> 3;
  for (int j = slot; j < 240; j += nslot) {
    const int mg = j / 120, rem = j % 120;
    const int ng = (rem >= 96) ? 3 : (rem >> 5), idx = rem - ng * 32;
    const int mt = xcd * 16 + mg * 8 + (idx & 7), sec = ng * 4 + (idx >> 3);
    gemm_in_tile(p, l, mt, sec, smem);
  }
}

__device__ void gemm_out_tile(const Params& p, int l, int mt, int nt, unsigned char* smem) {
  const int m0 = mt * 256, n0 = nt * 256;
  const int tid = otid(), lane = tid & 63, w = tid >> 6, wm = w >> 2, wn = w & 3, r = lane & 31, h = lane >> 5;
  const u16* A = p.Z;
  const u16* B = p.WtOut + (size_t)l * 1024 * 1024;
  const float* resid = (l == 0) ? p.x : p.out;
  float fold[4][4];
#pragma unroll
  for (int mi = 0; mi < 4; ++mi) {
    const int t = m0 + wm * 128 + mi * 32 + r;
    float rv[4];
#pragma unroll
    for (int br = 0; br < 4; ++br) {
      float4 sq = *(const float4*)(p.ssq + (size_t)t * 16 + br * 4);
      rv[br] = rsqrtf((sq.x + sq.y + sq.z + sq.w) * (1.f / 256.f) + EPS);
    }
    fold[mi][0] = rv[0] / rv[1]; fold[mi][1] = rv[1] / rv[2]; fold[mi][2] = rv[2] / rv[3]; fold[mi][3] = rv[3];
  }
  f32x16 acc[4][2];
#pragma unroll
  for (int mi = 0; mi < 4; ++mi)
#pragma unroll
    for (int ni = 0; ni < 2; ++ni)
#pragma unroll
      for (int i = 0; i < 16; ++i) acc[mi][ni][i] = 0.f;
  GL_STAGE(A, TT, m0, B, 1024, n0, 0, smem);
  GL_STAGE(A, TT, m0, B, 1024, n0, 1, smem + 32768);
  GL_STAGE(A, TT, m0, B, 1024, n0, 2, smem + 65536);
#pragma unroll 1
  for (int t = 0; t < 32; ++t) {
    GL_WAIT_BAR();
    { const int t3 = min(t + 3, 31); GL_STAGE(A, TT, m0, B, 1024, n0, t3, smem + ((t + 3) & 3) * 32768); }
    gemm_ktile32<true>(smem + (t & 3) * 32768, acc, wm, wn, r, h);
    if ((t & 7) == 7) {
      const int br = t >> 3;
#pragma unroll
      for (int mi = 0; mi < 4; ++mi) {
        const float f = (br == 0) ? fold[mi][0] : (br == 1) ? fold[mi][1] : (br == 2) ? fold[mi][2] : fold[mi][3];
#pragma unroll
        for (int ni = 0; ni < 2; ++ni)
#pragma unroll
          for (int i = 0; i < 16; ++i) acc[mi][ni][i] *= f;
      }
    }
  }
  asm volatile("s_waitcnt vmcnt(0)" ::: "memory");
  __syncthreads();
#pragma unroll
  for (int mi = 0; mi < 4; ++mi)
#pragma unroll
    for (int ni = 0; ni < 2; ++ni) {
      const int t = m0 + wm * 128 + mi * 32 + r;
#pragma unroll
      for (int gi = 0; gi < 4; ++gi) {
        const int d = n0 + wn * 64 + ni * 32 + 8 * gi + 4 * h;
        float4 rs = *(const float4*)(resid + (size_t)t * 1024 + d);
        rs.x += acc[mi][ni][4 * gi]; rs.y += acc[mi][ni][4 * gi + 1]; rs.z += acc[mi][ni][4 * gi + 2]; rs.w += acc[mi][ni][4 * gi + 3];
        *(float4*)(p.out + (size_t)t * 1024 + d) = rs;
      }
    }
}

__device__ void phase_gemm_out(const Params& p, int l, unsigned char* smem) {
  const int xcd = blockIdx.x & 7, slot = blockIdx.x >> 3, nslot = gridDim.x >> 3;
  for (int j = slot; j < 64; j += nslot) {
    const int mg = j >> 5, idx = j & 31;
    gemm_out_tile(p, l, xcd * 16 + mg * 8 + (idx & 7), idx >> 3, smem);
  }
}

__device__ void phase_final(const Params& p) {
  const int tid_ = otid();
  const int lane = tid_ & 63;
  const int gw = blockIdx.x * 8 + (tid_ >> 6), nw = gridDim.x * 8;
  const float4* g4 = (const float4*)p.final_g;
  float4 gr[4];
#pragma unroll
  for (int j = 0; j < 4; ++j) gr[j] = g4[lane + 64 * j];
  for (int row0 = gw * 4; row0 < TT; row0 += nw * 4) {
    float4 v[4][4]; float ss[4] = {0.f, 0.f, 0.f, 0.f};
#pragma unroll
    for (int q = 0; q < 4; ++q) {
      const float4* xr = (const float4*)(p.out + (size_t)(row0 + q) * 1024);
#pragma unroll
      for (int j = 0; j < 4; ++j) v[q][j] = xr[lane + 64 * j];
    }
#pragma unroll
    for (int q = 0; q < 4; ++q)
#pragma unroll
      for (int j = 0; j < 4; ++j) ss[q] += v[q][j].x * v[q][j].x + v[q][j].y * v[q][j].y + v[q][j].z * v[q][j].z + v[q][j].w * v[q][j].w;
    ss[0] = wave_sum(ss[0]); ss[1] = wave_sum(ss[1]); ss[2] = wave_sum(ss[2]); ss[3] = wave_sum(ss[3]);
#pragma unroll
    for (int q = 0; q < 4; ++q) {
      float4* xr = (float4*)(p.out + (size_t)(row0 + q) * 1024);
      const float rinv = rsqrtf(ss[q] * (1.f / 1024.f) + EPS);
#pragma unroll
      for (int j = 0; j < 4; ++j) {
        float4 o; o.x = v[q][j].x * rinv * gr[j].x; o.y = v[q][j].y * rinv * gr[j].y; o.z = v[q][j].z * rinv * gr[j].z; o.w = v[q][j].w * rinv * gr[j].w;
        xr[lane + 64 * j] = o;
      }
    }
  }
}

template <int MODE>
__device__ void naive_attn_item(const Params& p, int l, int bh, int qb, unsigned char* smem) {
  float (*Ks)[64] = (float (*)[64])smem;
  float (*Vs)[64] = (float (*)[64])(smem + 16384);
  const int tid = otid(), b = bh >> 2, hh = bh & 3;
  const int qcol = MODE == 0 ? AQ : MODE == 1 ? CQ : DQ, kcol = MODE == 0 ? AK : MODE == 1 ? CK : DK, gcol = MODE == 0 ? AG : MODE == 1 ? CG : DG;
  const int br = MODE == 0 ? 0 : MODE == 1 ? 2 : 3;
  const int t = qb * 256 + tid;
  const size_t tok = (size_t)b * SEQ + t;
  unsigned q2[32]; float o[64];
#pragma unroll
  for (int d8 = 0; d8 < 8; ++d8) {
    uint4 u = *(const uint4*)(p.P + tok * PC + qcol + hh * 64 + d8 * 8);
    q2[d8 * 4 + 0] = u.x; q2[d8 * 4 + 1] = u.y; q2[d8 * 4 + 2] = u.z; q2[d8 * 4 + 3] = u.w;
  }
#pragma unroll
  for (int d = 0; d < 64; ++d) o[d] = 0.f;
  float m = -INFINITY, lsum = 0.f, carry = 0.f;
  const int hi = qb * 4 + 3;
  const int lo = (MODE == 0) ? max(0, qb * 4 - 8) : 0;
  const int c = t >> 6;
  const float* bias = p.rel_bias + (size_t)(l * 4 + hh) * 257;
  for (int kt = hi; kt >= lo; --kt) {
    __syncthreads();
#pragma unroll 4
    for (int i = 0; i < 16; ++i) {
      const int idx = tid + 256 * i, a = idx >> 6, bb = idx & 63;
      Ks[a][bb] = bf2f(p.P[((size_t)b * SEQ + kt * 64 + a) * PC + kcol + hh * 64 + bb]);
      Vs[bb][a] = bf2f(p.Vt[((size_t)(br * 2 + b) * 256 + hh * 64 + a) * SEQ + kt * 64 + bb]);
    }
    __syncthreads();
    bool tile_ok = true;
    if (MODE == 0) tile_ok = (kt >= c - 8) && (kt <= c);
    if (MODE != 0) tile_ok = (kt * 64 <= t);
    if (!tile_ok) continue;
    for (int j = 63; j >= 0; --j) {
      const int kpos = kt * 64 + j;
      if (MODE == 1 && kpos > t) continue;
      if (MODE == 2 && kpos >= t) continue;
      float dot = 0.f;
#pragma unroll
      for (int d = 0; d < 32; ++d) dot += bflo(q2[d]) * Ks[j][2 * d] + bfhi(q2[d]) * Ks[j][2 * d + 1];
      float pw;
      if (MODE == 2) {
        const float sp = __log2f(1.f + exp2f(dot));
        pw = exp2f(dot - sp - carry);
        carry += sp;
      } else {
        float u;
        if (MODE == 0) { int rel = min(max(t - kpos, -128), 128) + 128; u = dot + bias[rel] * LOG2E; }
        else u = dot - p.csum[((size_t)b * SEQ + kpos) * 4 + hh];
        if (u > m) {
          const float sc = exp2f(m - u);
          lsum *= sc;
#pragma unroll
          for (int d = 0; d < 64; ++d) o[d] *= sc;
          m = u;
        }
        pw = exp2f(u - m);
        lsum += pw;
      }
#pragma unroll
      for (int d = 0; d < 64; ++d) o[d] += pw * Vs[j][d];
    }
  }
  if (MODE != 2) {
    const float inv = 1.f / lsum;
#pragma unroll
    for (int d = 0; d < 64; ++d) o[d] *= inv;
  }
  float ss = 0.f;
#pragma unroll
  for (int d = 0; d < 64; ++d) ss += o[d] * o[d];
  p.ssq[tok * 16 + br * 4 + hh] = ss;
#pragma unroll
  for (int d8 = 0; d8 < 8; ++d8) {
    uint4 g = *(const uint4*)(p.P + tok * PC + gcol + hh * 64 + d8 * 8);
    uint4 z;
    z.x = pk2(o[d8 * 8 + 0] * bflo(g.x), o[d8 * 8 + 1] * bfhi(g.x));
    z.y = pk2(o[d8 * 8 + 2] * bflo(g.y), o[d8 * 8 + 3] * bfhi(g.y));
    z.z = pk2(o[d8 * 8 + 4] * bflo(g.z), o[d8 * 8 + 5] * bfhi(g.z));
    z.w = pk2(o[d8 * 8 + 6] * bflo(g.w), o[d8 * 8 + 7] * bfhi(g.w));
    *(uint4*)(p.Z + tok * 1024 + br * 256 + hh * 64 + d8 * 8) = z;
  }
}


typedef _Float16 f16x8 __attribute__((ext_vector_type(8)));
typedef _Float16 f16v2 __attribute__((ext_vector_type(2)));
typedef unsigned u32x4 __attribute__((ext_vector_type(4)));
#define MFMA_F16(a, b, c) __builtin_amdgcn_mfma_f32_32x32x16_f16((a), (b), (c), 0, 0, 0)
constexpr int KST = 88, VST = 68;
constexpr int STAGE_BYTES = 64 * KST * 2 + 64 * VST * 2;
constexpr int ATT_TAB_OFF = 2 * STAGE_BYTES;

DI int crow(int i, int h) { return (i & 3) + 8 * (i >> 2) + 4 * h; }
DI unsigned pkh2(float a, float b) { f16v2 v; v[0] = (_Float16)a; v[1] = (_Float16)b; return __builtin_bit_cast(unsigned, v); }
DI float ex2(float x) { return __builtin_amdgcn_exp2f(x); }
DI float lg2(float x) { return __builtin_amdgcn_logf(x); }

template <int MODE>
DI void attn_subtile(const u16* Kt, const u16* Vs, int st, bool diag, int r, int h, const bf16x8 (&qf)[4], bf16x8 qx,
                     const f16x8 (&uf)[2], const float* tab, int dist0, f32x16 (&O)[2], float& m, float& lsum, float& carry) {
  f32x16 s;
#pragma unroll
  for (int i = 0; i < 16; ++i) s[i] = 0.f;
  const u16* kp = Kt + (32 * st + r) * KST + 8 * h;
#pragma unroll
  for (int ks = 0; ks < 4; ++ks) s = MFMA(*(const bf16x8*)(kp + 16 * ks), qf[ks], s);
  if (MODE == 1) s = MFMA(*(const bf16x8*)(kp + 64), qx, s);
  f32x16 pv;
  if (MODE == 2) {
    f32x16 sp;
#pragma unroll
    for (int i = 0; i < 16; ++i) sp[i] = lg2(1.f + ex2(s[i]));
    if (diag) {
#pragma unroll
      for (int i = 0; i < 16; ++i) if (crow(i, h) >= r) sp[i] = 0.f;
    }
    u32x4 a0, a1;
#pragma unroll
    for (int j = 0; j < 4; ++j) { a0[j] = pkh2(sp[2 * j], sp[2 * j + 1]); a1[j] = pkh2(sp[8 + 2 * j], sp[8 + 2 * j + 1]); }
    f32x16 cs;
#pragma unroll
    for (int i = 0; i < 16; ++i) cs[i] = carry;
    cs = MFMA_F16(uf[0], __builtin_bit_cast(f16x8, a0), cs);
    cs = MFMA_F16(uf[1], __builtin_bit_cast(f16x8, a1), cs);
#pragma unroll
    for (int i = 0; i < 16; ++i) pv[i] = ex2(s[i] - cs[i]);
    if (diag) {
#pragma unroll
      for (int i = 0; i < 16; ++i) if (crow(i, h) >= r) pv[i] = 0.f;
    }
    carry = __shfl(cs[0], r);
  } else {
    if (MODE == 0) {
#pragma unroll
      for (int i = 0; i < 16; ++i) { int idx = min(max(dist0 - crow(i, h), -128), 128) + 128; s[i] += tab[idx]; }
    }
    if (MODE == 1 && diag) {
#pragma unroll
      for (int i = 0; i < 16; ++i) if (crow(i, h) > r) s[i] = -1e30f;
    }
    float mx = s[0];
#pragma unroll
    for (int i = 1; i < 16; ++i) mx = fmaxf(mx, s[i]);
    mx = fmaxf(mx, __shfl_xor(mx, 32));
    if (__any(mx > m)) {
      const float mn = fmaxf(m, mx);
      const float al = ex2(m - mn);
      m = mn; lsum *= al;
#pragma unroll
      for (int i = 0; i < 16; ++i) { O[0][i] *= al; O[1][i] *= al; }
    }
    float rs = 0.f;
#pragma unroll
    for (int i = 0; i < 16; ++i) { pv[i] = ex2(s[i] - m); rs += pv[i]; }
    lsum += rs;
  }
#pragma unroll
  for (int s2 = 0; s2 < 2; ++s2) {
    u32x4 pp;
#pragma unroll
    for (int j = 0; j < 4; ++j) pp[j] = pk2(pv[8 * s2 + 2 * j], pv[8 * s2 + 2 * j + 1]);
    const bf16x8 pf = __builtin_bit_cast(bf16x8, pp);
#pragma unroll
    for (int mt = 0; mt < 2; ++mt) {
      const u16* vp = Vs + (32 * mt + r) * VST + 32 * st + 16 * s2 + 4 * h;
      const uint2 v0 = *(const uint2*)vp, v1 = *(const uint2*)(vp + 8);
      u32x4 vv; vv[0] = v0.x; vv[1] = v0.y; vv[2] = v1.x; vv[3] = v1.y;
      O[mt] = MFMA(__builtin_bit_cast(bf16x8, vv), pf, O[mt]);
    }
  }
}


template <int MODE>
DI void attn_tile2(const u16* Kt, const u16* Vs, bool diag1, int r, int h, const bf16x8 (&qf)[4], bf16x8 qx,
                   const f16x8 (&uf)[2], const float* tab, int dist0, f32x16 (&O)[2], float& m, float& lsum, float& carry) {
  f32x16 s1, s0;
#pragma unroll
  for (int i = 0; i < 16; ++i) { s1[i] = 0.f; s0[i] = 0.f; }
  const u16* kp0 = Kt + r * KST + 8 * h;
  const u16* kp1 = kp0 + 32 * KST;
#pragma unroll
  for (int ks = 0; ks < 4; ++ks) {
    s1 = MFMA(*(const bf16x8*)(kp1 + 16 * ks), qf[ks], s1);
    s0 = MFMA(*(const bf16x8*)(kp0 + 16 * ks), qf[ks], s0);
  }
  if (MODE == 1) { s1 = MFMA(*(const bf16x8*)(kp1 + 64), qx, s1); s0 = MFMA(*(const bf16x8*)(kp0 + 64), qx, s0); }
  u32x4 vf1[2][2];
#pragma unroll
  for (int s2 = 0; s2 < 2; ++s2)
#pragma unroll
    for (int mt = 0; mt < 2; ++mt) {
      const u16* vp = Vs + (32 * mt + r) * VST + 32 + 16 * s2 + 4 * h;
      const uint2 v0 = *(const uint2*)vp, v1 = *(const uint2*)(vp + 8);
      vf1[s2][mt][0] = v0.x; vf1[s2][mt][1] = v0.y; vf1[s2][mt][2] = v1.x; vf1[s2][mt][3] = v1.y;
    }
  __builtin_amdgcn_sched_barrier(0);
  f32x16 p1, p0;
  if (MODE == 2) {
    f32x16 sp1, sp0;
#pragma unroll
    for (int i = 0; i < 16; ++i) { sp1[i] = lg2(1.f + ex2(s1[i])); sp0[i] = lg2(1.f + ex2(s0[i])); }
    if (diag1) {
#pragma unroll
      for (int i = 0; i < 16; ++i) if (crow(i, h) >= r) sp1[i] = 0.f;
    }
    u32x4 a10, a11, a00, a01;
#pragma unroll
    for (int j = 0; j < 4; ++j) {
      a10[j] = pkh2(sp1[2 * j], sp1[2 * j + 1]); a11[j] = pkh2(sp1[8 + 2 * j], sp1[8 + 2 * j + 1]);
      a00[j] = pkh2(sp0[2 * j], sp0[2 * j + 1]); a01[j] = pkh2(sp0[8 + 2 * j], sp0[8 + 2 * j + 1]);
    }
    f32x16 cs1, cs0;
#pragma unroll
    for (int i = 0; i < 16; ++i) { cs1[i] = carry; cs0[i] = carry; }
    cs1 = MFMA_F16(uf[0], __builtin_bit_cast(f16x8, a10), cs1);
    cs0 = MFMA_F16(uf[0], __builtin_bit_cast(f16x8, a00), cs0);
    cs1 = MFMA_F16(uf[1], __builtin_bit_cast(f16x8, a11), cs1);
    cs0 = MFMA_F16(uf[1], __builtin_bit_cast(f16x8, a01), cs0);
#pragma unroll
    for (int i = 0; i < 16; ++i) p1[i] = ex2(s1[i] - cs1[i]);
    if (diag1) {
#pragma unroll
      for (int i = 0; i < 16; ++i) if (crow(i, h) >= r) p1[i] = 0.f;
    }
    const float tot1 = __shfl(cs1[0], r) - carry;
#pragma unroll
    for (int i = 0; i < 16; ++i) p0[i] = ex2(s0[i] - tot1 - cs0[i]);
    carry = __shfl(cs0[0], r) + tot1;
  } else {
    if (MODE == 0) {
      if (diag1) {
        const float cb = tab[256];
#pragma unroll
        for (int i = 0; i < 16; ++i) { s1[i] += cb; s0[i] += cb; }
      } else {
#pragma unroll
        for (int i = 0; i < 16; ++i) {
          const int d0 = dist0 - crow(i, h);
          s1[i] += tab[min(max(d0 - 32, -128), 128) + 128];
          s0[i] += tab[min(max(d0, -128), 128) + 128];
        }
      }
    }
    if (MODE == 1 && diag1) {
#pragma unroll
      for (int i = 0; i < 16; ++i) if (crow(i, h) > r) s1[i] = -1e30f;
    }
    float mx = fmaxf(s1[0], s0[0]);
#pragma unroll
    for (int i = 1; i < 16; ++i) mx = fmaxf(mx, fmaxf(s1[i], s0[i]));
    mx = fmaxf(mx, __shfl_xor(mx, 32));
    if (__any(mx > m)) {
      const float mn = fmaxf(m, mx);
      const float al = ex2(m - mn);
      m = mn; lsum *= al;
#pragma unroll
      for (int i = 0; i < 16; ++i) { O[0][i] *= al; O[1][i] *= al; }
    }
    float rs1 = 0.f, rs0 = 0.f;
#pragma unroll
    for (int i = 0; i < 16; ++i) { p1[i] = ex2(s1[i] - m); rs1 += p1[i]; p0[i] = ex2(s0[i] - m); rs0 += p0[i]; }
    lsum += rs1 + rs0;
  }
  __builtin_amdgcn_sched_barrier(0);
  u32x4 vf0[2][2];
#pragma unroll
  for (int s2 = 0; s2 < 2; ++s2)
#pragma unroll
    for (int mt = 0; mt < 2; ++mt) {
      const u16* vp = Vs + (32 * mt + r) * VST + 16 * s2 + 4 * h;
      const uint2 v0 = *(const uint2*)vp, v1 = *(const uint2*)(vp + 8);
      vf0[s2][mt][0] = v0.x; vf0[s2][mt][1] = v0.y; vf0[s2][mt][2] = v1.x; vf0[s2][mt][3] = v1.y;
    }
#pragma unroll
  for (int s2 = 0; s2 < 2; ++s2) {
    u32x4 pp;
#pragma unroll
    for (int j = 0; j < 4; ++j) pp[j] = pk2(p1[8 * s2 + 2 * j], p1[8 * s2 + 2 * j + 1]);
    const bf16x8 pf = __builtin_bit_cast(bf16x8, pp);
    O[0] = MFMA(__builtin_bit_cast(bf16x8, vf1[s2][0]), pf, O[0]);
    O[1] = MFMA(__builtin_bit_cast(bf16x8, vf1[s2][1]), pf, O[1]);
  }
#pragma unroll
  for (int s2 = 0; s2 < 2; ++s2) {
    u32x4 pp;
#pragma unroll
    for (int j = 0; j < 4; ++j) pp[j] = pk2(p0[8 * s2 + 2 * j], p0[8 * s2 + 2 * j + 1]);
    const bf16x8 pf = __builtin_bit_cast(bf16x8, pp);
    O[0] = MFMA(__builtin_bit_cast(bf16x8, vf0[s2][0]), pf, O[0]);
    O[1] = MFMA(__builtin_bit_cast(bf16x8, vf0[s2][1]), pf, O[1]);
  }
}

template <int MODE>
__device__ void attn_item(const Params& p, int l, int bh, int qb, unsigned char* smem) {
  const int tid = otid(), lane = tid & 63, w = tid >> 6, r = lane & 31, h = lane >> 5;
  const int b = bh >> 2, hh = bh & 3;
  const int qcol = MODE == 0 ? AQ : MODE == 1 ? CQ : DQ, kcol = MODE == 0 ? AK : MODE == 1 ? CK : DK, gcol = MODE == 0 ? AG : MODE == 1 ? CG : DG;
  const int br = MODE == 0 ? 0 : MODE == 1 ? 2 : 3;
  const int q0 = qb * 256, qs0 = q0 + 32 * w, t = qs0 + r;
  const size_t tok = (size_t)b * SEQ + t;
  const int hi = 4 * qb + 3, lo = (MODE == 0) ? max(0, 4 * qb - 8) : 0;
  float* tab = (float*)(smem + ATT_TAB_OFF);

  bf16x8 qf[4];
#pragma unroll
  for (int ks = 0; ks < 4; ++ks) qf[ks] = *(const bf16x8*)(p.P + tok * PC + qcol + hh * 64 + 16 * ks + 8 * h);
  bf16x8 qx;
#pragma unroll
  for (int j = 0; j < 8; ++j) qx[j] = (h == 0 && j < 3) ? (short)0x3F80 : (short)0;
  f16x8 uf[2];
#pragma unroll
  for (int s2 = 0; s2 < 2; ++s2)
#pragma unroll
    for (int j = 0; j < 8; ++j) uf[s2][j] = ((16 * s2 + 8 * (j >> 2) + 4 * h + (j & 3)) >= r) ? (_Float16)1.f : (_Float16)0.f;
  float* coff = (float*)(smem + ATT_TAB_OFF + 1040);
  float cref = 0.f;
  float qk_bound = 0.f, cbn = 0.f, cbc = 0.f;
  if (MODE == 1) {
    float n2 = 0.f;
#pragma unroll
    for (int ks = 0; ks < 4; ++ks)
#pragma unroll
      for (int j = 0; j < 8; ++j) { const float v = bf2f((u16)qf[ks][j]); n2 += v * v; }
    n2 += __shfl_xor(n2, 32);
    const float k2 = __uint_as_float(__hip_atomic_load(p.ctr + 48 + l * 8 + bh, __ATOMIC_RELAXED, __HIP_MEMORY_SCOPE_AGENT));
    qk_bound = sqrtf(n2) * sqrtf(k2) * 1.02f + 1e-3f;
  }

  const int lrow = tid >> 3, lch = tid & 7;
  const u16* kbase = p.P + ((size_t)b * SEQ + lrow) * PC + kcol + hh * 64 + lch * 8;
  const u16* vbase = p.Vt + ((size_t)(br * 2 + b) * 256 + hh * 64 + lrow) * VTLD + lch * 8;
  constexpr int STG2 = 2 * STAGE_BYTES;
  float* tab2 = (float*)(smem + 2 * STG2);
  float* coff2 = tab2 + 260;
  const int csub = (tid >> 6) & 1, ckey = tid & 63;
  uint4 kr0, kr1, vr0, vr1; float cval = 0.f, coffv = 0.f;
#define ATT_LOAD(KT_) do { const int k0_ = (KT_) * 64; \
    kr0 = *(const uint4*)(kbase + (size_t)k0_ * PC); kr1 = *(const uint4*)(kbase + (size_t)(k0_ - 64) * PC); \
    vr0 = *(const uint4*)(vbase + k0_); vr1 = *(const uint4*)(vbase + k0_ - 64); \
    if (MODE == 1) { cbn = p.csum[((size_t)b * SEQ + k0_ - 64) * 4 + hh] + coff2[(k0_ - 64) >> 10]; } \
    if (MODE == 1 && tid < 128) { const int kk_ = k0_ - 64 * csub; cval = p.csum[((size_t)b * SEQ + kk_ + ckey) * 4 + hh]; coffv = coff2[kk_ >> 10]; } } while (0)
#define ATT_STORE(STG_) do { u16* Kt_ = (u16*)(smem + (STG_) * STG2); u16* Vs_ = Kt_ + 64 * KST; \
    u16* Kt1_ = (u16*)(smem + (STG_) * STG2 + STAGE_BYTES); u16* Vs1_ = Kt1_ + 64 * KST; \
    *(uint4*)(Kt_ + lrow * KST + lch * 8) = kr0; *(uint4*)(Kt1_ + lrow * KST + lch * 8) = kr1; \
    *(uint2*)(Vs_ + lrow * VST + lch * 8) = make_uint2(vr0.x, vr0.y); *(uint2*)(Vs_ + lrow * VST + lch * 8 + 4) = make_uint2(vr0.z, vr0.w); \
    *(uint2*)(Vs1_ + lrow * VST + lch * 8) = make_uint2(vr1.x, vr1.y); *(uint2*)(Vs1_ + lrow * VST + lch * 8 + 4) = make_uint2(vr1.z, vr1.w); \
    if (MODE == 1 && tid < 128) { const float val_ = cref - (cval + coffv); const u16 c1_ = f2bf(val_); const float r1_ = val_ - bf2f(c1_); \
      const u16 c2_ = f2bf(r1_); const u16 c3_ = f2bf(r1_ - bf2f(c2_)); \
      uint4 e0_; e0_.x = (unsigned)c1_ | ((unsigned)c2_ << 16); e0_.y = (unsigned)c3_; e0_.z = 0u; e0_.w = 0u; \
      u16* ke_ = (csub ? Kt1_ : Kt_) + ckey * KST + 64; \
      *(uint4*)ke_ = e0_; *(uint4*)(ke_ + 8) = make_uint4(0u, 0u, 0u, 0u); } } while (0)

  __syncthreads();
  if (MODE == 0) { for (int i = tid; i < 257; i += NTHR) tab2[i] = p.rel_bias[(size_t)(l * 4 + hh) * 257 + i] * LOG2E; }
  if (MODE == 1) {
    if (tid < 16) { float a = 0.f; for (int c = 0; c < tid; ++c) a += p.ctot[(b * 16 + c) * 4 + hh]; coff2[tid] = a; }
    __syncthreads();
    cref = p.csum[((size_t)b * SEQ + q0) * 4 + hh] + coff2[q0 >> 10];
  }
  ATT_LOAD(hi);
  ATT_STORE(0);
  cbc = cbn;
  ATT_LOAD(max(hi - 2, lo + 1));
  __syncthreads();

  f32x16 O[2];
#pragma unroll
  for (int i = 0; i < 16; ++i) { O[0][i] = 0.f; O[1][i] = 0.f; }
  float m = -1e30f, lsum = 0.f, carry = 0.f;
  int stage = 0;
  bool wdone = false;
  const int cw = qs0 >> 6;
#pragma unroll 1
  for (int kp = hi; kp > lo; kp -= 2) {
    const float cb_next = cbn;
    ATT_STORE(stage ^ 1);
    __builtin_amdgcn_sched_barrier(0);
    ATT_LOAD(max(kp - 4, lo + 1));
    __builtin_amdgcn_sched_barrier(0);
    if (!(MODE == 2 && wdone)) {
#pragma unroll
    for (int sub = 0; sub < 2; ++sub) {
      const int kt = kp - sub;
      const u16* Kt = (const u16*)(smem + stage * STG2 + sub * STAGE_BYTES);
      const u16* Vs = Kt + 64 * KST;
      const int k0 = kt * 64;
      if (MODE == 0) {
        if (kt <= cw && kt >= cw - 8) attn_tile2<0>(Kt, Vs, (qs0 - k0 - 63 >= 128), r, h, qf, qx, uf, tab2, t - k0, O, m, lsum, carry);
      } else {
        if (k0 + 32 <= qs0) attn_tile2<MODE>(Kt, Vs, (k0 + 32 == qs0), r, h, qf, qx, uf, tab2, 0, O, m, lsum, carry);
        else if (k0 <= qs0) attn_subtile<MODE>(Kt, Vs, 0, (k0 == qs0), r, h, qf, qx, uf, tab2, 0, O, m, lsum, carry);
      }
    }
    }
    if (MODE == 2) {
      wdone = __all(carry > 160.f) != 0;
      if (__syncthreads_and(wdone ? 1 : 0)) break;
    } else if (MODE == 1) {
      const bool z = (m > -1e29f) && (qk_bound + (cref - cbc) - m < -165.f);
      if (__syncthreads_and(__all(z) ? 1 : 0)) break;
      cbc = cb_next;
    } else {
      __syncthreads();
    }
    stage ^= 1;
  }
#undef ATT_LOAD
#undef ATT_STORE
  if (MODE != 2) {
    const float lt = lsum + __shfl_xor(lsum, 32);
    const float inv = 1.f / lt;
#pragma unroll
    for (int i = 0; i < 16; ++i) { O[0][i] *= inv; O[1][i] *= inv; }
  }
  float ss = 0.f;
#pragma unroll
  for (int i = 0; i < 16; ++i) ss += O[0][i] * O[0][i] + O[1][i] * O[1][i];
  ss += __shfl_xor(ss, 32);
  if (h == 0) p.ssq[tok * 16 + br * 4 + hh] = ss;
  uint2 gq[2][4];
#pragma unroll
  for (int mt = 0; mt < 2; ++mt)
#pragma unroll
    for (int gi = 0; gi < 4; ++gi) gq[mt][gi] = *(const uint2*)(p.P + tok * PC + gcol + hh * 64 + 32 * mt + 8 * gi + 4 * h);
#pragma unroll
  for (int mt = 0; mt < 2; ++mt)
#pragma unroll
    for (int gi = 0; gi < 4; ++gi) {
      const int d0 = 32 * mt + 8 * gi + 4 * h;
      const uint2 g = gq[mt][gi];
      uint2 z;
      z.x = pk2(O[mt][4 * gi] * bflo(g.x), O[mt][4 * gi + 1] * bfhi(g.x));
      z.y = pk2(O[mt][4 * gi + 2] * bflo(g.y), O[mt][4 * gi + 3] * bfhi(g.y));
      *(uint2*)(p.Z + ((size_t)(br * 4 + hh) * TT + tok) * 64 + d0) = z;
    }
}

__device__ void naive_gmlp_item(const Params& p, int l, int item, unsigned char* smem) {
  float (*vn)[64] = (float (*)[64])smem;
  float* mu = (float*)(smem + 32768);
  float* rstd = mu + 128;
  float* red = rstd + 128;
  const int tid = otid(), b = item >> 7, ch = item & 127, s0 = ch * 128;
  const u16* vt = p.Vt + (size_t)(1 * 2 + b) * 256 * SEQ;
  {
    const int tkn = tid & 127, half = tid >> 7;
    float s1 = 0.f, s2 = 0.f;
    for (int cc = 0; cc < 128; ++cc) { float v = bf2f(vt[(size_t)(half * 128 + cc) * SEQ + s0 + tkn]); s1 += v; s2 += v * v; }
    __syncthreads();
    red[tid] = s1; red[256 + tid] = s2;
    __syncthreads();
    if (tid < 128) {
      float a1 = red[tid] + red[tid + 128], a2 = red[256 + tid] + red[256 + tid + 128];
      float mean = a1 * (1.f / 256.f);
      float var = a2 * (1.f / 256.f) - mean * mean;
      mu[tid] = mean; rstd[tid] = rsqrtf(fmaxf(var, 0.f) + EPS);
    }
    __syncthreads();
  }
  const int tkn = tid >> 1, c0 = (tid & 1) * 32;
  const size_t tok = (size_t)b * SEQ + s0 + tkn;
  for (int g = 0; g < 4; ++g) {
    __syncthreads();
    for (int i = 0; i < 32; ++i) {
      const int idx = tid + 256 * i, cc = idx >> 7, s = idx & 127;
      float v = bf2f(vt[(size_t)(g * 64 + cc) * SEQ + s0 + s]);
      vn[s][cc] = (v - mu[s]) * rstd[s] * p.v_gain[l * 256 + g * 64 + cc];
    }
    __syncthreads();
    float acc[32];
#pragma unroll
    for (int i = 0; i < 32; ++i) acc[i] = 0.f;
    const float* wrow = p.w_s + ((size_t)(l * 4 + g) * 128 + tkn) * 128;
    for (int s = 0; s <= tkn; ++s) {
      const float wv = wrow[s];
#pragma unroll
      for (int i = 0; i < 32; ++i) acc[i] += wv * vn[s][c0 + i];
    }
    const float bs = p.b_s[(size_t)(l * 4 + g) * 128 + tkn];
    float ss = 0.f;
#pragma unroll
    for (int i8 = 0; i8 < 4; ++i8) {
      uint4 uu = *(const uint4*)(p.P + tok * PC + BU + g * 64 + c0 + i8 * 8);
      uint4 gg = *(const uint4*)(p.P + tok * PC + BG + g * 64 + c0 + i8 * 8);
      float y[8];
      y[0] = bflo(uu.x) * (acc[i8 * 8 + 0] + bs); y[1] = bfhi(uu.x) * (acc[i8 * 8 + 1] + bs);
      y[2] = bflo(uu.y) * (acc[i8 * 8 + 2] + bs); y[3] = bfhi(uu.y) * (acc[i8 * 8 + 3] + bs);
      y[4] = bflo(uu.z) * (acc[i8 * 8 + 4] + bs); y[5] = bfhi(uu.z) * (acc[i8 * 8 + 5] + bs);
      y[6] = bflo(uu.w) * (acc[i8 * 8 + 6] + bs); y[7] = bfhi(uu.w) * (acc[i8 * 8 + 7] + bs);
#pragma unroll
      for (int e = 0; e < 8; ++e) ss += y[e] * y[e];
      uint4 z;
      z.x = pk2(y[0] * bflo(gg.x), y[1] * bfhi(gg.x)); z.y = pk2(y[2] * bflo(gg.y), y[3] * bfhi(gg.y));
      z.z = pk2(y[4] * bflo(gg.z), y[5] * bfhi(gg.z)); z.w = pk2(y[6] * bflo(gg.w), y[7] * bfhi(gg.w));
      *(uint4*)(p.Z + tok * 1024 + 256 + g * 64 + c0 + i8 * 8) = z;
    }
    ss += __shfl_xor(ss, 1);
    if ((tid & 1) == 0) p.ssq[tok * 16 + 4 + g] = ss;
  }
}


__device__ void gmlp_item(const Params& p, int l, int item2, unsigned char* smem0) {
  constexpr int GST = 136;
  const int tid512 = otid(), wg = tid512 >> 8;
  const int item = item2 * 2 + wg;
  unsigned char* smem = smem0 + wg * 24576;
  u16* vt = (u16*)smem;
  float* mu = (float*)(smem + 64 * GST * 2);
  float* rstd = mu + 128;
  float* red = rstd + 128;
  const int tid = tid512 & 255, lane = tid & 63, w = tid >> 6, r = lane & 31, h = lane >> 5;
  const int b = item >> 7, ch = item & 127, s0 = ch * 128;
  const u16* gv = p.Vt + (size_t)(1 * 2 + b) * 256 * VTLD + s0;
  const int lr = tid >> 4, lc = tid & 15;
  const int tk = tid & 127, half = tid >> 7;
  float s1 = 0.f, s2 = 0.f;
#pragma unroll 1
  for (int g = 0; g < 4; ++g) {
    __syncthreads();
    {
      uint4 tmp[4];
#pragma unroll
      for (int j = 0; j < 4; ++j) tmp[j] = *(const uint4*)(gv + (size_t)(g * 64 + lr + 16 * j) * VTLD + lc * 8);
#pragma unroll
      for (int j = 0; j < 4; ++j) *(uint4*)(vt + (lr + 16 * j) * GST + lc * 8) = tmp[j];
    }
    __syncthreads();
#pragma unroll 8
    for (int cc = 0; cc < 32; ++cc) { const float v = bf2f(vt[(half * 32 + cc) * GST + tk]); s1 += v; s2 += v * v; }
  }
  red[tid] = s1; red[256 + tid] = s2;
  __syncthreads();
  if (tid < 128) {
    const float a1 = red[tid] + red[tid + 128], a2 = red[256 + tid] + red[256 + tid + 128];
    const float mean = a1 * (1.f / 256.f);
    const float var = a2 * (1.f / 256.f) - mean * mean;
    mu[tid] = mean; rstd[tid] = rsqrtf(fmaxf(var, 0.f) + EPS);
  }
  __syncthreads();
  const float mm = mu[tk], rs = rstd[tk];
  const int t = 32 * w + r;
  const size_t tok = (size_t)b * SEQ + s0 + t;
  const int nks = 2 * (w + 1);
#pragma unroll 1
  for (int g = 0; g < 4; ++g) {
    __syncthreads();
    bf16x8 bw[8];
    {
      const u16* wrow = p.Ws16 + ((size_t)(l * 4 + g) * 128 + t) * 128 + 8 * h;
      uint4 tmp[4];
#pragma unroll
      for (int j = 0; j < 4; ++j) tmp[j] = *(const uint4*)(gv + (size_t)(g * 64 + lr + 16 * j) * VTLD + lc * 8);
#pragma unroll
      for (int ks = 0; ks < 8; ++ks) bw[ks] = *(const bf16x8*)(wrow + 16 * ks);
#pragma unroll
      for (int j = 0; j < 4; ++j) *(uint4*)(vt + (lr + 16 * j) * GST + lc * 8) = tmp[j];
    }
    __syncthreads();
    {
      const float* vg = p.v_gain + l * 256 + g * 64 + half * 32;
#pragma unroll 8
      for (int cc = 0; cc < 32; ++cc) {
        u16* q = vt + (half * 32 + cc) * GST + tk;
        *q = f2bf((bf2f(*q) - mm) * rs * vg[cc]);
      }
    }
    __syncthreads();
    f32x16 acc0, acc1;
#pragma unroll
    for (int i = 0; i < 16; ++i) { acc0[i] = 0.f; acc1[i] = 0.f; }
    uint2 uq[2][4], gq[2][4];
#pragma unroll
    for (int mt = 0; mt < 2; ++mt)
#pragma unroll
      for (int gi = 0; gi < 4; ++gi) {
        const int c = g * 64 + 32 * mt + 8 * gi + 4 * h;
        uq[mt][gi] = *(const uint2*)(p.P + tok * PC + BU + c);
        gq[mt][gi] = *(const uint2*)(p.P + tok * PC + BG + c);
      }
    const u16* a0p = vt + r * GST + 8 * h;
    const u16* a1p = a0p + 32 * GST;
#pragma unroll
    for (int ks = 0; ks < 8; ++ks) {
      const bf16x8 a0 = *(const bf16x8*)(a0p + 16 * ks), a1 = *(const bf16x8*)(a1p + 16 * ks);
      acc0 = MFMA(a0, bw[ks], acc0);
      acc1 = MFMA(a1, bw[ks], acc1);
    }
    const float bs = p.b_s[(size_t)(l * 4 + g) * 128 + t];
    float ss = 0.f;
#pragma unroll
    for (int mt = 0; mt < 2; ++mt)
#pragma unroll
      for (int gi = 0; gi < 4; ++gi) {
        const int c = g * 64 + 32 * mt + 8 * gi + 4 * h;
        const uint2 uu = uq[mt][gi];
        const uint2 gg = gq[mt][gi];
        float y[4];
        y[0] = bflo(uu.x) * ((mt ? acc1[4 * gi] : acc0[4 * gi]) + bs);
        y[1] = bfhi(uu.x) * ((mt ? acc1[4 * gi + 1] : acc0[4 * gi + 1]) + bs);
        y[2] = bflo(uu.y) * ((mt ? acc1[4 * gi + 2] : acc0[4 * gi + 2]) + bs);
        y[3] = bfhi(uu.y) * ((mt ? acc1[4 * gi + 3] : acc0[4 * gi + 3]) + bs);
        ss += y[0] * y[0] + y[1] * y[1] + y[2] * y[2] + y[3] * y[3];
        uint2 z;
        z.x = pk2(y[0] * bflo(gg.x), y[1] * bfhi(gg.x));
        z.y = pk2(y[2] * bflo(gg.y), y[3] * bfhi(gg.y));
        *(uint2*)(p.Z + ((size_t)(4 + g) * TT + tok) * 64 + (c & 63)) = z;
      }
    ss += __shfl_xor(ss, 32);
    if (h == 0) p.ssq[tok * 16 + 4 + g] = ss;
  }
}

#ifndef NAIVE_A
#define NAIVE_A 0
#endif
#ifndef NAIVE_C
#define NAIVE_C 0
#endif
#ifndef NAIVE_D
#define NAIVE_D 0
#endif
__device__ void phase_mix(const Params& p, int l, unsigned char* smem, int ctr_off, int only = -1) {
  __shared__ int s_item;
  unsigned* ctr = p.ctr + (ctr_off + l) * 8;
  constexpr int NITEMS = 512 + 512 + 512 + 128;
  (void)only;
  for (;;) {
    if (threadIdx.x == 0) s_item = (int)atomicAdd(ctr, 1u);
    __syncthreads();
    const int item = s_item;
    __syncthreads();
    if (item >= NITEMS) break;
    if (item < 128) {
      gmlp_item(p, l, item, smem);
    } else if (item < 640) {
      const int j = item - 128;
      attn_item<1>(p, l, j & 7, 63 - (j >> 3), smem);
    } else if (item < 1152) {
      const int j = item - 640;
      attn_item<0>(p, l, j & 7, j >> 3, smem);
    } else {
      const int j = item - 1152;
      attn_item<2>(p, l, j & 7, 63 - (j >> 3), smem);
    }
  }
}

DI void run_phase(const Params& p, int ph, unsigned char* smem) {
  if (ph == 0) { phase_pre(p, smem); return; }
  if (ph == 9) { phase_final(p); return; }
  const int l = (ph - 1) >> 2, s = (ph - 1) & 3;
  if (s == 0) phase_norm(p, l);
  else if (s == 1) phase_gemm_in(p, l, smem);
  else if (s == 2) phase_mix(p, l, smem, 0);
  else phase_gemm_out(p, l, smem);
}

#if !COOP
template <int KIND>
__global__ void __launch_bounds__(256, (KIND == 3) ? 1 : 2) mk_phase(Params p, int l) {
  __shared__ __attribute__((aligned(16))) unsigned char smem[SMEM_BYTES];
  if (KIND == 0) phase_pre(p, smem);
  else if (KIND == 1) phase_norm(p, l);
  else if (KIND == 2) phase_gemm_in(p, l, smem);
  else if (KIND == 3) phase_mix(p, l, smem, 0);
  else if (KIND == 4) phase_gemm_out(p, l, smem);
  else phase_final(p);
}
#endif

#if COOP

#define XB_TMO      128
#define XB_XCNT(j)  (256  + 64 * (j))
#define XB_XSUB(j)  (1280 + 64 * (j))
#define XB_XGEN(j)  (2304 + 64 * (j))
#define XB_TOP      3328
#define XB_TOPGEN   3392
#define XCD_BAR_WORDS 3456
#define XB_SPIN_CAP (1u << 18)
#define LAS __attribute__((address_space(3)))
DI unsigned xb_ld(unsigned* p) { return __hip_atomic_load(p, __ATOMIC_RELAXED, __HIP_MEMORY_SCOPE_AGENT); }
DI unsigned xb_add(unsigned* p, unsigned v) { return __hip_atomic_fetch_add(p, v, __ATOMIC_RELAXED, __HIP_MEMORY_SCOPE_AGENT); }
DI unsigned xb_xcc_id() { return (unsigned)__builtin_amdgcn_s_getreg((3 << 11) | 20) & 0xFu; }
#define XB_SPIN(cond, bar) do { unsigned _sp = 0; while (cond) { __builtin_amdgcn_s_sleep(1); \
    if ((++_sp & 255u) == 0u) { if (xb_ld(&(bar)[XB_TMO])) break; if (_sp > XB_SPIN_CAP) { atomicAdd(&(bar)[XB_TMO], 1u); break; } } } } while (0)
struct XcdBarrier { unsigned* bar; unsigned x; volatile LAS unsigned* st; };
DI XcdBarrier xcd_barrier_post(unsigned* bar, volatile LAS unsigned* st) {
  XcdBarrier b; b.bar = bar; b.x = xb_xcc_id(); b.st = st;
  if (threadIdx.x == 0) (void)xb_add(&bar[XB_XCNT(b.x)], 1u);
  return b;
}
DI void xcd_barrier_complete(unsigned* bar, unsigned x, unsigned& nloc, unsigned& nx) {
  const unsigned G = gridDim.x * gridDim.y * gridDim.z;
  unsigned sum, cnt, mine, sp = 0u;
  for (;;) {
    sum = 0u; cnt = 0u; mine = 0u;
#pragma unroll
    for (unsigned j = 0; j < 16; ++j) { const unsigned c = xb_ld(&bar[XB_XCNT(j)]); sum += c; cnt += (c > 0u) ? 1u : 0u; mine = (j == x) ? c : mine; }
    if (sum == G) break;
    __builtin_amdgcn_s_sleep(1);
    if ((++sp & 255u) == 0u) { if (xb_ld(&bar[XB_TMO])) break; if (sp > XB_SPIN_CAP) { atomicAdd(&bar[XB_TMO], 1u); break; } }
  }
  nloc = mine > 0u ? mine : 1u; nx = cnt > 0u ? cnt : 1u;
}
DI void xcd_barrier(const XcdBarrier& b) {
  asm volatile("s_waitcnt vmcnt(0)" ::: "memory");
  __syncthreads();
  if (threadIdx.x == 0) {
    unsigned* bar = b.bar;
    __builtin_amdgcn_s_waitcnt(0);
    unsigned nloc = b.st[0], nx = b.st[1];
    if (nloc == 0u) { xcd_barrier_complete(bar, b.x, nloc, nx); b.st[0] = nloc; b.st[1] = nx; }
    const unsigned old = xb_add(&bar[XB_XSUB(b.x)], 1u);
    const unsigned gen = old / nloc;
    if (old + 1u == (gen + 1u) * nloc) {
      __builtin_amdgcn_fence(__ATOMIC_RELEASE, "agent");
      asm volatile("s_waitcnt vmcnt(0)" ::: "memory");
      const unsigned og = xb_add(&bar[XB_TOP], 1u);
      const unsigned tg = og / nx;
      if (og + 1u == (tg + 1u) * nx) xb_add(&bar[XB_TOPGEN], 1u);
      else XB_SPIN(xb_ld(&bar[XB_TOPGEN]) == tg, bar);
      __builtin_amdgcn_fence(__ATOMIC_ACQUIRE, "agent");
      xb_add(&bar[XB_XGEN(b.x)], 1u);
      asm volatile("s_waitcnt vmcnt(0)" ::: "memory");
    } else {
      XB_SPIN(xb_ld(&bar[XB_XGEN(b.x)]) == gen, bar);
      __builtin_amdgcn_fence(__ATOMIC_ACQUIRE, "agent");
      asm volatile("s_waitcnt vmcnt(0)" ::: "memory");
    }
  }
  __syncthreads();
}

__global__ void __launch_bounds__(512, COOP_MINB) mk_coop(Params p) {
  __shared__ __attribute__((aligned(16))) unsigned char smem[SMEM_BYTES];
  __shared__ __attribute__((aligned(16))) unsigned xb_words[4];
  cg::grid_group grid = cg::this_grid();
  if (threadIdx.x < 4) xb_words[threadIdx.x] = 0u;
  __syncthreads();
  const XcdBarrier xb = xcd_barrier_post(p.bar, (volatile LAS unsigned*)xb_words);
  phase_pre(p, smem);
  grid.sync();
#pragma unroll 1
  for (int l = 0; l < 2; ++l) {
    phase_norm(p, l);
    xcd_barrier(xb);
#if PROBE_DUP == 3
    phase_norm(p, l);
    xcd_barrier(xb);
#endif
    phase_gemm_in(p, l, smem);
    xcd_barrier(xb);
#if PROBE_DUP == 1
    phase_gemm_in(p, l, smem);
    xcd_barrier(xb);
#endif
    phase_mix(p, l, smem, 0);
    xcd_barrier(xb);
#if PROBE_DUP == 2
    phase_mix(p, l, smem, 2, PROBE_ONLY);
    xcd_barrier(xb);
#endif
#if PROBE_DUP == 4
    if (l == 0) { phase_gemm_out(p, l, smem); xcd_barrier(xb); }
#endif
    phase_gemm_out(p, l, smem);
    xcd_barrier(xb);
  }
#if PROBE_DUP == 5
  for (int i = 0; i < 10; ++i) xcd_barrier(xb);
#endif
  phase_final(p);
}
#endif

extern "C" void kernel_launch(void* const* d_in, const int* in_sizes, int n_in, void* d_out, int out_size, void* d_ws,
                              size_t ws_size, hipStream_t stream) {
  Params p{};
  p.x = (const float*)d_in[0]; p.norm_g = (const float*)d_in[1]; p.w_in = (const float*)d_in[2]; p.b_f = (const float*)d_in[3];
  p.rel_bias = (const float*)d_in[4]; p.w_s = (const float*)d_in[5]; p.b_s = (const float*)d_in[6]; p.v_gain = (const float*)d_in[7];
  p.branch_gain = (const float*)d_in[8]; p.w_out = (const float*)d_in[9]; p.final_g = (const float*)d_in[10];
  p.out = (float*)d_out;
  unsigned char* ws = (unsigned char*)d_ws;
  size_t off = 0;
  auto carve = [&](size_t bytes) { unsigned char* q = ws + off; off += (bytes + 255) & ~(size_t)255; return q; };
  p.WtIn = (u16*)carve((size_t)2 * NW * 1024 * 2);
  p.WtOut = (u16*)carve((size_t)2 * 1024 * 1024 * 2);
  p.Ws16 = (u16*)carve((size_t)2 * 4 * 128 * 128 * 2);
  p.H = (u16*)carve((size_t)TT * 1024 * 2);
  p.P = (u16*)carve((size_t)TT * PC * 2);
  p.Vt = (u16*)carve((size_t)4 * 2 * 256 * VTLD * 2);
  p.Z = (u16*)carve((size_t)TT * 1024 * 2);
  p.lsf = (float*)carve((size_t)TT * 4 * 4);
  p.csum = (float*)carve((size_t)TT * 4 * 4);
  p.ssq = (float*)carve((size_t)TT * 16 * 4);
  p.ctot = (float*)carve(32 * 4 * 4);
  p.Wf = (float*)carve(2 * 1024 * 4 * 4);
  p.ctr = (unsigned*)carve(256);
  p.bar = (unsigned*)carve(XCD_BAR_WORDS * 4);
  static int grid_blocks = 0;
  if (!grid_blocks) {
    int dev = 0, cus = 0, per_cu = 0;
    hipGetDevice(&dev);
    hipDeviceGetAttribute(&cus, hipDeviceAttributeMultiprocessorCount, dev);
#if COOP
    hipOccupancyMaxActiveBlocksPerMultiprocessor(&per_cu, mk_coop, 256, 0);
#else
    hipOccupancyMaxActiveBlocksPerMultiprocessor(&per_cu, mk_phase<3>, 256, 0);
#endif
    (void)per_cu;
    grid_blocks = cus;
  }
#if COOP
  hipMemsetAsync(p.bar, 0, XCD_BAR_WORDS * 4, stream);
  void* args[] = {&p};
  hipError_t e = hipLaunchCooperativeKernel((void*)mk_coop, dim3(grid_blocks), dim3(512), args, 0, stream);
  if (e != hipSuccess) fprintf(stderr, "cooperative launch failed: %s (grid %d)\n", hipGetErrorString(e), grid_blocks);
#else
  mk_phase<0><<<grid_blocks, 256, 0, stream>>>(p, 0);
  for (int l = 0; l < 2; ++l) {
    mk_phase<1><<<grid_blocks, 256, 0, stream>>>(p, l);
    mk_phase<2><<<grid_blocks, 256, 0, stream>>>(p, l);
    mk_phase<3><<<grid_blocks, 256, 0, stream>>>(p, l);
    mk_phase<4><<<grid_blocks, 256, 0, stream>>>(p, l);
  }
  mk_phase<5><<<grid_blocks, 256, 0, stream>>>(p, 0);
#endif
}
```

```cpp
#include <hip/hip_runtime.h>
#include <hip/hip_cooperative_groups.h>
#include <cstdio>
namespace cg = cooperative_groups;

#ifndef COOP
#define COOP 1
#endif
#ifndef PROBE_ONLY
#define PROBE_ONLY 2
#endif
#ifndef PROBE_DUP
#define PROBE_DUP 0
#endif
#ifndef COOP_MINB
#define COOP_MINB 2
#endif

#define DI __device__ __forceinline__
typedef unsigned short u16;
typedef __attribute__((ext_vector_type(8))) short bf16x8;
typedef __attribute__((ext_vector_type(16))) float f32x16;
typedef __attribute__((ext_vector_type(2))) __bf16 bf16v2;
#define MFMA(a, b, c) __builtin_amdgcn_mfma_f32_32x32x16_bf16((a), (b), (c), 0, 0, 0)

constexpr int SEQ = 16384, TT = 32768, DM = 1024, NIN = 3844, NW = 3840, PC = 2816;
constexpr float EPS = 1e-6f, LOG2E = 1.4426950408889634f;
constexpr float QSCALE = 0.125f * LOG2E;
constexpr int AQ = 0, AK = 256, AG = 512, BU = 768, BG = 1024, CQ = 1280, CK = 1536, CG = 1792, DQ = 2048, DK = 2304, DG = 2560;
constexpr int SMEM_BYTES = 131072;
constexpr int NTHR = 512;
constexpr int VTLD = SEQ + 64;

struct Params {
  const float *x, *norm_g, *w_in, *b_f, *rel_bias, *w_s, *b_s, *v_gain, *branch_gain, *w_out, *final_g;
  float* out;
  u16 *WtIn, *WtOut, *Ws16, *H, *P, *Vt, *Z;
  float *lsf, *csum, *ssq, *ctot, *Wf;
  unsigned* ctr;
  unsigned* bar;
};

DI unsigned pk2(float a, float b) { bf16v2 v; v[0] = (__bf16)a; v[1] = (__bf16)b; return __builtin_bit_cast(unsigned, v); }
DI u16 f2bf(float a) { return __builtin_bit_cast(u16, (__bf16)a); }
DI float bf2f(u16 h) { return __uint_as_float(((unsigned)h) << 16); }
DI float bflo(unsigned u) { return __uint_as_float(u << 16); }
DI float bfhi(unsigned u) { return __uint_as_float(u & 0xffff0000u); }
DI int otid() { int t = threadIdx.x; asm volatile("" : "+v"(t)); return t; }
DI float wave_sum(float v) { for (int o = 32; o > 0; o >>= 1) v += __shfl_xor(v, o); return v; }

__device__ void phase_pre(const Params& p, unsigned char* smem) {
  float (*tile)[65] = (float (*)[65])smem;
  const int tid = otid(), tx = tid & 63, ty = tid >> 6;
  const int nA = 2 * 60 * 16, nB = 2 * 16 * 16;
  for (int it = blockIdx.x; it < nA + nB; it += gridDim.x) {
    const float* src; u16* dst; int ld_src, n0, k0, srcoff, nrows;
    if (it < nA) {
      int l = it / 960, rem = it % 960, ntile = rem / 16, ktile = rem % 16;
      n0 = ntile * 64; k0 = ktile * 64;
      src = p.w_in + (size_t)l * 1024 * NIN; ld_src = NIN; dst = p.WtIn + (size_t)l * NW * 1024; srcoff = (n0 >= 2816) ? 4 : 0; nrows = NW;
    } else {
      int j = it - nA; int l = j / 256, rem = j % 256, ntile = rem / 16, ktile = rem % 16;
      n0 = ntile * 64; k0 = ktile * 64;
      src = p.w_out + (size_t)l * 1024 * 1024; ld_src = 1024; dst = p.WtOut + (size_t)l * 1024 * 1024; srcoff = 0; nrows = 1024;
    }
    __syncthreads();
#pragma unroll 4
    for (int i = 0; i < 8; ++i) { int k = ty + 8 * i; tile[k][tx] = src[(size_t)(k0 + k) * ld_src + n0 + srcoff + tx]; }
    __syncthreads();
#pragma unroll 4
    for (int i = 0; i < 8; ++i) { int n = ty + 8 * i; dst[((size_t)(k0 >> 6) * nrows + n0 + n) * 64 + tx] = f2bf(tile[tx][n]); }
  }
  for (int idx = blockIdx.x * NTHR + tid; idx < 2 * 4 * 128 * 128; idx += gridDim.x * NTHR) {
    int t = (idx >> 7) & 127, s = idx & 127;
    p.Ws16[idx] = (s <= t) ? f2bf(p.w_s[idx]) : (u16)0;
  }
  for (int idx = blockIdx.x * NTHR + tid; idx < 2 * 1024; idx += gridDim.x * NTHR) {
    const int l = idx >> 10, k = idx & 1023;
    *(float4*)(p.Wf + (size_t)idx * 4) = *(const float4*)(p.w_in + ((size_t)l * 1024 + k) * NIN + 2816);
  }
  if (blockIdx.x == 0 && tid < 64) p.ctr[tid] = 0u;
}

__device__ void phase_norm(const Params& p, int l) {
  const float* src = (l == 0) ? p.x : p.out;
  const int tid_ = otid();
  const int lane = tid_ & 63;
  const int gw = blockIdx.x * 8 + (tid_ >> 6), nw = gridDim.x * 8;
  const float4* g4 = (const float4*)(p.norm_g + l * 1024);
  const float4* wf4 = (const float4*)(p.Wf + (size_t)l * 4096);
  float4 gr[4], w0[4], w1[4], w2[4], w3[4];
#pragma unroll
  for (int j = 0; j < 4; ++j) {
    const int k = 4 * (lane + 64 * j);
    gr[j] = g4[lane + 64 * j];
    w0[j] = wf4[k]; w1[j] = wf4[k + 1]; w2[j] = wf4[k + 2]; w3[j] = wf4[k + 3];
  }
  const float bf0 = p.b_f[l * 4 + 0], bf1 = p.b_f[l * 4 + 1], bf2 = p.b_f[l * 4 + 2], bf3 = p.b_f[l * 4 + 3];
  for (int row0 = gw * 4; row0 < TT; row0 += nw * 4) {
    float4 v[4][4]; float ss[4] = {0.f, 0.f, 0.f, 0.f};
#pragma unroll
    for (int q = 0; q < 4; ++q) {
      const float4* xr = (const float4*)(src + (size_t)(row0 + q) * 1024);
#pragma unroll
      for (int j = 0; j < 4; ++j) v[q][j] = xr[lane + 64 * j];
    }
#pragma unroll
    for (int q = 0; q < 4; ++q)
#pragma unroll
      for (int j = 0; j < 4; ++j) ss[q] += v[q][j].x * v[q][j].x + v[q][j].y * v[q][j].y + v[q][j].z * v[q][j].z + v[q][j].w * v[q][j].w;
    ss[0] = wave_sum(ss[0]); ss[1] = wave_sum(ss[1]); ss[2] = wave_sum(ss[2]); ss[3] = wave_sum(ss[3]);
#pragma unroll
    for (int q = 0; q < 4; ++q) {
      const int row = row0 + q;
      const float rinv = rsqrtf(ss[q] * (1.f / 1024.f) + EPS);
      float f0 = 0.f, f1 = 0.f, f2 = 0.f, f3 = 0.f;
#pragma unroll
      for (int j = 0; j < 4; ++j) {
        const float h0 = v[q][j].x * rinv * gr[j].x, h1 = v[q][j].y * rinv * gr[j].y, h2 = v[q][j].z * rinv * gr[j].z, h3 = v[q][j].w * rinv * gr[j].w;
        uint2 o; o.x = pk2(h0, h1); o.y = pk2(h2, h3);
        { const int col = 4 * (lane + 64 * j); *(uint2*)(p.H + ((size_t)(col >> 6) * TT + row) * 64 + (col & 63)) = o; }
        f0 += h0 * w0[j].x + h1 * w1[j].x + h2 * w2[j].x + h3 * w3[j].x;
        f1 += h0 * w0[j].y + h1 * w1[j].y + h2 * w2[j].y + h3 * w3[j].y;
        f2 += h0 * w0[j].z + h1 * w1[j].z + h2 * w2[j].z + h3 * w3[j].z;
        f3 += h0 * w0[j].w + h1 * w1[j].w + h2 * w2[j].w + h3 * w3[j].w;
      }
      f0 = wave_sum(f0); f1 = wave_sum(f1); f2 = wave_sum(f2); f3 = wave_sum(f3);
      if (lane == 0) {
        float4 o;
        o.x = f0 + bf0; o.y = f1 + bf1; o.z = f2 + bf2; o.w = f3 + bf3;
        o.x = (fminf(o.x, 0.f) - log1pf(expf(-fabsf(o.x)))) * LOG2E;
        o.y = (fminf(o.y, 0.f) - log1pf(expf(-fabsf(o.y)))) * LOG2E;
        o.z = (fminf(o.z, 0.f) - log1pf(expf(-fabsf(o.z)))) * LOG2E;
        o.w = (fminf(o.w, 0.f) - log1pf(expf(-fabsf(o.w)))) * LOG2E;
        *(float4*)(p.lsf + (size_t)row * 4) = o;
      }
    }
  }
}

__device__ void scan_chunk(const Params& p, int chunk, unsigned char* smem) {
  float4* wtot = (float4*)smem;
  const int tid = otid(), lane = tid & 63, w = tid >> 6;
  const bool act = tid < 256;
  const int ti = act ? tid : 0;
  const float4* in = (const float4*)p.lsf + (size_t)chunk * 1024 + ti * 4;
  float4 v0 = in[0], v1 = in[1], v2 = in[2], v3 = in[3];
  v1.x += v0.x; v1.y += v0.y; v1.z += v0.z; v1.w += v0.w;
  v2.x += v1.x; v2.y += v1.y; v2.z += v1.z; v2.w += v1.w;
  v3.x += v2.x; v3.y += v2.y; v3.z += v2.z; v3.w += v2.w;
  float4 inc = v3;
#pragma unroll
  for (int o = 1; o < 64; o <<= 1) {
    float4 n;
    n.x = __shfl_up(inc.x, o); n.y = __shfl_up(inc.y, o); n.z = __shfl_up(inc.z, o); n.w = __shfl_up(inc.w, o);
    if (lane >= o) { inc.x += n.x; inc.y += n.y; inc.z += n.z; inc.w += n.w; }
  }
  __syncthreads();
  if (act && lane == 63) wtot[w] = inc;
  __syncthreads();
  float4 pre = make_float4(inc.x - v3.x, inc.y - v3.y, inc.z - v3.z, inc.w - v3.w);
  float4 all = make_float4(0.f, 0.f, 0.f, 0.f);
#pragma unroll
  for (int i = 0; i < 4; ++i) {
    float4 t = wtot[i];
    if (i < w) { pre.x += t.x; pre.y += t.y; pre.z += t.z; pre.w += t.w; }
    all.x += t.x; all.y += t.y; all.z += t.z; all.w += t.w;
  }
  if (act) {
    float4* outp = (float4*)p.csum + (size_t)chunk * 1024 + tid * 4;
    outp[0] = make_float4(v0.x + pre.x, v0.y + pre.y, v0.z + pre.z, v0.w + pre.w);
    outp[1] = make_float4(v1.x + pre.x, v1.y + pre.y, v1.z + pre.z, v1.w + pre.w);
    outp[2] = make_float4(v2.x + pre.x, v2.y + pre.y, v2.z + pre.z, v2.w + pre.w);
    outp[3] = make_float4(v3.x + pre.x, v3.y + pre.y, v3.z + pre.z, v3.w + pre.w);
    if (tid == 0) ((float4*)p.ctot)[chunk] = all;
  }
  __syncthreads();
}

typedef u16 (*lds_tile_t)[72];
#define G_LOAD(A_, NR_, m0_, kt_, R_) do { const u16* gp_ = (A_) + ((size_t)(kt_) * (NR_) + (m0_) + (tid >> 3)) * 64 + (tid & 7) * 8; \
    R_##0 = *(const uint4*)gp_; R_##1 = *(const uint4*)(gp_ + 32 * 64); R_##2 = *(const uint4*)(gp_ + 64 * 64); R_##3 = *(const uint4*)(gp_ + 96 * 64); } while (0)
#define S_STORE(S_, R_) do { u16* sp_ = &(S_)[tid >> 3][(tid & 7) * 8]; \
    *(uint4*)sp_ = R_##0; *(uint4*)(sp_ + 32 * 72) = R_##1; *(uint4*)(sp_ + 64 * 72) = R_##2; *(uint4*)(sp_ + 96 * 72) = R_##3; } while (0)
template <bool SWAP>
DI void gemm_ktile(lds_tile_t As, lds_tile_t Bs, f32x16 (&acc)[2][2], int wm, int wn, int r, int h) {
  bf16x8 af[4][2], bfr[4][2];
  const u16* ap = &As[wm * 64 + r][h * 8];
  const u16* bp = &Bs[wn * 64 + r][h * 8];
#pragma unroll
  for (int ks = 0; ks < 4; ++ks) {
    af[ks][0] = *(const bf16x8*)(ap + ks * 16); af[ks][1] = *(const bf16x8*)(ap + 32 * 72 + ks * 16);
    bfr[ks][0] = *(const bf16x8*)(bp + ks * 16); bfr[ks][1] = *(const bf16x8*)(bp + 32 * 72 + ks * 16);
  }
  __builtin_amdgcn_sched_barrier(0);
#pragma unroll
  for (int ks = 0; ks < 4; ++ks)
#pragma unroll
    for (int mi = 0; mi < 2; ++mi)
#pragma unroll
      for (int ni = 0; ni < 2; ++ni)
        acc[mi][ni] = SWAP ? MFMA(bfr[ks][ni], af[ks][mi], acc[mi][ni]) : MFMA(af[ks][mi], bfr[ks][ni], acc[mi][ni]);
}

#define GL_STAGE(GA_, NRA_, m0_, GB_, NRB_, n0_, T32_, SBASE_) do { _Pragma("unroll") for (int j_ = 0; j_ < 2; ++j_) { \
    const int q_ = j_ * 512 + tid, rw_ = q_ >> 2, kc_ = (q_ & 3) ^ ((rw_ >> 2) & 3); \
    __builtin_amdgcn_global_load_lds((const unsigned*)((GA_) + ((size_t)((T32_) >> 1) * (NRA_) + (m0_) + rw_) * 64 + ((T32_) & 1) * 32 + kc_ * 8), \
        (__attribute__((address_space(3))) unsigned*)((SBASE_) + q_ * 16), 16, 0, 0); \
    __builtin_amdgcn_global_load_lds((const unsigned*)((GB_) + ((size_t)((T32_) >> 1) * (NRB_) + (n0_) + rw_) * 64 + ((T32_) & 1) * 32 + kc_ * 8), \
        (__attribute__((address_space(3))) unsigned*)((SBASE_) + 16384 + q_ * 16), 16, 0, 0); } } while (0)
#define GL_WAIT_BAR() do { asm volatile("s_waitcnt vmcnt(8)" ::: "memory"); __builtin_amdgcn_s_barrier(); asm volatile("" ::: "memory"); } while (0)
DI unsigned frag_addr(unsigned base, int row, int kc) { return base + row * 64 + ((kc ^ ((row >> 2) & 3)) << 4); }
template <bool SWAP>
DI void gemm_ktile32(const unsigned char* St, f32x16 (&acc)[4][2], int wm, int wn, int r, int h) {
  const unsigned sa = (unsigned)(size_t)St, sbb = sa + 16384;
  const int ra = wm * 128 + r, rb = wn * 64 + r;
  bf16x8 a0[4], a1[4], b0[2], b1[2];
  asm volatile(
      "ds_read_b128 %0, %6\n\tds_read_b128 %1, %7\n\tds_read_b128 %4, %10\n\tds_read_b128 %5, %11\n\t"
      "ds_read_b128 %2, %8\n\tds_read_b128 %3, %9\n\t"
      "s_waitcnt lgkmcnt(0)"
      : "=&v"(a0[0]), "=&v"(a0[1]), "=&v"(a0[2]), "=&v"(a0[3]), "=&v"(b0[0]), "=&v"(b0[1])
      : "v"(frag_addr(sa, ra, h)), "v"(frag_addr(sa, ra + 32, h)), "v"(frag_addr(sa, ra + 64, h)), "v"(frag_addr(sa, ra + 96, h)),
        "v"(frag_addr(sbb, rb, h)), "v"(frag_addr(sbb, rb + 32, h))
      : "memory");
  asm volatile(
      "ds_read_b128 %0, %6\n\tds_read_b128 %1, %7\n\tds_read_b128 %4, %10\n\tds_read_b128 %5, %11\n\t"
      "ds_read_b128 %2, %8\n\tds_read_b128 %3, %9"
      : "=&v"(a1[0]), "=&v"(a1[1]), "=&v"(a1[2]), "=&v"(a1[3]), "=&v"(b1[0]), "=&v"(b1[1])
      : "v"(frag_addr(sa, ra, 2 + h)), "v"(frag_addr(sa, ra + 32, 2 + h)), "v"(frag_addr(sa, ra + 64, 2 + h)), "v"(frag_addr(sa, ra + 96, 2 + h)),
        "v"(frag_addr(sbb, rb, 2 + h)), "v"(frag_addr(sbb, rb + 32, 2 + h))
      : "memory");
  __builtin_amdgcn_sched_barrier(0);
#pragma unroll
  for (int mi = 0; mi < 4; ++mi)
#pragma unroll
    for (int ni = 0; ni < 2; ++ni) acc[mi][ni] = SWAP ? MFMA(b0[ni], a0[mi], acc[mi][ni]) : MFMA(a0[mi], b0[ni], acc[mi][ni]);
  __builtin_amdgcn_sched_barrier(0);
  asm volatile("s_waitcnt lgkmcnt(0)"
               : "+v"(a1[0]), "+v"(a1[1]), "+v"(a1[2]), "+v"(a1[3]), "+v"(b1[0]), "+v"(b1[1]) : : "memory");
#pragma unroll
  for (int mi = 0; mi < 4; ++mi)
#pragma unroll
    for (int ni = 0; ni < 2; ++ni) acc[mi][ni] = SWAP ? MFMA(b1[ni], a1[mi], acc[mi][ni]) : MFMA(a1[mi], b1[ni], acc[mi][ni]);
}
typedef unsigned u32x2w __attribute__((ext_vector_type(2)));
DI uint4 widen_pair(uint2 ev, uint2 od) {
  const u32x2w a = __builtin_amdgcn_permlane32_swap(ev.x, od.x, false, false);
  const u32x2w b = __builtin_amdgcn_permlane32_swap(ev.y, od.y, false, false);
  return make_uint4(a[0], b[0], a[1], b[1]);
}
DI int sec_pcol(int s) { int nv = (s > 2) + (s > 5) + (s > 9) + (s > 13); return (s - nv) * 256; }
DI int sec_branch(int s) { return (s < 4) ? 0 : (s < 7) ? 1 : (s < 11) ? 2 : 3; }

template <bool SWAP>
DI void gemm_mainloop(const u16* A, const u16* B, int nrb, int m0, int n0, unsigned char* smem, f32x16 (&acc)[4][2]) {
  const int tid = otid(), lane = tid & 63, w = tid >> 6, wm = w >> 2, wn = w & 3, r = lane & 31, h = lane >> 5;
  GL_STAGE(A, TT, m0, B, nrb, n0, 0, smem);
  GL_STAGE(A, TT, m0, B, nrb, n0, 1, smem + 32768);
  GL_STAGE(A, TT, m0, B, nrb, n0, 2, smem + 65536);
#pragma unroll 1
  for (int t = 0; t < 32; ++t) {
    GL_WAIT_BAR();
    { const int t3 = min(t + 3, 31); GL_STAGE(A, TT, m0, B, nrb, n0, t3, smem + ((t + 3) & 3) * 32768); }
    gemm_ktile32<SWAP>(smem + (t & 3) * 32768, acc, wm, wn, r, h);
  }
  asm volatile("s_waitcnt vmcnt(0)" ::: "memory");
  __syncthreads();
}

__device__ void gemm_in_tile(const Params& p, int l, int mt, int sec, unsigned char* smem) {
  const int m0 = mt * 256, n0 = sec * 256;
  const bool is_vt = (sec == 2 || sec == 5 || sec == 9 || sec == 13);
  const bool is_q = (sec == 0 || sec == 7 || sec == 11);
  const bool is_gate = (sec == 3 || sec == 6 || sec == 10 || sec == 14);
  const int br = sec_branch(sec);
  const int tid = otid(), lane = tid & 63, w = tid >> 6, wm = w >> 2, wn = w & 3, r = lane & 31, h = lane >> 5;
  const u16* A = p.H;
  const u16* B = p.WtIn + (size_t)l * NW * 1024;
  f32x16 acc[4][2];
#pragma unroll
  for (int mi = 0; mi < 4; ++mi)
#pragma unroll
    for (int ni = 0; ni < 2; ++ni)
#pragma unroll
      for (int i = 0; i < 16; ++i) acc[mi][ni][i] = 0.f;
  if (is_vt) {
    gemm_mainloop<false>(A, B, NW, m0, n0, smem, acc);
#pragma unroll
    for (int mi = 0; mi < 4; ++mi)
#pragma unroll
      for (int ni = 0; ni < 2; ++ni) {
        const int c = wn * 64 + ni * 32 + r;
#pragma unroll
        for (int gp = 0; gp < 2; ++gp) {
          uint2 ev, od;
          ev.x = pk2(acc[mi][ni][8 * gp], acc[mi][ni][8 * gp + 1]); ev.y = pk2(acc[mi][ni][8 * gp + 2], acc[mi][ni][8 * gp + 3]);
          od.x = pk2(acc[mi][ni][8 * gp + 4], acc[mi][ni][8 * gp + 5]); od.y = pk2(acc[mi][ni][8 * gp + 6], acc[mi][ni][8 * gp + 7]);
          const uint4 o = widen_pair(ev, od);
          const int t0 = m0 + wm * 128 + mi * 32 + 8 * (2 * gp + h);
          const int b = t0 >> 14, sq = t0 & (SEQ - 1);
          *(uint4*)(p.Vt + ((size_t)(br * 2 + b) * 256 + c) * VTLD + sq) = o;
        }
      }
  } else {
    gemm_mainloop<true>(A, B, NW, m0, n0, smem, acc);
    const int pcol = sec_pcol(sec);
    const float* gain = p.branch_gain + (size_t)(l * 4 + br) * 256;
    if (sec == 8) {
      float mx2 = 0.f;
#pragma unroll
      for (int mi = 0; mi < 4; ++mi) {
        float n2 = 0.f;
#pragma unroll
        for (int ni = 0; ni < 2; ++ni)
#pragma unroll
          for (int i = 0; i < 16; ++i) n2 += acc[mi][ni][i] * acc[mi][ni][i];
        n2 += __shfl_xor(n2, 32);
        mx2 = fmaxf(mx2, n2);
      }
#pragma unroll
      for (int o = 16; o > 0; o >>= 1) mx2 = fmaxf(mx2, __shfl_xor(mx2, o));
      if (lane == 0) atomicMax(p.ctr + 48 + l * 8 + (m0 >> 14) * 4 + wn, __float_as_uint(mx2));
    }
#pragma unroll
    for (int mi = 0; mi < 4; ++mi)
#pragma unroll
      for (int ni = 0; ni < 2; ++ni) {
        const int t = m0 + wm * 128 + mi * 32 + r;
        uint2 og[4];
#pragma unroll
        for (int gi = 0; gi < 4; ++gi) {
          const int nl = wn * 64 + ni * 32 + 8 * gi + 4 * h;
          float v[4];
#pragma unroll
          for (int e = 0; e < 4; ++e) v[e] = acc[mi][ni][4 * gi + e];
          if (is_q) {
#pragma unroll
            for (int e = 0; e < 4; ++e) v[e] *= QSCALE;
          } else if (is_gate) {
            float4 gg = *(const float4*)(gain + nl);
            const float* gp = (const float*)&gg;
#pragma unroll
            for (int e = 0; e < 4; ++e) v[e] = gp[e] * v[e] / (1.f + __expf(-v[e]));
          }
          og[gi].x = pk2(v[0], v[1]); og[gi].y = pk2(v[2], v[3]);
        }
#pragma unroll
        for (int gp = 0; gp < 2; ++gp) {
          const uint4 o = widen_pair(og[2 * gp], og[2 * gp + 1]);
          const int nl8 = wn * 64 + ni * 32 + 8 * (2 * gp + h);
          *(uint4*)(p.P + (size_t)t * PC + pcol + nl8) = o;
        }
      }
  }
}

__device__ void phase_gemm_in(const Params& p, int l, unsigned char* smem) {
  for (int c = (int)gridDim.x - 1 - (int)blockIdx.x; c < 32; c += gridDim.x) scan_chunk(p, c, smem);
  const int xcd = blockIdx.x & 7, slot = blockIdx.x >> 3, nslot = gridDim.x >> 3;
  for (int j = slot; j < 240; j += nslot) {
    const int mg = j / 120, rem = j % 120;
    const int ng = (rem >= 96) ? 3 : (rem >> 5), idx = rem - ng * 32;
    const int mt = xcd * 16 + mg * 8 + (idx & 7), sec = ng * 4 + (idx >> 3);
    gemm_in_tile(p, l, mt, sec, smem);
  }
}

__device__ void gemm_out_tile(const Params& p, int l, int mt, int nt, unsigned char* smem) {
  const int m0 = mt * 256, n0 = nt * 256;
  const int tid = otid(), lane = tid & 63, w = tid >> 6, wm = w >> 2, wn = w & 3, r = lane & 31, h = lane >> 5;
  const u16* A = p.Z;
  const u16* B = p.WtOut + (size_t)l * 1024 * 1024;
  const float* resid = (l == 0) ? p.x : p.out;
  float fold[4][4];
#pragma unroll
  for (int mi = 0; mi < 4; ++mi) {
    const int t = m0 + wm * 128 + mi * 32 + r;
    float rv[4];
#pragma unroll
    for (int br = 0; br < 4; ++br) {
      float4 sq = *(const float4*)(p.ssq + (size_t)t * 16 + br * 4);
      rv[br] = rsqrtf((sq.x + sq.y + sq.z + sq.w) * (1.f / 256.f) + EPS);
    }
    fold[mi][0] = rv[0] / rv[1]; fold[mi][1] = rv[1] / rv[2]; fold[mi][2] = rv[2] / rv[3]; fold[mi][3] = rv[3];
  }
  f32x16 acc[4][2];
#pragma unroll
  for (int mi = 0; mi < 4; ++mi)
#pragma unroll
    for (int ni = 0; ni < 2; ++ni)
#pragma unroll
      for (int i = 0; i < 16; ++i) acc[mi][ni][i] = 0.f;
  GL_STAGE(A, TT, m0, B, 1024, n0, 0, smem);
  GL_STAGE(A, TT, m0, B, 1024, n0, 1, smem + 32768);
  GL_STAGE(A, TT, m0, B, 1024, n0, 2, smem + 65536);
#pragma unroll 1
  for (int t = 0; t < 32; ++t) {
    GL_WAIT_BAR();
    { const int t3 = min(t + 3, 31); GL_STAGE(A, TT, m0, B, 1024, n0, t3, smem + ((t + 3) & 3) * 32768); }
    gemm_ktile32<true>(smem + (t & 3) * 32768, acc, wm, wn, r, h);
    if ((t & 7) == 7) {
      const int br = t >> 3;
#pragma unroll
      for (int mi = 0; mi < 4; ++mi) {
        const float f = (br == 0) ? fold[mi][0] : (br == 1) ? fold[mi][1] : (br == 2) ? fold[mi][2] : fold[mi][3];
#pragma unroll
        for (int ni = 0; ni < 2; ++ni)
#pragma unroll
          for (int i = 0; i < 16; ++i) acc[mi][ni][i] *= f;
      }
    }
  }
  asm volatile("s_waitcnt vmcnt(0)" ::: "memory");
  __syncthreads();
#pragma unroll
  for (int mi = 0; mi < 4; ++mi)
#pragma unroll
    for (int ni = 0; ni < 2; ++ni) {
      const int t = m0 + wm * 128 + mi * 32 + r;
#pragma unroll
      for (int gi = 0; gi < 4; ++gi) {
        const int d = n0 + wn * 64 + ni * 32 + 8 * gi + 4 * h;
        float4 rs = *(const float4*)(resid + (size_t)t * 1024 + d);
        rs.x += acc[mi][ni][4 * gi]; rs.y += acc[mi][ni][4 * gi + 1]; rs.z += acc[mi][ni][4 * gi + 2]; rs.w += acc[mi][ni][4 * gi + 3];
        *(float4*)(p.out + (size_t)t * 1024 + d) = rs;
      }
    }
}

__device__ void phase_gemm_out(const Params& p, int l, unsigned char* smem) {
  const int xcd = blockIdx.x & 7, slot = blockIdx.x >> 3, nslot = gridDim.x >> 3;
  for (int j = slot; j < 64; j += nslot) {
    const int mg = j >> 5, idx = j & 31;
    gemm_out_tile(p, l, xcd * 16 + mg * 8 + (idx & 7), idx >> 3, smem);
  }
}

__device__ void phase_final(const Params& p) {
  const int tid_ = otid();
  const int lane = tid_ & 63;
  const int gw = blockIdx.x * 8 + (tid_ >> 6), nw = gridDim.x * 8;
  const float4* g4 = (const float4*)p.final_g;
  float4 gr[4];
#pragma unroll
  for (int j = 0; j < 4; ++j) gr[j] = g4[lane + 64 * j];
  for (int row0 = gw * 4; row0 < TT; row0 += nw * 4) {
    float4 v[4][4]; float ss[4] = {0.f, 0.f, 0.f, 0.f};
#pragma unroll
    for (int q = 0; q < 4; ++q) {
      const float4* xr = (const float4*)(p.out + (size_t)(row0 + q) * 1024);
#pragma unroll
      for (int j = 0; j < 4; ++j) v[q][j] = xr[lane + 64 * j];
    }
#pragma unroll
    for (int q = 0; q < 4; ++q)
#pragma unroll
      for (int j = 0; j < 4; ++j) ss[q] += v[q][j].x * v[q][j].x + v[q][j].y * v[q][j].y + v[q][j].z * v[q][j].z + v[q][j].w * v[q][j].w;
    ss[0] = wave_sum(ss[0]); ss[1] = wave_sum(ss[1]); ss[2] = wave_sum(ss[2]); ss[3] = wave_sum(ss[3]);
#pragma unroll
    for (int q = 0; q < 4; ++q) {
      float4* xr = (float4*)(p.out + (size_t)(row0 + q) * 1024);
      const float rinv = rsqrtf(ss[q] * (1.f / 1024.f) + EPS);
#pragma unroll
      for (int j = 0; j < 4; ++j) {
        float4 o; o.x = v[q][j].x * rinv * gr[j].x; o.y = v[q][j].y * rinv * gr[j].y; o.z = v[q][j].z * rinv * gr[j].z; o.w = v[q][j].w * rinv * gr[j].w;
        xr[lane + 64 * j] = o;
      }
    }
  }
}

template <int MODE>
__device__ void naive_attn_item(const Params& p, int l, int bh, int qb, unsigned char* smem) {
  float (*Ks)[64] = (float (*)[64])smem;
  float (*Vs)[64] = (float (*)[64])(smem + 16384);
  const int tid = otid(), b = bh >> 2, hh = bh & 3;
  const int qcol = MODE == 0 ? AQ : MODE == 1 ? CQ : DQ, kcol = MODE == 0 ? AK : MODE == 1 ? CK : DK, gcol = MODE == 0 ? AG : MODE == 1 ? CG : DG;
  const int br = MODE == 0 ? 0 : MODE == 1 ? 2 : 3;
  const int t = qb * 256 + tid;
  const size_t tok = (size_t)b * SEQ + t;
  unsigned q2[32]; float o[64];
#pragma unroll
  for (int d8 = 0; d8 < 8; ++d8) {
    uint4 u = *(const uint4*)(p.P + tok * PC + qcol + hh * 64 + d8 * 8);
    q2[d8 * 4 + 0] = u.x; q2[d8 * 4 + 1] = u.y; q2[d8 * 4 + 2] = u.z; q2[d8 * 4 + 3] = u.w;
  }
#pragma unroll
  for (int d = 0; d < 64; ++d) o[d] = 0.f;
  float m = -INFINITY, lsum = 0.f, carry = 0.f;
  const int hi = qb * 4 + 3;
  const int lo = (MODE == 0) ? max(0, qb * 4 - 8) : 0;
  const int c = t >> 6;
  const float* bias = p.rel_bias + (size_t)(l * 4 + hh) * 257;
  for (int kt = hi; kt >= lo; --kt) {
    __syncthreads();
#pragma unroll 4
    for (int i = 0; i < 16; ++i) {
      const int idx = tid + 256 * i, a = idx >> 6, bb = idx & 63;
      Ks[a][bb] = bf2f(p.P[((size_t)b * SEQ + kt * 64 + a) * PC + kcol + hh * 64 + bb]);
      Vs[bb][a] = bf2f(p.Vt[((size_t)(br * 2 + b) * 256 + hh * 64 + a) * SEQ + kt * 64 + bb]);
    }
    __syncthreads();
    bool tile_ok = true;
    if (MODE == 0) tile_ok = (kt >= c - 8) && (kt <= c);
    if (MODE != 0) tile_ok = (kt * 64 <= t);
    if (!tile_ok) continue;
    for (int j = 63; j >= 0; --j) {
      const int kpos = kt * 64 + j;
      if (MODE == 1 && kpos > t) continue;
      if (MODE == 2 && kpos >= t) continue;
      float dot = 0.f;
#pragma unroll
      for (int d = 0; d < 32; ++d) dot += bflo(q2[d]) * Ks[j][2 * d] + bfhi(q2[d]) * Ks[j][2 * d + 1];
      float pw;
      if (MODE == 2) {
        const float sp = __log2f(1.f + exp2f(dot));
        pw = exp2f(dot - sp - carry);
        carry += sp;
      } else {
        float u;
        if (MODE == 0) { int rel = min(max(t - kpos, -128), 128) + 128; u = dot + bias[rel] * LOG2E; }
        else u = dot - p.csum[((size_t)b * SEQ + kpos) * 4 + hh];
        if (u > m) {
          const float sc = exp2f(m - u);
          lsum *= sc;
#pragma unroll
          for (int d = 0; d < 64; ++d) o[d] *= sc;
          m = u;
        }
        pw = exp2f(u - m);
        lsum += pw;
      }
#pragma unroll
      for (int d = 0; d < 64; ++d) o[d] += pw * Vs[j][d];
    }
  }
  if (MODE != 2) {
    const float inv = 1.f / lsum;
#pragma unroll
    for (int d = 0; d < 64; ++d) o[d] *= inv;
  }
  float ss = 0.f;
#pragma unroll
  for (int d = 0; d < 64; ++d) ss += o[d] * o[d];
  p.ssq[tok * 16 + br * 4 + hh] = ss;
#pragma unroll
  for (int d8 = 0; d8 < 8; ++d8) {
    uint4 g = *(const uint4*)(p.P + tok * PC + gcol + hh * 64 + d8 * 8);
    uint4 z;
    z.x = pk2(o[d8 * 8 + 0] * bflo(g.x), o[d8 * 8 + 1] * bfhi(g.x));
    z.y = pk2(o[d8 * 8 + 2] * bflo(g.y), o[d8 * 8 + 3] * bfhi(g.y));
    z.z = pk2(o[d8 * 8 + 4] * bflo(g.z), o[d8 * 8 + 5] * bfhi(g.z));
    z.w = pk2(o[d8 * 8 + 6] * bflo(g.w), o[d8 * 8 + 7] * bfhi(g.w));
    *(uint4*)(p.Z + tok * 1024 + br * 256 + hh * 64 + d8 * 8) = z;
  }
}


typedef _Float16 f16x8 __attribute__((ext_vector_type(8)));
typedef _Float16 f16v2 __attribute__((ext_vector_type(2)));
typedef unsigned u32x4 __attribute__((ext_vector_type(4)));
#define MFMA_F16(a, b, c) __builtin_amdgcn_mfma_f32_32x32x16_f16((a), (b), (c), 0, 0, 0)
constexpr int KST = 88, VST = 68;
constexpr int STAGE_BYTES = 64 * KST * 2 + 64 * VST * 2;
constexpr int ATT_TAB_OFF = 2 * STAGE_BYTES;

DI int crow(int i, int h) { return (i & 3) + 8 * (i >> 2) + 4 * h; }
DI unsigned pkh2(float a, float b) { f16v2 v; v[0] = (_Float16)a; v[1] = (_Float16)b; return __builtin_bit_cast(unsigned, v); }
DI float ex2(float x) { return __builtin_amdgcn_exp2f(x); }
DI float lg2(float x) { return __builtin_amdgcn_logf(x); }

template <int MODE>
DI void attn_subtile(const u16* Kt, const u16* Vs, int st, bool diag, int r, int h, const bf16x8 (&qf)[4], bf16x8 qx,
                     const f16x8 (&uf)[2], const float* tab, int dist0, f32x16 (&O)[2], float& m, float& lsum, float& carry) {
  f32x16 s;
#pragma unroll
  for (int i = 0; i < 16; ++i) s[i] = 0.f;
  const u16* kp = Kt + (32 * st + r) * KST + 8 * h;
#pragma unroll
  for (int ks = 0; ks < 4; ++ks) s = MFMA(*(const bf16x8*)(kp + 16 * ks), qf[ks], s);
  if (MODE == 1) s = MFMA(*(const bf16x8*)(kp + 64), qx, s);
  f32x16 pv;
  if (MODE == 2) {
    f32x16 sp;
#pragma unroll
    for (int i = 0; i < 16; ++i) sp[i] = lg2(1.f + ex2(s[i]));
    if (diag) {
#pragma unroll
      for (int i = 0; i < 16; ++i) if (crow(i, h) >= r) sp[i] = 0.f;
    }
    u32x4 a0, a1;
#pragma unroll
    for (int j = 0; j < 4; ++j) { a0[j] = pkh2(sp[2 * j], sp[2 * j + 1]); a1[j] = pkh2(sp[8 + 2 * j], sp[8 + 2 * j + 1]); }
    f32x16 cs;
#pragma unroll
    for (int i = 0; i < 16; ++i) cs[i] = carry;
    cs = MFMA_F16(uf[0], __builtin_bit_cast(f16x8, a0), cs);
    cs = MFMA_F16(uf[1], __builtin_bit_cast(f16x8, a1), cs);
#pragma unroll
    for (int i = 0; i < 16; ++i) pv[i] = ex2(s[i] - cs[i]);
    if (diag) {
#pragma unroll
      for (int i = 0; i < 16; ++i) if (crow(i, h) >= r) pv[i] = 0.f;
    }
    carry = __shfl(cs[0], r);
  } else {
    if (MODE == 0) {
#pragma unroll
      for (int i = 0; i < 16; ++i) { int idx = min(max(dist0 - crow(i, h), -128), 128) + 128; s[i] += tab[idx]; }
    }
    if (MODE == 1 && diag) {
#pragma unroll
      for (int i = 0; i < 16; ++i) if (crow(i, h) > r) s[i] = -1e30f;
    }
    float mx = s[0];
#pragma unroll
    for (int i = 1; i < 16; ++i) mx = fmaxf(mx, s[i]);
    mx = fmaxf(mx, __shfl_xor(mx, 32));
    if (__any(mx > m)) {
      const float mn = fmaxf(m, mx);
      const float al = ex2(m - mn);
      m = mn; lsum *= al;
#pragma unroll
      for (int i = 0; i < 16; ++i) { O[0][i] *= al; O[1][i] *= al; }
    }
    float rs = 0.f;
#pragma unroll
    for (int i = 0; i < 16; ++i) { pv[i] = ex2(s[i] - m); rs += pv[i]; }
    lsum += rs;
  }
#pragma unroll
  for (int s2 = 0; s2 < 2; ++s2) {
    u32x4 pp;
#pragma unroll
    for (int j = 0; j < 4; ++j) pp[j] = pk2(pv[8 * s2 + 2 * j], pv[8 * s2 + 2 * j + 1]);
    const bf16x8 pf = __builtin_bit_cast(bf16x8, pp);
#pragma unroll
    for (int mt = 0; mt < 2; ++mt) {
      const u16* vp = Vs + (32 * mt + r) * VST + 32 * st + 16 * s2 + 4 * h;
      const uint2 v0 = *(const uint2*)vp, v1 = *(const uint2*)(vp + 8);
      u32x4 vv; vv[0] = v0.x; vv[1] = v0.y; vv[2] = v1.x; vv[3] = v1.y;
      O[mt] = MFMA(__builtin_bit_cast(bf16x8, vv), pf, O[mt]);
    }
  }
}


template <int MODE>
DI void attn_tile2(const u16* Kt, const u16* Vs, bool diag1, int r, int h, const bf16x8 (&qf)[4], bf16x8 qx,
                   const f16x8 (&uf)[2], const float* tab, int dist0, f32x16 (&O)[2], float& m, float& lsum, float& carry) {
  f32x16 s1, s0;
#pragma unroll
  for (int i = 0; i < 16; ++i) { s1[i] = 0.f; s0[i] = 0.f; }
  const u16* kp0 = Kt + r * KST + 8 * h;
  const u16* kp1 = kp0 + 32 * KST;
#pragma unroll
  for (int ks = 0; ks < 4; ++ks) {
    s1 = MFMA(*(const bf16x8*)(kp1 + 16 * ks), qf[ks], s1);
    s0 = MFMA(*(const bf16x8*)(kp0 + 16 * ks), qf[ks], s0);
  }
  if (MODE == 1) { s1 = MFMA(*(const bf16x8*)(kp1 + 64), qx, s1); s0 = MFMA(*(const bf16x8*)(kp0 + 64), qx, s0); }
  u32x4 vf1[2][2];
#pragma unroll
  for (int s2 = 0; s2 < 2; ++s2)
#pragma unroll
    for (int mt = 0; mt < 2; ++mt) {
      const u16* vp = Vs + (32 * mt + r) * VST + 32 + 16 * s2 + 4 * h;
      const uint2 v0 = *(const uint2*)vp, v1 = *(const uint2*)(vp + 8);
      vf1[s2][mt][0] = v0.x; vf1[s2][mt][1] = v0.y; vf1[s2][mt][2] = v1.x; vf1[s2][mt][3] = v1.y;
    }
  __builtin_amdgcn_sched_barrier(0);
  f32x16 p1, p0;
  if (MODE == 2) {
    f32x16 sp1, sp0;
#pragma unroll
    for (int i = 0; i < 16; ++i) { sp1[i] = lg2(1.f + ex2(s1[i])); sp0[i] = lg2(1.f + ex2(s0[i])); }
    if (diag1) {
#pragma unroll
      for (int i = 0; i < 16; ++i) if (crow(i, h) >= r) sp1[i] = 0.f;
    }
    u32x4 a10, a11, a00, a01;
#pragma unroll
    for (int j = 0; j < 4; ++j) {
      a10[j] = pkh2(sp1[2 * j], sp1[2 * j + 1]); a11[j] = pkh2(sp1[8 + 2 * j], sp1[8 + 2 * j + 1]);
      a00[j] = pkh2(sp0[2 * j], sp0[2 * j + 1]); a01[j] = pkh2(sp0[8 + 2 * j], sp0[8 + 2 * j + 1]);
    }
    f32x16 cs1, cs0;
#pragma unroll
    for (int i = 0; i < 16; ++i) { cs1[i] = carry; cs0[i] = carry; }
    cs1 = MFMA_F16(uf[0], __builtin_bit_cast(f16x8, a10), cs1);
    cs0 = MFMA_F16(uf[0], __builtin_bit_cast(f16x8, a00), cs0);
    cs1 = MFMA_F16(uf[1], __builtin_bit_cast(f16x8, a11), cs1);
    cs0 = MFMA_F16(uf[1], __builtin_bit_cast(f16x8, a01), cs0);
#pragma unroll
    for (int i = 0; i < 16; ++i) p1[i] = ex2(s1[i] - cs1[i]);
    if (diag1) {
#pragma unroll
      for (int i = 0; i < 16; ++i) if (crow(i, h) >= r) p1[i] = 0.f;
    }
    const float tot1 = __shfl(cs1[0], r) - carry;
#pragma unroll
    for (int i = 0; i < 16; ++i) p0[i] = ex2(s0[i] - tot1 - cs0[i]);
    carry = __shfl(cs0[0], r) + tot1;
  } else {
    if (MODE == 0) {
      if (diag1) {
        const float cb = tab[256];
#pragma unroll
        for (int i = 0; i < 16; ++i) { s1[i] += cb; s0[i] += cb; }
      } else {
#pragma unroll
        for (int i = 0; i < 16; ++i) {
          const int d0 = dist0 - crow(i, h);
          s1[i] += tab[min(max(d0 - 32, -128), 128) + 128];
          s0[i] += tab[min(max(d0, -128), 128) + 128];
        }
      }
    }
    if (MODE == 1 && diag1) {
#pragma unroll
      for (int i = 0; i < 16; ++i) if (crow(i, h) > r) s1[i] = -1e30f;
    }
    float mx = fmaxf(s1[0], s0[0]);
#pragma unroll
    for (int i = 1; i < 16; ++i) mx = fmaxf(mx, fmaxf(s1[i], s0[i]));
    mx = fmaxf(mx, __shfl_xor(mx, 32));
    if (__any(mx > m)) {
      const float mn = fmaxf(m, mx);
      const float al = ex2(m - mn);
      m = mn; lsum *= al;
#pragma unroll
      for (int i = 0; i < 16; ++i) { O[0][i] *= al; O[1][i] *= al; }
    }
    float rs1 = 0.f, rs0 = 0.f;
#pragma unroll
    for (int i = 0; i < 16; ++i) { p1[i] = ex2(s1[i] - m); rs1 += p1[i]; p0[i] = ex2(s0[i] - m); rs0 += p0[i]; }
    lsum += rs1 + rs0;
  }
  __builtin_amdgcn_sched_barrier(0);
  u32x4 vf0[2][2];
#pragma unroll
  for (int s2 = 0; s2 < 2; ++s2)
#pragma unroll
    for (int mt = 0; mt < 2; ++mt) {
      const u16* vp = Vs + (32 * mt + r) * VST + 16 * s2 + 4 * h;
      const uint2 v0 = *(const uint2*)vp, v1 = *(const uint2*)(vp + 8);
      vf0[s2][mt][0] = v0.x; vf0[s2][mt][1] = v0.y; vf0[s2][mt][2] = v1.x; vf0[s2][mt][3] = v1.y;
    }
#pragma unroll
  for (int s2 = 0; s2 < 2; ++s2) {
    u32x4 pp;
#pragma unroll
    for (int j = 0; j < 4; ++j) pp[j] = pk2(p1[8 * s2 + 2 * j], p1[8 * s2 + 2 * j + 1]);
    const bf16x8 pf = __builtin_bit_cast(bf16x8, pp);
    O[0] = MFMA(__builtin_bit_cast(bf16x8, vf1[s2][0]), pf, O[0]);
    O[1] = MFMA(__builtin_bit_cast(bf16x8, vf1[s2][1]), pf, O[1]);
  }
#pragma unroll
  for (int s2 = 0; s2 < 2; ++s2) {
    u32x4 pp;
#pragma unroll
    for (int j = 0; j < 4; ++j) pp[j] = pk2(p0[8 * s2 + 2 * j], p0[8 * s2 + 2 * j + 1]);
    const bf16x8 pf = __builtin_bit_cast(bf16x8, pp);
    O[0] = MFMA(__builtin_bit_cast(bf16x8, vf0[s2][0]), pf, O[0]);
    O[1] = MFMA(__builtin_bit_cast(bf16x8, vf0[s2][1]), pf, O[1]);
  }
}

template <int MODE>
__device__ void attn_item(const Params& p, int l, int bh, int qb, unsigned char* smem) {
  const int tid = otid(), lane = tid & 63, w = tid >> 6, r = lane & 31, h = lane >> 5;
  const int b = bh >> 2, hh = bh & 3;
  const int qcol = MODE == 0 ? AQ : MODE == 1 ? CQ : DQ, kcol = MODE == 0 ? AK : MODE == 1 ? CK : DK, gcol = MODE == 0 ? AG : MODE == 1 ? CG : DG;
  const int br = MODE == 0 ? 0 : MODE == 1 ? 2 : 3;
  const int q0 = qb * 256, qs0 = q0 + 32 * w, t = qs0 + r;
  const size_t tok = (size_t)b * SEQ + t;
  const int hi = 4 * qb + 3, lo = (MODE == 0) ? max(0, 4 * qb - 8) : 0;
  float* tab = (float*)(smem + ATT_TAB_OFF);

  bf16x8 qf[4];
#pragma unroll
  for (int ks = 0; ks < 4; ++ks) qf[ks] = *(const bf16x8*)(p.P + tok * PC + qcol + hh * 64 + 16 * ks + 8 * h);
  bf16x8 qx;
#pragma unroll
  for (int j = 0; j < 8; ++j) qx[j] = (h == 0 && j < 3) ? (short)0x3F80 : (short)0;
  f16x8 uf[2];
#pragma unroll
  for (int s2 = 0; s2 < 2; ++s2)
#pragma unroll
    for (int j = 0; j < 8; ++j) uf[s2][j] = ((16 * s2 + 8 * (j >> 2) + 4 * h + (j & 3)) >= r) ? (_Float16)1.f : (_Float16)0.f;
  float* coff = (float*)(smem + ATT_TAB_OFF + 1040);
  float cref = 0.f;
  float qk_bound = 0.f, cbn = 0.f, cbc = 0.f;
  if (MODE == 1) {
    float n2 = 0.f;
#pragma unroll
    for (int ks = 0; ks < 4; ++ks)
#pragma unroll
      for (int j = 0; j < 8; ++j) { const float v = bf2f((u16)qf[ks][j]); n2 += v * v; }
    n2 += __shfl_xor(n2, 32);
    const float k2 = __uint_as_float(__hip_atomic_load(p.ctr + 48 + l * 8 + bh, __ATOMIC_RELAXED, __HIP_MEMORY_SCOPE_AGENT));
    qk_bound = sqrtf(n2) * sqrtf(k2) * 1.02f + 1e-3f;
  }

  const int lrow = tid >> 3, lch = tid & 7;
  const u16* kbase = p.P + ((size_t)b * SEQ + lrow) * PC + kcol + hh * 64 + lch * 8;
  const u16* vbase = p.Vt + ((size_t)(br * 2 + b) * 256 + hh * 64 + lrow) * VTLD + lch * 8;
  constexpr int STG2 = 2 * STAGE_BYTES;
  float* tab2 = (float*)(smem + 2 * STG2);
  float* coff2 = tab2 + 260;
  const int csub = (tid >> 6) & 1, ckey = tid & 63;
  uint4 kr0, kr1, vr0, vr1; float cval = 0.f, coffv = 0.f;
#define ATT_LOAD(KT_) do { const int k0_ = (KT_) * 64; \
    kr0 = *(const uint4*)(kbase + (size_t)k0_ * PC); kr1 = *(const uint4*)(kbase + (size_t)(k0_ - 64) * PC); \
    vr0 = *(const uint4*)(vbase + k0_); vr1 = *(const uint4*)(vbase + k0_ - 64); \
    if (MODE == 1) { cbn = p.csum[((size_t)b * SEQ + k0_ - 64) * 4 + hh] + coff2[(k0_ - 64) >> 10]; } \
    if (MODE == 1 && tid < 128) { const int kk_ = k0_ - 64 * csub; cval = p.csum[((size_t)b * SEQ + kk_ + ckey) * 4 + hh]; coffv = coff2[kk_ >> 10]; } } while (0)
#define ATT_STORE(STG_) do { u16* Kt_ = (u16*)(smem + (STG_) * STG2); u16* Vs_ = Kt_ + 64 * KST; \
    u16* Kt1_ = (u16*)(smem + (STG_) * STG2 + STAGE_BYTES); u16* Vs1_ = Kt1_ + 64 * KST; \
    *(uint4*)(Kt_ + lrow * KST + lch * 8) = kr0; *(uint4*)(Kt1_ + lrow * KST + lch * 8) = kr1; \
    *(uint2*)(Vs_ + lrow * VST + lch * 8) = make_uint2(vr0.x, vr0.y); *(uint2*)(Vs_ + lrow * VST + lch * 8 + 4) = make_uint2(vr0.z, vr0.w); \
    *(uint2*)(Vs1_ + lrow * VST + lch * 8) = make_uint2(vr1.x, vr1.y); *(uint2*)(Vs1_ + lrow * VST + lch * 8 + 4) = make_uint2(vr1.z, vr1.w); \
    if (MODE == 1 && tid < 128) { const float val_ = cref - (cval + coffv); const u16 c1_ = f2bf(val_); const float r1_ = val_ - bf2f(c1_); \
      const u16 c2_ = f2bf(r1_); const u16 c3_ = f2bf(r1_ - bf2f(c2_)); \
      uint4 e0_; e0_.x = (unsigned)c1_ | ((unsigned)c2_ << 16); e0_.y = (unsigned)c3_; e0_.z = 0u; e0_.w = 0u; \
      u16* ke_ = (csub ? Kt1_ : Kt_) + ckey * KST + 64; \
      *(uint4*)ke_ = e0_; *(uint4*)(ke_ + 8) = make_uint4(0u, 0u, 0u, 0u); } } while (0)

  __syncthreads();
  if (MODE == 0) { for (int i = tid; i < 257; i += NTHR) tab2[i] = p.rel_bias[(size_t)(l * 4 + hh) * 257 + i] * LOG2E; }
  if (MODE == 1) {
    if (tid < 16) { float a = 0.f; for (int c = 0; c < tid; ++c) a += p.ctot[(b * 16 + c) * 4 + hh]; coff2[tid] = a; }
    __syncthreads();
    cref = p.csum[((size_t)b * SEQ + q0) * 4 + hh] + coff2[q0 >> 10];
  }
  ATT_LOAD(hi);
  ATT_STORE(0);
  cbc = cbn;
  ATT_LOAD(max(hi - 2, lo + 1));
  __syncthreads();

  f32x16 O[2];
#pragma unroll
  for (int i = 0; i < 16; ++i) { O[0][i] = 0.f; O[1][i] = 0.f; }
  float m = -1e30f, lsum = 0.f, carry = 0.f;
  int stage = 0;
  bool wdone = false;
  const int cw = qs0 >> 6;
#pragma unroll 1
  for (int kp = hi; kp > lo; kp -= 2) {
    const float cb_next = cbn;
    ATT_STORE(stage ^ 1);
    __builtin_amdgcn_sched_barrier(0);
    ATT_LOAD(max(kp - 4, lo + 1));
    __builtin_amdgcn_sched_barrier(0);
    if (!(MODE == 2 && wdone)) {
#pragma unroll
    for (int sub = 0; sub < 2; ++sub) {
      const int kt = kp - sub;
      const u16* Kt = (const u16*)(smem + stage * STG2 + sub * STAGE_BYTES);
      const u16* Vs = Kt + 64 * KST;
      const int k0 = kt * 64;
      if (MODE == 0) {
        if (kt <= cw && kt >= cw - 8) attn_tile2<0>(Kt, Vs, (qs0 - k0 - 63 >= 128), r, h, qf, qx, uf, tab2, t - k0, O, m, lsum, carry);
      } else {
        if (k0 + 32 <= qs0) attn_tile2<MODE>(Kt, Vs, (k0 + 32 == qs0), r, h, qf, qx, uf, tab2, 0, O, m, lsum, carry);
        else if (k0 <= qs0) attn_subtile<MODE>(Kt, Vs, 0, (k0 == qs0), r, h, qf, qx, uf, tab2, 0, O, m, lsum, carry);
      }
    }
    }
    if (MODE == 2) {
      wdone = __all(carry > 160.f) != 0;
      if (__syncthreads_and(wdone ? 1 : 0)) break;
    } else if (MODE == 1) {
      const bool z = (m > -1e29f) && (qk_bound + (cref - cbc) - m < -165.f);
      if (__syncthreads_and(__all(z) ? 1 : 0)) break;
      cbc = cb_next;
    } else {
      __syncthreads();
    }
    stage ^= 1;
  }
#undef ATT_LOAD
#undef ATT_STORE
  if (MODE != 2) {
    const float lt = lsum + __shfl_xor(lsum, 32);
    const float inv = 1.f / lt;
#pragma unroll
    for (int i = 0; i < 16; ++i) { O[0][i] *= inv; O[1][i] *= inv; }
  }
  float ss = 0.f;
#pragma unroll
  for (int i = 0; i < 16; ++i) ss += O[0][i] * O[0][i] + O[1][i] * O[1][i];
  ss += __shfl_xor(ss, 32);
  if (h == 0) p.ssq[tok * 16 + br * 4 + hh] = ss;
#pragma unroll
  for (int mt = 0; mt < 2; ++mt)
#pragma unroll
    for (int gi = 0; gi < 4; ++gi) {
      const int d0 = 32 * mt + 8 * gi + 4 * h;
      const uint2 g = *(const uint2*)(p.P + tok * PC + gcol + hh * 64 + d0);
      uint2 z;
      z.x = pk2(O[mt][4 * gi] * bflo(g.x), O[mt][4 * gi + 1] * bfhi(g.x));
      z.y = pk2(O[mt][4 * gi + 2] * bflo(g.y), O[mt][4 * gi + 3] * bfhi(g.y));
      *(uint2*)(p.Z + ((size_t)(br * 4 + hh) * TT + tok) * 64 + d0) = z;
    }
}

__device__ void naive_gmlp_item(const Params& p, int l, int item, unsigned char* smem) {
  float (*vn)[64] = (float (*)[64])smem;
  float* mu = (float*)(smem + 32768);
  float* rstd = mu + 128;
  float* red = rstd + 128;
  const int tid = otid(), b = item >> 7, ch = item & 127, s0 = ch * 128;
  const u16* vt = p.Vt + (size_t)(1 * 2 + b) * 256 * SEQ;
  {
    const int tkn = tid & 127, half = tid >> 7;
    float s1 = 0.f, s2 = 0.f;
    for (int cc = 0; cc < 128; ++cc) { float v = bf2f(vt[(size_t)(half * 128 + cc) * SEQ + s0 + tkn]); s1 += v; s2 += v * v; }
    __syncthreads();
    red[tid] = s1; red[256 + tid] = s2;
    __syncthreads();
    if (tid < 128) {
      float a1 = red[tid] + red[tid + 128], a2 = red[256 + tid] + red[256 + tid + 128];
      float mean = a1 * (1.f / 256.f);
      float var = a2 * (1.f / 256.f) - mean * mean;
      mu[tid] = mean; rstd[tid] = rsqrtf(fmaxf(var, 0.f) + EPS);
    }
    __syncthreads();
  }
  const int tkn = tid >> 1, c0 = (tid & 1) * 32;
  const size_t tok = (size_t)b * SEQ + s0 + tkn;
  for (int g = 0; g < 4; ++g) {
    __syncthreads();
    for (int i = 0; i < 32; ++i) {
      const int idx = tid + 256 * i, cc = idx >> 7, s = idx & 127;
      float v = bf2f(vt[(size_t)(g * 64 + cc) * SEQ + s0 + s]);
      vn[s][cc] = (v - mu[s]) * rstd[s] * p.v_gain[l * 256 + g * 64 + cc];
    }
    __syncthreads();
    float acc[32];
#pragma unroll
    for (int i = 0; i < 32; ++i) acc[i] = 0.f;
    const float* wrow = p.w_s + ((size_t)(l * 4 + g) * 128 + tkn) * 128;
    for (int s = 0; s <= tkn; ++s) {
      const float wv = wrow[s];
#pragma unroll
      for (int i = 0; i < 32; ++i) acc[i] += wv * vn[s][c0 + i];
    }
    const float bs = p.b_s[(size_t)(l * 4 + g) * 128 + tkn];
    float ss = 0.f;
#pragma unroll
    for (int i8 = 0; i8 < 4; ++i8) {
      uint4 uu = *(const uint4*)(p.P + tok * PC + BU + g * 64 + c0 + i8 * 8);
      uint4 gg = *(const uint4*)(p.P + tok * PC + BG + g * 64 + c0 + i8 * 8);
      float y[8];
      y[0] = bflo(uu.x) * (acc[i8 * 8 + 0] + bs); y[1] = bfhi(uu.x) * (acc[i8 * 8 + 1] + bs);
      y[2] = bflo(uu.y) * (acc[i8 * 8 + 2] + bs); y[3] = bfhi(uu.y) * (acc[i8 * 8 + 3] + bs);
      y[4] = bflo(uu.z) * (acc[i8 * 8 + 4] + bs); y[5] = bfhi(uu.z) * (acc[i8 * 8 + 5] + bs);
      y[6] = bflo(uu.w) * (acc[i8 * 8 + 6] + bs); y[7] = bfhi(uu.w) * (acc[i8 * 8 + 7] + bs);
#pragma unroll
      for (int e = 0; e < 8; ++e) ss += y[e] * y[e];
      uint4 z;
      z.x = pk2(y[0] * bflo(gg.x), y[1] * bfhi(gg.x)); z.y = pk2(y[2] * bflo(gg.y), y[3] * bfhi(gg.y));
      z.z = pk2(y[4] * bflo(gg.z), y[5] * bfhi(gg.z)); z.w = pk2(y[6] * bflo(gg.w), y[7] * bfhi(gg.w));
      *(uint4*)(p.Z + tok * 1024 + 256 + g * 64 + c0 + i8 * 8) = z;
    }
    ss += __shfl_xor(ss, 1);
    if ((tid & 1) == 0) p.ssq[tok * 16 + 4 + g] = ss;
  }
}


__device__ void gmlp_item(const Params& p, int l, int item2, unsigned char* smem0) {
  constexpr int GST = 136;
  const int tid512 = otid(), wg = tid512 >> 8;
  const int item = item2 * 2 + wg;
  unsigned char* smem = smem0 + wg * 24576;
  u16* vt = (u16*)smem;
  float* mu = (float*)(smem + 64 * GST * 2);
  float* rstd = mu + 128;
  float* red = rstd + 128;
  const int tid = tid512 & 255, lane = tid & 63, w = tid >> 6, r = lane & 31, h = lane >> 5;
  const int b = item >> 7, ch = item & 127, s0 = ch * 128;
  const u16* gv = p.Vt + (size_t)(1 * 2 + b) * 256 * VTLD + s0;
  const int lr = tid >> 4, lc = tid & 15;
  const int tk = tid & 127, half = tid >> 7;
  float s1 = 0.f, s2 = 0.f;
#pragma unroll 1
  for (int g = 0; g < 4; ++g) {
    __syncthreads();
    {
      uint4 tmp[4];
#pragma unroll
      for (int j = 0; j < 4; ++j) tmp[j] = *(const uint4*)(gv + (size_t)(g * 64 + lr + 16 * j) * VTLD + lc * 8);
#pragma unroll
      for (int j = 0; j < 4; ++j) *(uint4*)(vt + (lr + 16 * j) * GST + lc * 8) = tmp[j];
    }
    __syncthreads();
#pragma unroll 8
    for (int cc = 0; cc < 32; ++cc) { const float v = bf2f(vt[(half * 32 + cc) * GST + tk]); s1 += v; s2 += v * v; }
  }
  red[tid] = s1; red[256 + tid] = s2;
  __syncthreads();
  if (tid < 128) {
    const float a1 = red[tid] + red[tid + 128], a2 = red[256 + tid] + red[256 + tid + 128];
    const float mean = a1 * (1.f / 256.f);
    const float var = a2 * (1.f / 256.f) - mean * mean;
    mu[tid] = mean; rstd[tid] = rsqrtf(fmaxf(var, 0.f) + EPS);
  }
  __syncthreads();
  const float mm = mu[tk], rs = rstd[tk];
  const int t = 32 * w + r;
  const size_t tok = (size_t)b * SEQ + s0 + t;
  const int nks = 2 * (w + 1);
#pragma unroll 1
  for (int g = 0; g < 4; ++g) {
    __syncthreads();
    bf16x8 bw[8];
    {
      const u16* wrow = p.Ws16 + ((size_t)(l * 4 + g) * 128 + t) * 128 + 8 * h;
      uint4 tmp[4];
#pragma unroll
      for (int j = 0; j < 4; ++j) tmp[j] = *(const uint4*)(gv + (size_t)(g * 64 + lr + 16 * j) * VTLD + lc * 8);
#pragma unroll
      for (int ks = 0; ks < 8; ++ks) bw[ks] = *(const bf16x8*)(wrow + 16 * ks);
#pragma unroll
      for (int j = 0; j < 4; ++j) *(uint4*)(vt + (lr + 16 * j) * GST + lc * 8) = tmp[j];
    }
    __syncthreads();
    {
      const float* vg = p.v_gain + l * 256 + g * 64 + half * 32;
#pragma unroll 8
      for (int cc = 0; cc < 32; ++cc) {
        u16* q = vt + (half * 32 + cc) * GST + tk;
        *q = f2bf((bf2f(*q) - mm) * rs * vg[cc]);
      }
    }
    __syncthreads();
    f32x16 acc0, acc1;
#pragma unroll
    for (int i = 0; i < 16; ++i) { acc0[i] = 0.f; acc1[i] = 0.f; }
    const u16* a0p = vt + r * GST + 8 * h;
    const u16* a1p = a0p + 32 * GST;
#pragma unroll
    for (int ks = 0; ks < 8; ++ks) {
      const bf16x8 a0 = *(const bf16x8*)(a0p + 16 * ks), a1 = *(const bf16x8*)(a1p + 16 * ks);
      acc0 = MFMA(a0, bw[ks], acc0);
      acc1 = MFMA(a1, bw[ks], acc1);
    }
    const float bs = p.b_s[(size_t)(l * 4 + g) * 128 + t];
    float ss = 0.f;
#pragma unroll
    for (int mt = 0; mt < 2; ++mt)
#pragma unroll
      for (int gi = 0; gi < 4; ++gi) {
        const int c = g * 64 + 32 * mt + 8 * gi + 4 * h;
        const uint2 uu = *(const uint2*)(p.P + tok * PC + BU + c);
        const uint2 gg = *(const uint2*)(p.P + tok * PC + BG + c);
        float y[4];
        y[0] = bflo(uu.x) * ((mt ? acc1[4 * gi] : acc0[4 * gi]) + bs);
        y[1] = bfhi(uu.x) * ((mt ? acc1[4 * gi + 1] : acc0[4 * gi + 1]) + bs);
        y[2] = bflo(uu.y) * ((mt ? acc1[4 * gi + 2] : acc0[4 * gi + 2]) + bs);
        y[3] = bfhi(uu.y) * ((mt ? acc1[4 * gi + 3] : acc0[4 * gi + 3]) + bs);
        ss += y[0] * y[0] + y[1] * y[1] + y[2] * y[2] + y[3] * y[3];
        uint2 z;
        z.x = pk2(y[0] * bflo(gg.x), y[1] * bfhi(gg.x));
        z.y = pk2(y[2] * bflo(gg.y), y[3] * bfhi(gg.y));
        *(uint2*)(p.Z + ((size_t)(4 + g) * TT + tok) * 64 + (c & 63)) = z;
      }
    ss += __shfl_xor(ss, 32);
    if (h == 0) p.ssq[tok * 16 + 4 + g] = ss;
  }
}

#ifndef NAIVE_A
#define NAIVE_A 0
#endif
#ifndef NAIVE_C
#define NAIVE_C 0
#endif
#ifndef NAIVE_D
#define NAIVE_D 0
#endif
__device__ void phase_mix(const Params& p, int l, unsigned char* smem, int ctr_off, int only = -1) {
  __shared__ int s_item;
  unsigned* ctr = p.ctr + (ctr_off + l) * 8;
  constexpr int NITEMS = 512 + 512 + 512 + 128;
  (void)only;
  for (;;) {
    if (threadIdx.x == 0) s_item = (int)atomicAdd(ctr, 1u);
    __syncthreads();
    const int item = s_item;
    __syncthreads();
    if (item >= NITEMS) break;
    if (item < 128) {
      gmlp_item(p, l, item, smem);
    } else if (item < 640) {
      const int j = item - 128;
      attn_item<1>(p, l, j & 7, 63 - (j >> 3), smem);
    } else if (item < 1152) {
      const int j = item - 640;
      attn_item<0>(p, l, j & 7, j >> 3, smem);
    } else {
      const int j = item - 1152;
      attn_item<2>(p, l, j & 7, 63 - (j >> 3), smem);
    }
  }
}

DI void run_phase(const Params& p, int ph, unsigned char* smem) {
  if (ph == 0) { phase_pre(p, smem); return; }
  if (ph == 9) { phase_final(p); return; }
  const int l = (ph - 1) >> 2, s = (ph - 1) & 3;
  if (s == 0) phase_norm(p, l);
  else if (s == 1) phase_gemm_in(p, l, smem);
  else if (s == 2) phase_mix(p, l, smem, 0);
  else phase_gemm_out(p, l, smem);
}

#if !COOP
template <int KIND>
__global__ void __launch_bounds__(256, (KIND == 3) ? 1 : 2) mk_phase(Params p, int l) {
  __shared__ __attribute__((aligned(16))) unsigned char smem[SMEM_BYTES];
  if (KIND == 0) phase_pre(p, smem);
  else if (KIND == 1) phase_norm(p, l);
  else if (KIND == 2) phase_gemm_in(p, l, smem);
  else if (KIND == 3) phase_mix(p, l, smem, 0);
  else if (KIND == 4) phase_gemm_out(p, l, smem);
  else phase_final(p);
}
#endif

#if COOP

#define XB_TMO      128
#define XB_XCNT(j)  (256  + 64 * (j))
#define XB_XSUB(j)  (1280 + 64 * (j))
#define XB_XGEN(j)  (2304 + 64 * (j))
#define XB_TOP      3328
#define XB_TOPGEN   3392
#define XCD_BAR_WORDS 3456
#define XB_SPIN_CAP (1u << 18)
#define LAS __attribute__((address_space(3)))
DI unsigned xb_ld(unsigned* p) { return __hip_atomic_load(p, __ATOMIC_RELAXED, __HIP_MEMORY_SCOPE_AGENT); }
DI unsigned xb_add(unsigned* p, unsigned v) { return __hip_atomic_fetch_add(p, v, __ATOMIC_RELAXED, __HIP_MEMORY_SCOPE_AGENT); }
DI unsigned xb_xcc_id() { return (unsigned)__builtin_amdgcn_s_getreg((3 << 11) | 20) & 0xFu; }
#define XB_SPIN(cond, bar) do { unsigned _sp = 0; while (cond) { __builtin_amdgcn_s_sleep(1); \
    if ((++_sp & 255u) == 0u) { if (xb_ld(&(bar)[XB_TMO])) break; if (_sp > XB_SPIN_CAP) { atomicAdd(&(bar)[XB_TMO], 1u); break; } } } } while (0)
struct XcdBarrier { unsigned* bar; unsigned x; volatile LAS unsigned* st; };
DI XcdBarrier xcd_barrier_post(unsigned* bar, volatile LAS unsigned* st) {
  XcdBarrier b; b.bar = bar; b.x = xb_xcc_id(); b.st = st;
  if (threadIdx.x == 0) (void)xb_add(&bar[XB_XCNT(b.x)], 1u);
  return b;
}
DI void xcd_barrier_complete(unsigned* bar, unsigned x, unsigned& nloc, unsigned& nx) {
  const unsigned G = gridDim.x * gridDim.y * gridDim.z;
  unsigned sum, cnt, mine, sp = 0u;
  for (;;) {
    sum = 0u; cnt = 0u; mine = 0u;
#pragma unroll
    for (unsigned j = 0; j < 16; ++j) { const unsigned c = xb_ld(&bar[XB_XCNT(j)]); sum += c; cnt += (c > 0u) ? 1u : 0u; mine = (j == x) ? c : mine; }
    if (sum == G) break;
    __builtin_amdgcn_s_sleep(1);
    if ((++sp & 255u) == 0u) { if (xb_ld(&bar[XB_TMO])) break; if (sp > XB_SPIN_CAP) { atomicAdd(&bar[XB_TMO], 1u); break; } }
  }
  nloc = mine > 0u ? mine : 1u; nx = cnt > 0u ? cnt : 1u;
}
DI void xcd_barrier(const XcdBarrier& b) {
  asm volatile("s_waitcnt vmcnt(0)" ::: "memory");
  __syncthreads();
  if (threadIdx.x == 0) {
    unsigned* bar = b.bar;
    __builtin_amdgcn_s_waitcnt(0);
    unsigned nloc = b.st[0], nx = b.st[1];
    if (nloc == 0u) { xcd_barrier_complete(bar, b.x, nloc, nx); b.st[0] = nloc; b.st[1] = nx; }
    const unsigned old = xb_add(&bar[XB_XSUB(b.x)], 1u);
    const unsigned gen = old / nloc;
    if (old + 1u == (gen + 1u) * nloc) {
      __builtin_amdgcn_fence(__ATOMIC_RELEASE, "agent");
      asm volatile("s_waitcnt vmcnt(0)" ::: "memory");
      const unsigned og = xb_add(&bar[XB_TOP], 1u);
      const unsigned tg = og / nx;
      if (og + 1u == (tg + 1u) * nx) xb_add(&bar[XB_TOPGEN], 1u);
      else XB_SPIN(xb_ld(&bar[XB_TOPGEN]) == tg, bar);
      __builtin_amdgcn_fence(__ATOMIC_ACQUIRE, "agent");
      xb_add(&bar[XB_XGEN(b.x)], 1u);
      asm volatile("s_waitcnt vmcnt(0)" ::: "memory");
    } else {
      XB_SPIN(xb_ld(&bar[XB_XGEN(b.x)]) == gen, bar);
      __builtin_amdgcn_fence(__ATOMIC_ACQUIRE, "agent");
      asm volatile("s_waitcnt vmcnt(0)" ::: "memory");
    }
  }
  __syncthreads();
}

__global__ void __launch_bounds__(512, COOP_MINB) mk_coop(Params p) {
  __shared__ __attribute__((aligned(16))) unsigned char smem[SMEM_BYTES];
  __shared__ __attribute__((aligned(16))) unsigned xb_words[4];
  cg::grid_group grid = cg::this_grid();
  if (threadIdx.x < 4) xb_words[threadIdx.x] = 0u;
  __syncthreads();
  const XcdBarrier xb = xcd_barrier_post(p.bar, (volatile LAS unsigned*)xb_words);
  phase_pre(p, smem);
  grid.sync();
#pragma unroll 1
  for (int l = 0; l < 2; ++l) {
    phase_norm(p, l);
    xcd_barrier(xb);
#if PROBE_DUP == 3
    phase_norm(p, l);
    xcd_barrier(xb);
#endif
    phase_gemm_in(p, l, smem);
    xcd_barrier(xb);
#if PROBE_DUP == 1
    phase_gemm_in(p, l, smem);
    xcd_barrier(xb);
#endif
    phase_mix(p, l, smem, 0);
    xcd_barrier(xb);
#if PROBE_DUP == 2
    phase_mix(p, l, smem, 2, PROBE_ONLY);
    xcd_barrier(xb);
#endif
#if PROBE_DUP == 4
    if (l == 0) { phase_gemm_out(p, l, smem); xcd_barrier(xb); }
#endif
    phase_gemm_out(p, l, smem);
    xcd_barrier(xb);
  }
#if PROBE_DUP == 5
  for (int i = 0; i < 10; ++i) xcd_barrier(xb);
#endif
  phase_final(p);
}
#endif

extern "C" void kernel_launch(void* const* d_in, const int* in_sizes, int n_in, void* d_out, int out_size, void* d_ws,
                              size_t ws_size, hipStream_t stream) {
  Params p{};
  p.x = (const float*)d_in[0]; p.norm_g = (const float*)d_in[1]; p.w_in = (const float*)d_in[2]; p.b_f = (const float*)d_in[3];
  p.rel_bias = (const float*)d_in[4]; p.w_s = (const float*)d_in[5]; p.b_s = (const float*)d_in[6]; p.v_gain = (const float*)d_in[7];
  p.branch_gain = (const float*)d_in[8]; p.w_out = (const float*)d_in[9]; p.final_g = (const float*)d_in[10];
  p.out = (float*)d_out;
  unsigned char* ws = (unsigned char*)d_ws;
  size_t off = 0;
  auto carve = [&](size_t bytes) { unsigned char* q = ws + off; off += (bytes + 255) & ~(size_t)255; return q; };
  p.WtIn = (u16*)carve((size_t)2 * NW * 1024 * 2);
  p.WtOut = (u16*)carve((size_t)2 * 1024 * 1024 * 2);
  p.Ws16 = (u16*)carve((size_t)2 * 4 * 128 * 128 * 2);
  p.H = (u16*)carve((size_t)TT * 1024 * 2);
  p.P = (u16*)carve((size_t)TT * PC * 2);
  p.Vt = (u16*)carve((size_t)4 * 2 * 256 * VTLD * 2);
  p.Z = (u16*)carve((size_t)TT * 1024 * 2);
  p.lsf = (float*)carve((size_t)TT * 4 * 4);
  p.csum = (float*)carve((size_t)TT * 4 * 4);
  p.ssq = (float*)carve((size_t)TT * 16 * 4);
  p.ctot = (float*)carve(32 * 4 * 4);
  p.Wf = (float*)carve(2 * 1024 * 4 * 4);
  p.ctr = (unsigned*)carve(256);
  p.bar = (unsigned*)carve(XCD_BAR_WORDS * 4);
  static int grid_blocks = 0;
  if (!grid_blocks) {
    int dev = 0, cus = 0, per_cu = 0;
    hipGetDevice(&dev);
    hipDeviceGetAttribute(&cus, hipDeviceAttributeMultiprocessorCount, dev);
#if COOP
    hipOccupancyMaxActiveBlocksPerMultiprocessor(&per_cu, mk_coop, 256, 0);
#else
    hipOccupancyMaxActiveBlocksPerMultiprocessor(&per_cu, mk_phase<3>, 256, 0);
#endif
    (void)per_cu;
    grid_blocks = cus;
  }
#if COOP
  hipMemsetAsync(p.bar, 0, XCD_BAR_WORDS * 4, stream);
  void* args[] = {&p};
  hipError_t e = hipLaunchCooperativeKernel((void*)mk_coop, dim3(grid_blocks), dim3(512), args, 0, stream);
  if (e != hipSuccess) fprintf(stderr, "cooperative launch failed: %s (grid %d)\n", hipGetErrorString(e), grid_blocks);
#else
  mk_phase<0><<<grid_blocks, 256, 0, stream>>>(p, 0);
  for (int l = 0; l < 2; ++l) {
    mk_phase<1><<<grid_blocks, 256, 0, stream>>>(p, l);
    mk_phase<2><<<grid_blocks, 256, 0, stream>>>(p, l);
    mk_phase<3><<<grid_blocks, 256, 0, stream>>>(p, l);
    mk_phase<4><<<grid_blocks, 256, 0, stream>>>(p, l);
  }
  mk_phase<5><<<grid_blocks, 256, 0, stream>>>(p, 0);
#endif
}
```

```cpp
#include <hip/hip_runtime.h>
#include <hip/hip_cooperative_groups.h>
#include <cstdio>
namespace cg = cooperative_groups;

#ifndef COOP
#define COOP 1
#endif
#ifndef PROBE_ONLY
#define PROBE_ONLY 2
#endif
#ifndef PROBE_DUP
#define PROBE_DUP 0
#endif
#ifndef COOP_MINB
#define COOP_MINB 2
#endif

#define DI __device__ __forceinline__
typedef unsigned short u16;
typedef __attribute__((ext_vector_type(8))) short bf16x8;
typedef __attribute__((ext_vector_type(16))) float f32x16;
typedef __attribute__((ext_vector_type(2))) __bf16 bf16v2;
#define MFMA(a, b, c) __builtin_amdgcn_mfma_f32_32x32x16_bf16((a), (b), (c), 0, 0, 0)

constexpr int SEQ = 16384, TT = 32768, DM = 1024, NIN = 3844, NW = 3840, PC = 2816;
constexpr float EPS = 1e-6f, LOG2E = 1.4426950408889634f;
constexpr float QSCALE = 0.125f * LOG2E;
constexpr int AQ = 0, AK = 256, AG = 512, BU = 768, BG = 1024, CQ = 1280, CK = 1536, CG = 1792, DQ = 2048, DK = 2304, DG = 2560;
constexpr int SMEM_BYTES = 131072;
constexpr int NTHR = 512;
constexpr int VTLD = SEQ + 64;

struct Params {
  const float *x, *norm_g, *w_in, *b_f, *rel_bias, *w_s, *b_s, *v_gain, *branch_gain, *w_out, *final_g;
  float* out;
  u16 *WtIn, *WtOut, *Ws16, *H, *P, *Vt, *Z;
  float *lsf, *csum, *ssq, *ctot, *Wf;
  unsigned* ctr;
  unsigned* bar;
};

DI unsigned pk2(float a, float b) { bf16v2 v; v[0] = (__bf16)a; v[1] = (__bf16)b; return __builtin_bit_cast(unsigned, v); }
DI u16 f2bf(float a) { return __builtin_bit_cast(u16, (__bf16)a); }
DI float bf2f(u16 h) { return __uint_as_float(((unsigned)h) << 16); }
DI float bflo(unsigned u) { return __uint_as_float(u << 16); }
DI float bfhi(unsigned u) { return __uint_as_float(u & 0xffff0000u); }
DI int otid() { int t = threadIdx.x; asm volatile("" : "+v"(t)); return t; }
DI float wave_sum(float v) { for (int o = 32; o > 0; o >>= 1) v += __shfl_xor(v, o); return v; }

__device__ void phase_pre(const Params& p, unsigned char* smem) {
  float (*tile)[65] = (float (*)[65])smem;
  const int tid = otid(), tx = tid & 63, ty = tid >> 6;
  const int nA = 2 * 60 * 16, nB = 2 * 16 * 16;
  for (int it = blockIdx.x; it < nA + nB; it += gridDim.x) {
    const float* src; u16* dst; int ld_src, n0, k0, srcoff, nrows;
    if (it < nA) {
      int l = it / 960, rem = it % 960, ntile = rem / 16, ktile = rem % 16;
      n0 = ntile * 64; k0 = ktile * 64;
      src = p.w_in + (size_t)l * 1024 * NIN; ld_src = NIN; dst = p.WtIn + (size_t)l * NW * 1024; srcoff = (n0 >= 2816) ? 4 : 0; nrows = NW;
    } else {
      int j = it - nA; int l = j / 256, rem = j % 256, ntile = rem / 16, ktile = rem % 16;
      n0 = ntile * 64; k0 = ktile * 64;
      src = p.w_out + (size_t)l * 1024 * 1024; ld_src = 1024; dst = p.WtOut + (size_t)l * 1024 * 1024; srcoff = 0; nrows = 1024;
    }
    __syncthreads();
#pragma unroll 4
    for (int i = 0; i < 8; ++i) { int k = ty + 8 * i; tile[k][tx] = src[(size_t)(k0 + k) * ld_src + n0 + srcoff + tx]; }
    __syncthreads();
#pragma unroll 4
    for (int i = 0; i < 8; ++i) { int n = ty + 8 * i; dst[((size_t)(k0 >> 6) * nrows + n0 + n) * 64 + tx] = f2bf(tile[tx][n]); }
  }
  for (int idx = blockIdx.x * NTHR + tid; idx < 2 * 4 * 128 * 128; idx += gridDim.x * NTHR) {
    int t = (idx >> 7) & 127, s = idx & 127;
    p.Ws16[idx] = (s <= t) ? f2bf(p.w_s[idx]) : (u16)0;
  }
  for (int idx = blockIdx.x * NTHR + tid; idx < 2 * 1024; idx += gridDim.x * NTHR) {
    const int l = idx >> 10, k = idx & 1023;
    *(float4*)(p.Wf + (size_t)idx * 4) = *(const float4*)(p.w_in + ((size_t)l * 1024 + k) * NIN + 2816);
  }
  if (blockIdx.x == 0 && tid < 64) p.ctr[tid] = 0u;
}

__device__ void phase_norm(const Params& p, int l) {
  const float* src = (l == 0) ? p.x : p.out;
  const int tid_ = otid();
  const int lane = tid_ & 63;
  const int gw = blockIdx.x * 8 + (tid_ >> 6), nw = gridDim.x * 8;
  const float4* g4 = (const float4*)(p.norm_g + l * 1024);
  const float4* wf4 = (const float4*)(p.Wf + (size_t)l * 4096);
  float4 gr[4], w0[4], w1[4], w2[4], w3[4];
#pragma unroll
  for (int j = 0; j < 4; ++j) {
    const int k = 4 * (lane + 64 * j);
    gr[j] = g4[lane + 64 * j];
    w0[j] = wf4[k]; w1[j] = wf4[k + 1]; w2[j] = wf4[k + 2]; w3[j] = wf4[k + 3];
  }
  const float bf0 = p.b_f[l * 4 + 0], bf1 = p.b_f[l * 4 + 1], bf2 = p.b_f[l * 4 + 2], bf3 = p.b_f[l * 4 + 3];
  for (int row0 = gw * 4; row0 < TT; row0 += nw * 4) {
    float4 v[4][4]; float ss[4] = {0.f, 0.f, 0.f, 0.f};
#pragma unroll
    for (int q = 0; q < 4; ++q) {
      const float4* xr = (const float4*)(src + (size_t)(row0 + q) * 1024);
#pragma unroll
      for (int j = 0; j < 4; ++j) v[q][j] = xr[lane + 64 * j];
    }
#pragma unroll
    for (int q = 0; q < 4; ++q)
#pragma unroll
      for (int j = 0; j < 4; ++j) ss[q] += v[q][j].x * v[q][j].x + v[q][j].y * v[q][j].y + v[q][j].z * v[q][j].z + v[q][j].w * v[q][j].w;
    ss[0] = wave_sum(ss[0]); ss[1] = wave_sum(ss[1]); ss[2] = wave_sum(ss[2]); ss[3] = wave_sum(ss[3]);
#pragma unroll
    for (int q = 0; q < 4; ++q) {
      const int row = row0 + q;
      const float rinv = rsqrtf(ss[q] * (1.f / 1024.f) + EPS);
      float f0 = 0.f, f1 = 0.f, f2 = 0.f, f3 = 0.f;
#pragma unroll
      for (int j = 0; j < 4; ++j) {
        const float h0 = v[q][j].x * rinv * gr[j].x, h1 = v[q][j].y * rinv * gr[j].y, h2 = v[q][j].z * rinv * gr[j].z, h3 = v[q][j].w * rinv * gr[j].w;
        uint2 o; o.x = pk2(h0, h1); o.y = pk2(h2, h3);
        { const int col = 4 * (lane + 64 * j); *(uint2*)(p.H + ((size_t)(col >> 6) * TT + row) * 64 + (col & 63)) = o; }
        f0 += h0 * w0[j].x + h1 * w1[j].x + h2 * w2[j].x + h3 * w3[j].x;
        f1 += h0 * w0[j].y + h1 * w1[j].y + h2 * w2[j].y + h3 * w3[j].y;
        f2 += h0 * w0[j].z + h1 * w1[j].z + h2 * w2[j].z + h3 * w3[j].z;
        f3 += h0 * w0[j].w + h1 * w1[j].w + h2 * w2[j].w + h3 * w3[j].w;
      }
      f0 = wave_sum(f0); f1 = wave_sum(f1); f2 = wave_sum(f2); f3 = wave_sum(f3);
      if (lane == 0) {
        float4 o;
        o.x = f0 + bf0; o.y = f1 + bf1; o.z = f2 + bf2; o.w = f3 + bf3;
        o.x = (fminf(o.x, 0.f) - log1pf(expf(-fabsf(o.x)))) * LOG2E;
        o.y = (fminf(o.y, 0.f) - log1pf(expf(-fabsf(o.y)))) * LOG2E;
        o.z = (fminf(o.z, 0.f) - log1pf(expf(-fabsf(o.z)))) * LOG2E;
        o.w = (fminf(o.w, 0.f) - log1pf(expf(-fabsf(o.w)))) * LOG2E;
        *(float4*)(p.lsf + (size_t)row * 4) = o;
      }
    }
  }
}

__device__ void scan_chunk(const Params& p, int chunk, unsigned char* smem) {
  float4* wtot = (float4*)smem;
  const int tid = otid(), lane = tid & 63, w = tid >> 6;
  const bool act = tid < 256;
  const int ti = act ? tid : 0;
  const float4* in = (const float4*)p.lsf + (size_t)chunk * 1024 + ti * 4;
  float4 v0 = in[0], v1 = in[1], v2 = in[2], v3 = in[3];
  v1.x += v0.x; v1.y += v0.y; v1.z += v0.z; v1.w += v0.w;
  v2.x += v1.x; v2.y += v1.y; v2.z += v1.z; v2.w += v1.w;
  v3.x += v2.x; v3.y += v2.y; v3.z += v2.z; v3.w += v2.w;
  float4 inc = v3;
#pragma unroll
  for (int o = 1; o < 64; o <<= 1) {
    float4 n;
    n.x = __shfl_up(inc.x, o); n.y = __shfl_up(inc.y, o); n.z = __shfl_up(inc.z, o); n.w = __shfl_up(inc.w, o);
    if (lane >= o) { inc.x += n.x; inc.y += n.y; inc.z += n.z; inc.w += n.w; }
  }
  __syncthreads();
  if (act && lane == 63) wtot[w] = inc;
  __syncthreads();
  float4 pre = make_float4(inc.x - v3.x, inc.y - v3.y, inc.z - v3.z, inc.w - v3.w);
  float4 all = make_float4(0.f, 0.f, 0.f, 0.f);
#pragma unroll
  for (int i = 0; i < 4; ++i) {
    float4 t = wtot[i];
    if (i < w) { pre.x += t.x; pre.y += t.y; pre.z += t.z; pre.w += t.w; }
    all.x += t.x; all.y += t.y; all.z += t.z; all.w += t.w;
  }
  if (act) {
    float4* outp = (float4*)p.csum + (size_t)chunk * 1024 + tid * 4;
    outp[0] = make_float4(v0.x + pre.x, v0.y + pre.y, v0.z + pre.z, v0.w + pre.w);
    outp[1] = make_float4(v1.x + pre.x, v1.y + pre.y, v1.z + pre.z, v1.w + pre.w);
    outp[2] = make_float4(v2.x + pre.x, v2.y + pre.y, v2.z + pre.z, v2.w + pre.w);
    outp[3] = make_float4(v3.x + pre.x, v3.y + pre.y, v3.z + pre.z, v3.w + pre.w);
    if (tid == 0) ((float4*)p.ctot)[chunk] = all;
  }
  __syncthreads();
}

typedef u16 (*lds_tile_t)[72];
#define G_LOAD(A_, NR_, m0_, kt_, R_) do { const u16* gp_ = (A_) + ((size_t)(kt_) * (NR_) + (m0_) + (tid >> 3)) * 64 + (tid & 7) * 8; \
    R_##0 = *(const uint4*)gp_; R_##1 = *(const uint4*)(gp_ + 32 * 64); R_##2 = *(const uint4*)(gp_ + 64 * 64); R_##3 = *(const uint4*)(gp_ + 96 * 64); } while (0)
#define S_STORE(S_, R_) do { u16* sp_ = &(S_)[tid >> 3][(tid & 7) * 8]; \
    *(uint4*)sp_ = R_##0; *(uint4*)(sp_ + 32 * 72) = R_##1; *(uint4*)(sp_ + 64 * 72) = R_##2; *(uint4*)(sp_ + 96 * 72) = R_##3; } while (0)
template <bool SWAP>
DI void gemm_ktile(lds_tile_t As, lds_tile_t Bs, f32x16 (&acc)[2][2], int wm, int wn, int r, int h) {
  bf16x8 af[4][2], bfr[4][2];
  const u16* ap = &As[wm * 64 + r][h * 8];
  const u16* bp = &Bs[wn * 64 + r][h * 8];
#pragma unroll
  for (int ks = 0; ks < 4; ++ks) {
    af[ks][0] = *(const bf16x8*)(ap + ks * 16); af[ks][1] = *(const bf16x8*)(ap + 32 * 72 + ks * 16);
    bfr[ks][0] = *(const bf16x8*)(bp + ks * 16); bfr[ks][1] = *(const bf16x8*)(bp + 32 * 72 + ks * 16);
  }
  __builtin_amdgcn_sched_barrier(0);
#pragma unroll
  for (int ks = 0; ks < 4; ++ks)
#pragma unroll
    for (int mi = 0; mi < 2; ++mi)
#pragma unroll
      for (int ni = 0; ni < 2; ++ni)
        acc[mi][ni] = SWAP ? MFMA(bfr[ks][ni], af[ks][mi], acc[mi][ni]) : MFMA(af[ks][mi], bfr[ks][ni], acc[mi][ni]);
}

#define GL_STAGE(GA_, NRA_, m0_, GB_, NRB_, n0_, T32_, SBASE_) do { _Pragma("unroll") for (int j_ = 0; j_ < 2; ++j_) { \
    const int q_ = j_ * 512 + tid, rw_ = q_ >> 2, kc_ = (q_ & 3) ^ ((rw_ >> 2) & 3); \
    __builtin_amdgcn_global_load_lds((const unsigned*)((GA_) + ((size_t)((T32_) >> 1) * (NRA_) + (m0_) + rw_) * 64 + ((T32_) & 1) * 32 + kc_ * 8), \
        (__attribute__((address_space(3))) unsigned*)((SBASE_) + q_ * 16), 16, 0, 0); \
    __builtin_amdgcn_global_load_lds((const unsigned*)((GB_) + ((size_t)((T32_) >> 1) * (NRB_) + (n0_) + rw_) * 64 + ((T32_) & 1) * 32 + kc_ * 8), \
        (__attribute__((address_space(3))) unsigned*)((SBASE_) + 16384 + q_ * 16), 16, 0, 0); } } while (0)
#define GL_WAIT_BAR() do { asm volatile("s_waitcnt vmcnt(8)" ::: "memory"); __builtin_amdgcn_s_barrier(); asm volatile("" ::: "memory"); } while (0)
DI unsigned frag_addr(unsigned base, int row, int kc) { return base + row * 64 + ((kc ^ ((row >> 2) & 3)) << 4); }
template <bool SWAP>
DI void gemm_ktile32(const unsigned char* St, f32x16 (&acc)[4][2], int wm, int wn, int r, int h) {
  const unsigned sa = (unsigned)(size_t)St, sbb = sa + 16384;
  const int ra = wm * 128 + r, rb = wn * 64 + r;
  bf16x8 a0[4], a1[4], b0[2], b1[2];
  asm volatile(
      "ds_read_b128 %0, %6\n\tds_read_b128 %1, %7\n\tds_read_b128 %4, %10\n\tds_read_b128 %5, %11\n\t"
      "ds_read_b128 %2, %8\n\tds_read_b128 %3, %9\n\t"
      "s_waitcnt lgkmcnt(0)"
      : "=&v"(a0[0]), "=&v"(a0[1]), "=&v"(a0[2]), "=&v"(a0[3]), "=&v"(b0[0]), "=&v"(b0[1])
      : "v"(frag_addr(sa, ra, h)), "v"(frag_addr(sa, ra + 32, h)), "v"(frag_addr(sa, ra + 64, h)), "v"(frag_addr(sa, ra + 96, h)),
        "v"(frag_addr(sbb, rb, h)), "v"(frag_addr(sbb, rb + 32, h))
      : "memory");
  asm volatile(
      "ds_read_b128 %0, %6\n\tds_read_b128 %1, %7\n\tds_read_b128 %4, %10\n\tds_read_b128 %5, %11\n\t"
      "ds_read_b128 %2, %8\n\tds_read_b128 %3, %9"
      : "=&v"(a1[0]), "=&v"(a1[1]), "=&v"(a1[2]), "=&v"(a1[3]), "=&v"(b1[0]), "=&v"(b1[1])
      : "v"(frag_addr(sa, ra, 2 + h)), "v"(frag_addr(sa, ra + 32, 2 + h)), "v"(frag_addr(sa, ra + 64, 2 + h)), "v"(frag_addr(sa, ra + 96, 2 + h)),
        "v"(frag_addr(sbb, rb, 2 + h)), "v"(frag_addr(sbb, rb + 32, 2 + h))
      : "memory");
  __builtin_amdgcn_sched_barrier(0);
#pragma unroll
  for (int mi = 0; mi < 4; ++mi)
#pragma unroll
    for (int ni = 0; ni < 2; ++ni) acc[mi][ni] = SWAP ? MFMA(b0[ni], a0[mi], acc[mi][ni]) : MFMA(a0[mi], b0[ni], acc[mi][ni]);
  __builtin_amdgcn_sched_barrier(0);
  asm volatile("s_waitcnt lgkmcnt(0)"
               : "+v"(a1[0]), "+v"(a1[1]), "+v"(a1[2]), "+v"(a1[3]), "+v"(b1[0]), "+v"(b1[1]) : : "memory");
#pragma unroll
  for (int mi = 0; mi < 4; ++mi)
#pragma unroll
    for (int ni = 0; ni < 2; ++ni) acc[mi][ni] = SWAP ? MFMA(b1[ni], a1[mi], acc[mi][ni]) : MFMA(a1[mi], b1[ni], acc[mi][ni]);
}
typedef unsigned u32x2w __attribute__((ext_vector_type(2)));
DI uint4 widen_pair(uint2 ev, uint2 od) {
  const u32x2w a = __builtin_amdgcn_permlane32_swap(ev.x, od.x, false, false);
  const u32x2w b = __builtin_amdgcn_permlane32_swap(ev.y, od.y, false, false);
  return make_uint4(a[0], b[0], a[1], b[1]);
}
DI int sec_pcol(int s) { int nv = (s > 2) + (s > 5) + (s > 9) + (s > 13); return (s - nv) * 256; }
DI int sec_branch(int s) { return (s < 4) ? 0 : (s < 7) ? 1 : (s < 11) ? 2 : 3; }

template <bool SWAP>
DI void gemm_mainloop(const u16* A, const u16* B, int nrb, int m0, int n0, unsigned char* smem, f32x16 (&acc)[4][2]) {
  const int tid = otid(), lane = tid & 63, w = tid >> 6, wm = w >> 2, wn = w & 3, r = lane & 31, h = lane >> 5;
  GL_STAGE(A, TT, m0, B, nrb, n0, 0, smem);
  GL_STAGE(A, TT, m0, B, nrb, n0, 1, smem + 32768);
  GL_STAGE(A, TT, m0, B, nrb, n0, 2, smem + 65536);
#pragma unroll 1
  for (int t = 0; t < 32; ++t) {
    GL_WAIT_BAR();
    { const int t3 = min(t + 3, 31); GL_STAGE(A, TT, m0, B, nrb, n0, t3, smem + ((t + 3) & 3) * 32768); }
    gemm_ktile32<SWAP>(smem + (t & 3) * 32768, acc, wm, wn, r, h);
  }
  asm volatile("s_waitcnt vmcnt(0)" ::: "memory");
  __syncthreads();
}

__device__ void gemm_in_tile(const Params& p, int l, int mt, int sec, unsigned char* smem) {
  const int m0 = mt * 256, n0 = sec * 256;
  const bool is_vt = (sec == 2 || sec == 5 || sec == 9 || sec == 13);
  const bool is_q = (sec == 0 || sec == 7 || sec == 11);
  const bool is_gate = (sec == 3 || sec == 6 || sec == 10 || sec == 14);
  const int br = sec_branch(sec);
  const int tid = otid(), lane = tid & 63, w = tid >> 6, wm = w >> 2, wn = w & 3, r = lane & 31, h = lane >> 5;
  const u16* A = p.H;
  const u16* B = p.WtIn + (size_t)l * NW * 1024;
  f32x16 acc[4][2];
#pragma unroll
  for (int mi = 0; mi < 4; ++mi)
#pragma unroll
    for (int ni = 0; ni < 2; ++ni)
#pragma unroll
      for (int i = 0; i < 16; ++i) acc[mi][ni][i] = 0.f;
  if (is_vt) {
    gemm_mainloop<false>(A, B, NW, m0, n0, smem, acc);
#pragma unroll
    for (int mi = 0; mi < 4; ++mi)
#pragma unroll
      for (int ni = 0; ni < 2; ++ni) {
        const int c = wn * 64 + ni * 32 + r;
#pragma unroll
        for (int gp = 0; gp < 2; ++gp) {
          uint2 ev, od;
          ev.x = pk2(acc[mi][ni][8 * gp], acc[mi][ni][8 * gp + 1]); ev.y = pk2(acc[mi][ni][8 * gp + 2], acc[mi][ni][8 * gp + 3]);
          od.x = pk2(acc[mi][ni][8 * gp + 4], acc[mi][ni][8 * gp + 5]); od.y = pk2(acc[mi][ni][8 * gp + 6], acc[mi][ni][8 * gp + 7]);
          const uint4 o = widen_pair(ev, od);
          const int t0 = m0 + wm * 128 + mi * 32 + 8 * (2 * gp + h);
          const int b = t0 >> 14, sq = t0 & (SEQ - 1);
          *(uint4*)(p.Vt + ((size_t)(br * 2 + b) * 256 + c) * VTLD + sq) = o;
        }
      }
  } else {
    gemm_mainloop<true>(A, B, NW, m0, n0, smem, acc);
    const int pcol = sec_pcol(sec);
    const float* gain = p.branch_gain + (size_t)(l * 4 + br) * 256;
    if (sec == 8) {
      float mx2 = 0.f;
#pragma unroll
      for (int mi = 0; mi < 4; ++mi) {
        float n2 = 0.f;
#pragma unroll
        for (int ni = 0; ni < 2; ++ni)
#pragma unroll
          for (int i = 0; i < 16; ++i) n2 += acc[mi][ni][i] * acc[mi][ni][i];
        n2 += __shfl_xor(n2, 32);
        mx2 = fmaxf(mx2, n2);
      }
#pragma unroll
      for (int o = 16; o > 0; o >>= 1) mx2 = fmaxf(mx2, __shfl_xor(mx2, o));
      if (lane == 0) atomicMax(p.ctr + 48 + l * 8 + (m0 >> 14) * 4 + wn, __float_as_uint(mx2));
    }
#pragma unroll
    for (int mi = 0; mi < 4; ++mi)
#pragma unroll
      for (int ni = 0; ni < 2; ++ni) {
        const int t = m0 + wm * 128 + mi * 32 + r;
        uint2 og[4];
#pragma unroll
        for (int gi = 0; gi < 4; ++gi) {
          const int nl = wn * 64 + ni * 32 + 8 * gi + 4 * h;
          float v[4];
#pragma unroll
          for (int e = 0; e < 4; ++e) v[e] = acc[mi][ni][4 * gi + e];
          if (is_q) {
#pragma unroll
            for (int e = 0; e < 4; ++e) v[e] *= QSCALE;
          } else if (is_gate) {
            float4 gg = *(const float4*)(gain + nl);
            const float* gp = (const float*)&gg;
#pragma unroll
            for (int e = 0; e < 4; ++e) v[e] = gp[e] * v[e] / (1.f + __expf(-v[e]));
          }
          og[gi].x = pk2(v[0], v[1]); og[gi].y = pk2(v[2], v[3]);
        }
#pragma unroll
        for (int gp = 0; gp < 2; ++gp) {
          const uint4 o = widen_pair(og[2 * gp], og[2 * gp + 1]);
          const int nl8 = wn * 64 + ni * 32 + 8 * (2 * gp + h);
          *(uint4*)(p.P + (size_t)t * PC + pcol + nl8) = o;
        }
      }
  }
}

__device__ void phase_gemm_in(const Params& p, int l, unsigned char* smem) {
  for (int c = (int)gridDim.x - 1 - (int)blockIdx.x; c < 32; c += gridDim.x) scan_chunk(p, c, smem);
  const int xcd = blockIdx.x & 7, slot = blockIdx.x >> 3, nslot = gridDim.x >> 3;
  for (int j = slot; j < 240; j += nslot) {
    const int mg = j / 120, rem = j % 120;
    const int ng = (rem >= 96) ? 3 : (rem >> 5), idx = rem - ng * 32;
    const int mt = xcd * 16 + mg * 8 + (idx & 7), sec = ng * 4 + (idx >> 3);
    gemm_in_tile(p, l, mt, sec, smem);
  }
}

__device__ void gemm_out_tile(const Params& p, int l, int mt, int nt, unsigned char* smem) {
  const int m0 = mt * 256, n0 = nt * 256;
  const int tid = otid(), lane = tid & 63, w = tid >> 6, wm = w >> 2, wn = w & 3, r = lane & 31, h = lane >> 5;
  const u16* A = p.Z;
  const u16* B = p.WtOut + (size_t)l * 1024 * 1024;
  const float* resid = (l == 0) ? p.x : p.out;
  float fold[4][4];
#pragma unroll
  for (int mi = 0; mi < 4; ++mi) {
    const int t = m0 + wm * 128 + mi * 32 + r;
    float rv[4];
#pragma unroll
    for (int br = 0; br < 4; ++br) {
      float4 sq = *(const float4*)(p.ssq + (size_t)t * 16 + br * 4);
      rv[br] = rsqrtf((sq.x + sq.y + sq.z + sq.w) * (1.f / 256.f) + EPS);
    }
    fold[mi][0] = rv[0] / rv[1]; fold[mi][1] = rv[1] / rv[2]; fold[mi][2] = rv[2] / rv[3]; fold[mi][3] = rv[3];
  }
  f32x16 acc[4][2];
#pragma unroll
  for (int mi = 0; mi < 4; ++mi)
#pragma unroll
    for (int ni = 0; ni < 2; ++ni)
#pragma unroll
      for (int i = 0; i < 16; ++i) acc[mi][ni][i] = 0.f;
  GL_STAGE(A, TT, m0, B, 1024, n0, 0, smem);
  GL_STAGE(A, TT, m0, B, 1024, n0, 1, smem + 32768);
  GL_STAGE(A, TT, m0, B, 1024, n0, 2, smem + 65536);
#pragma unroll 1
  for (int t = 0; t < 32; ++t) {
    GL_WAIT_BAR();
    { const int t3 = min(t + 3, 31); GL_STAGE(A, TT, m0, B, 1024, n0, t3, smem + ((t + 3) & 3) * 32768); }
    gemm_ktile32<true>(smem + (t & 3) * 32768, acc, wm, wn, r, h);
    if ((t & 7) == 7) {
      const int br = t >> 3;
#pragma unroll
      for (int mi = 0; mi < 4; ++mi) {
        const float f = (br == 0) ? fold[mi][0] : (br == 1) ? fold[mi][1] : (br == 2) ? fold[mi][2] : fold[mi][3];
#pragma unroll
        for (int ni = 0; ni < 2; ++ni)
#pragma unroll
          for (int i = 0; i < 16; ++i) acc[mi][ni][i] *= f;
      }
    }
  }
  asm volatile("s_waitcnt vmcnt(0)" ::: "memory");
  __syncthreads();
#pragma unroll
  for (int mi = 0; mi < 4; ++mi)
#pragma unroll
    for (int ni = 0; ni < 2; ++ni) {
      const int t = m0 + wm * 128 + mi * 32 + r;
#pragma unroll
      for (int gi = 0; gi < 4; ++gi) {
        const int d = n0 + wn * 64 + ni * 32 + 8 * gi + 4 * h;
        float4 rs = *(const float4*)(resid + (size_t)t * 1024 + d);
        rs.x += acc[mi][ni][4 * gi]; rs.y += acc[mi][ni][4 * gi + 1]; rs.z += acc[mi][ni][4 * gi + 2]; rs.w += acc[mi][ni][4 * gi + 3];
        *(float4*)(p.out + (size_t)t * 1024 + d) = rs;
      }
    }
}

__device__ void phase_gemm_out(const Params& p, int l, unsigned char* smem) {
  const int xcd = blockIdx.x & 7, slot = blockIdx.x >> 3, nslot = gridDim.x >> 3;
  for (int j = slot; j < 64; j += nslot) {
    const int mg = j >> 5, idx = j & 31;
    gemm_out_tile(p, l, xcd * 16 + mg * 8 + (idx & 7), idx >> 3, smem);
  }
}

__device__ void phase_final(const Params& p) {
  const int tid_ = otid();
  const int lane = tid_ & 63;
  const int gw = blockIdx.x * 8 + (tid_ >> 6), nw = gridDim.x * 8;
  const float4* g4 = (const float4*)p.final_g;
  float4 gr[4];
#pragma unroll
  for (int j = 0; j < 4; ++j) gr[j] = g4[lane + 64 * j];
  for (int row0 = gw * 4; row0 < TT; row0 += nw * 4) {
    float4 v[4][4]; float ss[4] = {0.f, 0.f, 0.f, 0.f};
#pragma unroll
    for (int q = 0; q < 4; ++q) {
      const float4* xr = (const float4*)(p.out + (size_t)(row0 + q) * 1024);
#pragma unroll
      for (int j = 0; j < 4; ++j) v[q][j] = xr[lane + 64 * j];
    }
#pragma unroll
    for (int q = 0; q < 4; ++q)
#pragma unroll
      for (int j = 0; j < 4; ++j) ss[q] += v[q][j].x * v[q][j].x + v[q][j].y * v[q][j].y + v[q][j].z * v[q][j].z + v[q][j].w * v[q][j].w;
    ss[0] = wave_sum(ss[0]); ss[1] = wave_sum(ss[1]); ss[2] = wave_sum(ss[2]); ss[3] = wave_sum(ss[3]);
#pragma unroll
    for (int q = 0; q < 4; ++q) {
      float4* xr = (float4*)(p.out + (size_t)(row0 + q) * 1024);
      const float rinv = rsqrtf(ss[q] * (1.f / 1024.f) + EPS);
#pragma unroll
      for (int j = 0; j < 4; ++j) {
        float4 o; o.x = v[q][j].x * rinv * gr[j].x; o.y = v[q][j].y * rinv * gr[j].y; o.z = v[q][j].z * rinv * gr[j].z; o.w = v[q][j].w * rinv * gr[j].w;
        xr[lane + 64 * j] = o;
      }
    }
  }
}

template <int MODE>
__device__ void naive_attn_item(const Params& p, int l, int bh, int qb, unsigned char* smem) {
  float (*Ks)[64] = (float (*)[64])smem;
  float (*Vs)[64] = (float (*)[64])(smem + 16384);
  const int tid = otid(), b = bh >> 2, hh = bh & 3;
  const int qcol = MODE == 0 ? AQ : MODE == 1 ? CQ : DQ, kcol = MODE == 0 ? AK : MODE == 1 ? CK : DK, gcol = MODE == 0 ? AG : MODE == 1 ? CG : DG;
  const int br = MODE == 0 ? 0 : MODE == 1 ? 2 : 3;
  const int t = qb * 256 + tid;
  const size_t tok = (size_t)b * SEQ + t;
  unsigned q2[32]; float o[64];
#pragma unroll
  for (int d8 = 0; d8 < 8; ++d8) {
    uint4 u = *(const uint4*)(p.P + tok * PC + qcol + hh * 64 + d8 * 8);
    q2[d8 * 4 + 0] = u.x; q2[d8 * 4 + 1] = u.y; q2[d8 * 4 + 2] = u.z; q2[d8 * 4 + 3] = u.w;
  }
#pragma unroll
  for (int d = 0; d < 64; ++d) o[d] = 0.f;
  float m = -INFINITY, lsum = 0.f, carry = 0.f;
  const int hi = qb * 4 + 3;
  const int lo = (MODE == 0) ? max(0, qb * 4 - 8) : 0;
  const int c = t >> 6;
  const float* bias = p.rel_bias + (size_t)(l * 4 + hh) * 257;
  for (int kt = hi; kt >= lo; --kt) {
    __syncthreads();
#pragma unroll 4
    for (int i = 0; i < 16; ++i) {
      const int idx = tid + 256 * i, a = idx >> 6, bb = idx & 63;
      Ks[a][bb] = bf2f(p.P[((size_t)b * SEQ + kt * 64 + a) * PC + kcol + hh * 64 + bb]);
      Vs[bb][a] = bf2f(p.Vt[((size_t)(br * 2 + b) * 256 + hh * 64 + a) * SEQ + kt * 64 + bb]);
    }
    __syncthreads();
    bool tile_ok = true;
    if (MODE == 0) tile_ok = (kt >= c - 8) && (kt <= c);
    if (MODE != 0) tile_ok = (kt * 64 <= t);
    if (!tile_ok) continue;
    for (int j = 63; j >= 0; --j) {
      const int kpos = kt * 64 + j;
      if (MODE == 1 && kpos > t) continue;
      if (MODE == 2 && kpos >= t) continue;
      float dot = 0.f;
#pragma unroll
      for (int d = 0; d < 32; ++d) dot += bflo(q2[d]) * Ks[j][2 * d] + bfhi(q2[d]) * Ks[j][2 * d + 1];
      float pw;
      if (MODE == 2) {
        const float sp = __log2f(1.f + exp2f(dot));
        pw = exp2f(dot - sp - carry);
        carry += sp;
      } else {
        float u;
        if (MODE == 0) { int rel = min(max(t - kpos, -128), 128) + 128; u = dot + bias[rel] * LOG2E; }
        else u = dot - p.csum[((size_t)b * SEQ + kpos) * 4 + hh];
        if (u > m) {
          const float sc = exp2f(m - u);
          lsum *= sc;
#pragma unroll
          for (int d = 0; d < 64; ++d) o[d] *= sc;
          m = u;
        }
        pw = exp2f(u - m);
        lsum += pw;
      }
#pragma unroll
      for (int d = 0; d < 64; ++d) o[d] += pw * Vs[j][d];
    }
  }
  if (MODE != 2) {
    const float inv = 1.f / lsum;
#pragma unroll
    for (int d = 0; d < 64; ++d) o[d] *= inv;
  }
  float ss = 0.f;
#pragma unroll
  for (int d = 0; d < 64; ++d) ss += o[d] * o[d];
  p.ssq[tok * 16 + br * 4 + hh] = ss;
#pragma unroll
  for (int d8 = 0; d8 < 8; ++d8) {
    uint4 g = *(const uint4*)(p.P + tok * PC + gcol + hh * 64 + d8 * 8);
    uint4 z;
    z.x = pk2(o[d8 * 8 + 0] * bflo(g.x), o[d8 * 8 + 1] * bfhi(g.x));
    z.y = pk2(o[d8 * 8 + 2] * bflo(g.y), o[d8 * 8 + 3] * bfhi(g.y));
    z.z = pk2(o[d8 * 8 + 4] * bflo(g.z), o[d8 * 8 + 5] * bfhi(g.z));
    z.w = pk2(o[d8 * 8 + 6] * bflo(g.w), o[d8 * 8 + 7] * bfhi(g.w));
    *(uint4*)(p.Z + tok * 1024 + br * 256 + hh * 64 + d8 * 8) = z;
  }
}


typedef _Float16 f16x8 __attribute__((ext_vector_type(8)));
typedef _Float16 f16v2 __attribute__((ext_vector_type(2)));
typedef unsigned u32x4 __attribute__((ext_vector_type(4)));
#define MFMA_F16(a, b, c) __builtin_amdgcn_mfma_f32_32x32x16_f16((a), (b), (c), 0, 0, 0)
constexpr int KST = 88, VST = 68;
constexpr int STAGE_BYTES = 64 * KST * 2 + 64 * VST * 2;
constexpr int ATT_TAB_OFF = 2 * STAGE_BYTES;

DI int crow(int i, int h) { return (i & 3) + 8 * (i >> 2) + 4 * h; }
DI unsigned pkh2(float a, float b) { f16v2 v; v[0] = (_Float16)a; v[1] = (_Float16)b; return __builtin_bit_cast(unsigned, v); }
DI float ex2(float x) { return __builtin_amdgcn_exp2f(x); }
DI float lg2(float x) { return __builtin_amdgcn_logf(x); }

template <int MODE>
DI void attn_subtile(const u16* Kt, const u16* Vs, int st, bool diag, int r, int h, const bf16x8 (&qf)[4], bf16x8 qx,
                     const f16x8 (&uf)[2], const float* tab, int dist0, f32x16 (&O)[2], float& m, float& lsum, float& carry) {
  f32x16 s;
#pragma unroll
  for (int i = 0; i < 16; ++i) s[i] = 0.f;
  const u16* kp = Kt + (32 * st + r) * KST + 8 * h;
#pragma unroll
  for (int ks = 0; ks < 4; ++ks) s = MFMA(*(const bf16x8*)(kp + 16 * ks), qf[ks], s);
  if (MODE == 1) s = MFMA(*(const bf16x8*)(kp + 64), qx, s);
  f32x16 pv;
  if (MODE == 2) {
    f32x16 sp;
#pragma unroll
    for (int i = 0; i < 16; ++i) sp[i] = lg2(1.f + ex2(s[i]));
    if (diag) {
#pragma unroll
      for (int i = 0; i < 16; ++i) if (crow(i, h) >= r) sp[i] = 0.f;
    }
    u32x4 a0, a1;
#pragma unroll
    for (int j = 0; j < 4; ++j) { a0[j] = pkh2(sp[2 * j], sp[2 * j + 1]); a1[j] = pkh2(sp[8 + 2 * j], sp[8 + 2 * j + 1]); }
    f32x16 cs;
#pragma unroll
    for (int i = 0; i < 16; ++i) cs[i] = carry;
    cs = MFMA_F16(uf[0], __builtin_bit_cast(f16x8, a0), cs);
    cs = MFMA_F16(uf[1], __builtin_bit_cast(f16x8, a1), cs);
#pragma unroll
    for (int i = 0; i < 16; ++i) pv[i] = ex2(s[i] - cs[i]);
    if (diag) {
#pragma unroll
      for (int i = 0; i < 16; ++i) if (crow(i, h) >= r) pv[i] = 0.f;
    }
    carry = __shfl(cs[0], r);
  } else {
    if (MODE == 0) {
#pragma unroll
      for (int i = 0; i < 16; ++i) { int idx = min(max(dist0 - crow(i, h), -128), 128) + 128; s[i] += tab[idx]; }
    }
    if (MODE == 1 && diag) {
#pragma unroll
      for (int i = 0; i < 16; ++i) if (crow(i, h) > r) s[i] = -1e30f;
    }
    float mx = s[0];
#pragma unroll
    for (int i = 1; i < 16; ++i) mx = fmaxf(mx, s[i]);
    mx = fmaxf(mx, __shfl_xor(mx, 32));
    if (__any(mx > m)) {
      const float mn = fmaxf(m, mx);
      const float al = ex2(m - mn);
      m = mn; lsum *= al;
#pragma unroll
      for (int i = 0; i < 16; ++i) { O[0][i] *= al; O[1][i] *= al; }
    }
    float rs = 0.f;
#pragma unroll
    for (int i = 0; i < 16; ++i) { pv[i] = ex2(s[i] - m); rs += pv[i]; }
    lsum += rs;
  }
#pragma unroll
  for (int s2 = 0; s2 < 2; ++s2) {
    u32x4 pp;
#pragma unroll
    for (int j = 0; j < 4; ++j) pp[j] = pk2(pv[8 * s2 + 2 * j], pv[8 * s2 + 2 * j + 1]);
    const bf16x8 pf = __builtin_bit_cast(bf16x8, pp);
#pragma unroll
    for (int mt = 0; mt < 2; ++mt) {
      const u16* vp = Vs + (32 * mt + r) * VST + 32 * st + 16 * s2 + 4 * h;
      const uint2 v0 = *(const uint2*)vp, v1 = *(const uint2*)(vp + 8);
      u32x4 vv; vv[0] = v0.x; vv[1] = v0.y; vv[2] = v1.x; vv[3] = v1.y;
      O[mt] = MFMA(__builtin_bit_cast(bf16x8, vv), pf, O[mt]);
    }
  }
}


template <int MODE>
DI void attn_tile2(const u16* Kt, const u16* Vs, bool diag1, int r, int h, const bf16x8 (&qf)[4], bf16x8 qx,
                   const f16x8 (&uf)[2], const float* tab, int dist0, f32x16 (&O)[2], float& m, float& lsum, float& carry) {
  f32x16 s1, s0;
#pragma unroll
  for (int i = 0; i < 16; ++i) { s1[i] = 0.f; s0[i] = 0.f; }
  const u16* kp0 = Kt + r * KST + 8 * h;
  const u16* kp1 = kp0 + 32 * KST;
#pragma unroll
  for (int ks = 0; ks < 4; ++ks) {
    s1 = MFMA(*(const bf16x8*)(kp1 + 16 * ks), qf[ks], s1);
    s0 = MFMA(*(const bf16x8*)(kp0 + 16 * ks), qf[ks], s0);
  }
  if (MODE == 1) { s1 = MFMA(*(const bf16x8*)(kp1 + 64), qx, s1); s0 = MFMA(*(const bf16x8*)(kp0 + 64), qx, s0); }
  u32x4 vf1[2][2];
#pragma unroll
  for (int s2 = 0; s2 < 2; ++s2)
#pragma unroll
    for (int mt = 0; mt < 2; ++mt) {
      const u16* vp = Vs + (32 * mt + r) * VST + 32 + 16 * s2 + 4 * h;
      const uint2 v0 = *(const uint2*)vp, v1 = *(const uint2*)(vp + 8);
      vf1[s2][mt][0] = v0.x; vf1[s2][mt][1] = v0.y; vf1[s2][mt][2] = v1.x; vf1[s2][mt][3] = v1.y;
    }
  __builtin_amdgcn_sched_barrier(0);
  f32x16 p1, p0;
  if (MODE == 2) {
    f32x16 sp1, sp0;
#pragma unroll
    for (int i = 0; i < 16; ++i) { sp1[i] = lg2(1.f + ex2(s1[i])); sp0[i] = lg2(1.f + ex2(s0[i])); }
    if (diag1) {
#pragma unroll
      for (int i = 0; i < 16; ++i) if (crow(i, h) >= r) sp1[i] = 0.f;
    }
    u32x4 a10, a11, a00, a01;
#pragma unroll
    for (int j = 0; j < 4; ++j) {
      a10[j] = pkh2(sp1[2 * j], sp1[2 * j + 1]); a11[j] = pkh2(sp1[8 + 2 * j], sp1[8 + 2 * j + 1]);
      a00[j] = pkh2(sp0[2 * j], sp0[2 * j + 1]); a01[j] = pkh2(sp0[8 + 2 * j], sp0[8 + 2 * j + 1]);
    }
    f32x16 cs1, cs0;
#pragma unroll
    for (int i = 0; i < 16; ++i) { cs1[i] = carry; cs0[i] = carry; }
    cs1 = MFMA_F16(uf[0], __builtin_bit_cast(f16x8, a10), cs1);
    cs0 = MFMA_F16(uf[0], __builtin_bit_cast(f16x8, a00), cs0);
    cs1 = MFMA_F16(uf[1], __builtin_bit_cast(f16x8, a11), cs1);
    cs0 = MFMA_F16(uf[1], __builtin_bit_cast(f16x8, a01), cs0);
#pragma unroll
    for (int i = 0; i < 16; ++i) p1[i] = ex2(s1[i] - cs1[i]);
    if (diag1) {
#pragma unroll
      for (int i = 0; i < 16; ++i) if (crow(i, h) >= r) p1[i] = 0.f;
    }
    const float tot1 = __shfl(cs1[0], r) - carry;
#pragma unroll
    for (int i = 0; i < 16; ++i) p0[i] = ex2(s0[i] - tot1 - cs0[i]);
    carry = __shfl(cs0[0], r) + tot1;
  } else {
    if (MODE == 0) {
      if (diag1) {
        const float cb = tab[256];
#pragma unroll
        for (int i = 0; i < 16; ++i) { s1[i] += cb; s0[i] += cb; }
      } else {
#pragma unroll
        for (int i = 0; i < 16; ++i) {
          const int d0 = dist0 - crow(i, h);
          s1[i] += tab[min(max(d0 - 32, -128), 128) + 128];
          s0[i] += tab[min(max(d0, -128), 128) + 128];
        }
      }
    }
    if (MODE == 1 && diag1) {
#pragma unroll
      for (int i = 0; i < 16; ++i) if (crow(i, h) > r) s1[i] = -1e30f;
    }
    float mx = fmaxf(s1[0], s0[0]);
#pragma unroll
    for (int i = 1; i < 16; ++i) mx = fmaxf(mx, fmaxf(s1[i], s0[i]));
    mx = fmaxf(mx, __shfl_xor(mx, 32));
    if (__any(mx > m)) {
      const float mn = fmaxf(m, mx);
      const float al = ex2(m - mn);
      m = mn; lsum *= al;
#pragma unroll
      for (int i = 0; i < 16; ++i) { O[0][i] *= al; O[1][i] *= al; }
    }
    float rs1 = 0.f, rs0 = 0.f;
#pragma unroll
    for (int i = 0; i < 16; ++i) { p1[i] = ex2(s1[i] - m); rs1 += p1[i]; p0[i] = ex2(s0[i] - m); rs0 += p0[i]; }
    lsum += rs1 + rs0;
  }
  __builtin_amdgcn_sched_barrier(0);
  u32x4 vf0[2][2];
#pragma unroll
  for (int s2 = 0; s2 < 2; ++s2)
#pragma unroll
    for (int mt = 0; mt < 2; ++mt) {
      const u16* vp = Vs + (32 * mt + r) * VST + 16 * s2 + 4 * h;
      const uint2 v0 = *(const uint2*)vp, v1 = *(const uint2*)(vp + 8);
      vf0[s2][mt][0] = v0.x; vf0[s2][mt][1] = v0.y; vf0[s2][mt][2] = v1.x; vf0[s2][mt][3] = v1.y;
    }
#pragma unroll
  for (int s2 = 0; s2 < 2; ++s2) {
    u32x4 pp;
#pragma unroll
    for (int j = 0; j < 4; ++j) pp[j] = pk2(p1[8 * s2 + 2 * j], p1[8 * s2 + 2 * j + 1]);
    const bf16x8 pf = __builtin_bit_cast(bf16x8, pp);
    O[0] = MFMA(__builtin_bit_cast(bf16x8, vf1[s2][0]), pf, O[0]);
    O[1] = MFMA(__builtin_bit_cast(bf16x8, vf1[s2][1]), pf, O[1]);
  }
#pragma unroll
  for (int s2 = 0; s2 < 2; ++s2) {
    u32x4 pp;
#pragma unroll
    for (int j = 0; j < 4; ++j) pp[j] = pk2(p0[8 * s2 + 2 * j], p0[8 * s2 + 2 * j + 1]);
    const bf16x8 pf = __builtin_bit_cast(bf16x8, pp);
    O[0] = MFMA(__builtin_bit_cast(bf16x8, vf0[s2][0]), pf, O[0]);
    O[1] = MFMA(__builtin_bit_cast(bf16x8, vf0[s2][1]), pf, O[1]);
  }
}

template <int MODE>
__device__ void attn_item(const Params& p, int l, int bh, int qb, unsigned char* smem) {
  const int tid = otid(), lane = tid & 63, w = tid >> 6, r = lane & 31, h = lane >> 5;
  const int b = bh >> 2, hh = bh & 3;
  const int qcol = MODE == 0 ? AQ : MODE == 1 ? CQ : DQ, kcol = MODE == 0 ? AK : MODE == 1 ? CK : DK, gcol = MODE == 0 ? AG : MODE == 1 ? CG : DG;
  const int br = MODE == 0 ? 0 : MODE == 1 ? 2 : 3;
  const int q0 = qb * 256, qs0 = q0 + 32 * w, t = qs0 + r;
  const size_t tok = (size_t)b * SEQ + t;
  const int hi = 4 * qb + 3, lo = (MODE == 0) ? max(0, 4 * qb - 8) : 0;
  float* tab = (float*)(smem + ATT_TAB_OFF);

  bf16x8 qf[4];
#pragma unroll
  for (int ks = 0; ks < 4; ++ks) qf[ks] = *(const bf16x8*)(p.P + tok * PC + qcol + hh * 64 + 16 * ks + 8 * h);
  bf16x8 qx;
#pragma unroll
  for (int j = 0; j < 8; ++j) qx[j] = (h == 0 && j < 3) ? (short)0x3F80 : (short)0;
  f16x8 uf[2];
#pragma unroll
  for (int s2 = 0; s2 < 2; ++s2)
#pragma unroll
    for (int j = 0; j < 8; ++j) uf[s2][j] = ((16 * s2 + 8 * (j >> 2) + 4 * h + (j & 3)) >= r) ? (_Float16)1.f : (_Float16)0.f;
  float* coff = (float*)(smem + ATT_TAB_OFF + 1040);
  float cref = 0.f;
  float qk_bound = 0.f, cbn = 0.f, cbc = 0.f;
  if (MODE == 1) {
    float n2 = 0.f;
#pragma unroll
    for (int ks = 0; ks < 4; ++ks)
#pragma unroll
      for (int j = 0; j < 8; ++j) { const float v = bf2f((u16)qf[ks][j]); n2 += v * v; }
    n2 += __shfl_xor(n2, 32);
    const float k2 = __uint_as_float(__hip_atomic_load(p.ctr + 48 + l * 8 + bh, __ATOMIC_RELAXED, __HIP_MEMORY_SCOPE_AGENT));
    qk_bound = sqrtf(n2) * sqrtf(k2) * 1.02f + 1e-3f;
  }

  const int lrow = tid >> 3, lch = tid & 7;
  const u16* kbase = p.P + ((size_t)b * SEQ + lrow) * PC + kcol + hh * 64 + lch * 8;
  const u16* vbase = p.Vt + ((size_t)(br * 2 + b) * 256 + hh * 64 + lrow) * VTLD + lch * 8;
  constexpr int STG2 = 2 * STAGE_BYTES;
  float* tab2 = (float*)(smem + 2 * STG2);
  float* coff2 = tab2 + 260;
  const int csub = (tid >> 6) & 1, ckey = tid & 63;
  uint4 kr0, kr1, vr0, vr1; float cval = 0.f, coffv = 0.f;
#define ATT_LOAD(KT_) do { const int k0_ = (KT_) * 64; \
    kr0 = *(const uint4*)(kbase + (size_t)k0_ * PC); kr1 = *(const uint4*)(kbase + (size_t)(k0_ - 64) * PC); \
    vr0 = *(const uint4*)(vbase + k0_); vr1 = *(const uint4*)(vbase + k0_ - 64); \
    if (MODE == 1) { cbn = p.csum[((size_t)b * SEQ + k0_ - 64) * 4 + hh] + coff2[(k0_ - 64) >> 10]; } \
    if (MODE == 1 && tid < 128) { const int kk_ = k0_ - 64 * csub; cval = p.csum[((size_t)b * SEQ + kk_ + ckey) * 4 + hh]; coffv = coff2[kk_ >> 10]; } } while (0)
#define ATT_STORE(STG_) do { u16* Kt_ = (u16*)(smem + (STG_) * STG2); u16* Vs_ = Kt_ + 64 * KST; \
    u16* Kt1_ = (u16*)(smem + (STG_) * STG2 + STAGE_BYTES); u16* Vs1_ = Kt1_ + 64 * KST; \
    *(uint4*)(Kt_ + lrow * KST + lch * 8) = kr0; *(uint4*)(Kt1_ + lrow * KST + lch * 8) = kr1; \
    *(uint2*)(Vs_ + lrow * VST + lch * 8) = make_uint2(vr0.x, vr0.y); *(uint2*)(Vs_ + lrow * VST + lch * 8 + 4) = make_uint2(vr0.z, vr0.w); \
    *(uint2*)(Vs1_ + lrow * VST + lch * 8) = make_uint2(vr1.x, vr1.y); *(uint2*)(Vs1_ + lrow * VST + lch * 8 + 4) = make_uint2(vr1.z, vr1.w); \
    if (MODE == 1 && tid < 128) { const float val_ = cref - (cval + coffv); const u16 c1_ = f2bf(val_); const float r1_ = val_ - bf2f(c1_); \
      const u16 c2_ = f2bf(r1_); const u16 c3_ = f2bf(r1_ - bf2f(c2_)); \
      uint4 e0_; e0_.x = (unsigned)c1_ | ((unsigned)c2_ << 16); e0_.y = (unsigned)c3_; e0_.z = 0u; e0_.w = 0u; \
      u16* ke_ = (csub ? Kt1_ : Kt_) + ckey * KST + 64; \
      *(uint4*)ke_ = e0_; *(uint4*)(ke_ + 8) = make_uint4(0u, 0u, 0u, 0u); } } while (0)

  __syncthreads();
  if (MODE == 0) { for (int i = tid; i < 257; i += NTHR) tab2[i] = p.rel_bias[(size_t)(l * 4 + hh) * 257 + i] * LOG2E; }
  if (MODE == 1) {
    if (tid < 16) { float a = 0.f; for (int c = 0; c < tid; ++c) a += p.ctot[(b * 16 + c) * 4 + hh]; coff2[tid] = a; }
    __syncthreads();
    cref = p.csum[((size_t)b * SEQ + q0) * 4 + hh] + coff2[q0 >> 10];
  }
  ATT_LOAD(hi);
  ATT_STORE(0);
  cbc = cbn;
  ATT_LOAD(max(hi - 2, lo + 1));
  __syncthreads();

  f32x16 O[2];
#pragma unroll
  for (int i = 0; i < 16; ++i) { O[0][i] = 0.f; O[1][i] = 0.f; }
  float m = -1e30f, lsum = 0.f, carry = 0.f;
  int stage = 0;
  bool wdone = false;
  const int cw = qs0 >> 6;
#pragma unroll 1
  for (int kp = hi; kp > lo; kp -= 2) {
    const float cb_next = cbn;
    ATT_STORE(stage ^ 1);
    __builtin_amdgcn_sched_barrier(0);
    ATT_LOAD(max(kp - 4, lo + 1));
    __builtin_amdgcn_sched_barrier(0);
    if (!(MODE == 2 && wdone)) {
#pragma unroll
    for (int sub = 0; sub < 2; ++sub) {
      const int kt = kp - sub;
      const u16* Kt = (const u16*)(smem + stage * STG2 + sub * STAGE_BYTES);
      const u16* Vs = Kt + 64 * KST;
      const int k0 = kt * 64;
      if (MODE == 0) {
        if (kt <= cw && kt >= cw - 8) attn_tile2<0>(Kt, Vs, (qs0 - k0 - 63 >= 128), r, h, qf, qx, uf, tab2, t - k0, O, m, lsum, carry);
      } else {
        if (k0 + 32 <= qs0) attn_tile2<MODE>(Kt, Vs, (k0 + 32 == qs0), r, h, qf, qx, uf, tab2, 0, O, m, lsum, carry);
        else if (k0 <= qs0) attn_subtile<MODE>(Kt, Vs, 0, (k0 == qs0), r, h, qf, qx, uf, tab2, 0, O, m, lsum, carry);
      }
    }
    }
    if (MODE == 2) {
      wdone = __all(carry > 160.f) != 0;
      if (__syncthreads_and(wdone ? 1 : 0)) break;
    } else if (MODE == 1) {
      const bool z = (m > -1e29f) && (qk_bound + (cref - cbc) - m < -165.f);
      if (__syncthreads_and(__all(z) ? 1 : 0)) break;
      cbc = cb_next;
    } else {
      __syncthreads();
    }
    stage ^= 1;
  }
#undef ATT_LOAD
#undef ATT_STORE
  if (MODE != 2) {
    const float lt = lsum + __shfl_xor(lsum, 32);
    const float inv = 1.f / lt;
#pragma unroll
    for (int i = 0; i < 16; ++i) { O[0][i] *= inv; O[1][i] *= inv; }
  }
  float ss = 0.f;
#pragma unroll
  for (int i = 0; i < 16; ++i) ss += O[0][i] * O[0][i] + O[1][i] * O[1][i];
  ss += __shfl_xor(ss, 32);
  if (h == 0) p.ssq[tok * 16 + br * 4 + hh] = ss;
  uint2 gq[2][4];
#pragma unroll
  for (int mt = 0; mt < 2; ++mt)
#pragma unroll
    for (int gi = 0; gi < 4; ++gi) gq[mt][gi] = *(const uint2*)(p.P + tok * PC + gcol + hh * 64 + 32 * mt + 8 * gi + 4 * h);
#pragma unroll
  for (int mt = 0; mt < 2; ++mt)
#pragma unroll
    for (int gi = 0; gi < 4; ++gi) {
      const int d0 = 32 * mt + 8 * gi + 4 * h;
      const uint2 g = gq[mt][gi];
      uint2 z;
      z.x = pk2(O[mt][4 * gi] * bflo(g.x), O[mt][4 * gi + 1] * bfhi(g.x));
      z.y = pk2(O[mt][4 * gi + 2] * bflo(g.y), O[mt][4 * gi + 3] * bfhi(g.y));
      *(uint2*)(p.Z + ((size_t)(br * 4 + hh) * TT + tok) * 64 + d0) = z;
    }
}

__device__ void naive_gmlp_item(const Params& p, int l, int item, unsigned char* smem) {
  float (*vn)[64] = (float (*)[64])smem;
  float* mu = (float*)(smem + 32768);
  float* rstd = mu + 128;
  float* red = rstd + 128;
  const int tid = otid(), b = item >> 7, ch = item & 127, s0 = ch * 128;
  const u16* vt = p.Vt + (size_t)(1 * 2 + b) * 256 * SEQ;
  {
    const int tkn = tid & 127, half = tid >> 7;
    float s1 = 0.f, s2 = 0.f;
    for (int cc = 0; cc < 128; ++cc) { float v = bf2f(vt[(size_t)(half * 128 + cc) * SEQ + s0 + tkn]); s1 += v; s2 += v * v; }
    __syncthreads();
    red[tid] = s1; red[256 + tid] = s2;
    __syncthreads();
    if (tid < 128) {
      float a1 = red[tid] + red[tid + 128], a2 = red[256 + tid] + red[256 + tid + 128];
      float mean = a1 * (1.f / 256.f);
      float var = a2 * (1.f / 256.f) - mean * mean;
      mu[tid] = mean; rstd[tid] = rsqrtf(fmaxf(var, 0.f) + EPS);
    }
    __syncthreads();
  }
  const int tkn = tid >> 1, c0 = (tid & 1) * 32;
  const size_t tok = (size_t)b * SEQ + s0 + tkn;
  for (int g = 0; g < 4; ++g) {
    __syncthreads();
    for (int i = 0; i < 32; ++i) {
      const int idx = tid + 256 * i, cc = idx >> 7, s = idx & 127;
      float v = bf2f(vt[(size_t)(g * 64 + cc) * SEQ + s0 + s]);
      vn[s][cc] = (v - mu[s]) * rstd[s] * p.v_gain[l * 256 + g * 64 + cc];
    }
    __syncthreads();
    float acc[32];
#pragma unroll
    for (int i = 0; i < 32; ++i) acc[i] = 0.f;
    const float* wrow = p.w_s + ((size_t)(l * 4 + g) * 128 + tkn) * 128;
    for (int s = 0; s <= tkn; ++s) {
      const float wv = wrow[s];
#pragma unroll
      for (int i = 0; i < 32; ++i) acc[i] += wv * vn[s][c0 + i];
    }
    const float bs = p.b_s[(size_t)(l * 4 + g) * 128 + tkn];
    float ss = 0.f;
#pragma unroll
    for (int i8 = 0; i8 < 4; ++i8) {
      uint4 uu = *(const uint4*)(p.P + tok * PC + BU + g * 64 + c0 + i8 * 8);
      uint4 gg = *(const uint4*)(p.P + tok * PC + BG + g * 64 + c0 + i8 * 8);
      float y[8];
      y[0] = bflo(uu.x) * (acc[i8 * 8 + 0] + bs); y[1] = bfhi(uu.x) * (acc[i8 * 8 + 1] + bs);
      y[2] = bflo(uu.y) * (acc[i8 * 8 + 2] + bs); y[3] = bfhi(uu.y) * (acc[i8 * 8 + 3] + bs);
      y[4] = bflo(uu.z) * (acc[i8 * 8 + 4] + bs); y[5] = bfhi(uu.z) * (acc[i8 * 8 + 5] + bs);
      y[6] = bflo(uu.w) * (acc[i8 * 8 + 6] + bs); y[7] = bfhi(uu.w) * (acc[i8 * 8 + 7] + bs);
#pragma unroll
      for (int e = 0; e < 8; ++e) ss += y[e] * y[e];
      uint4 z;
      z.x = pk2(y[0] * bflo(gg.x), y[1] * bfhi(gg.x)); z.y = pk2(y[2] * bflo(gg.y), y[3] * bfhi(gg.y));
      z.z = pk2(y[4] * bflo(gg.z), y[5] * bfhi(gg.z)); z.w = pk2(y[6] * bflo(gg.w), y[7] * bfhi(gg.w));
      *(uint4*)(p.Z + tok * 1024 + 256 + g * 64 + c0 + i8 * 8) = z;
    }
    ss += __shfl_xor(ss, 1);
    if ((tid & 1) == 0) p.ssq[tok * 16 + 4 + g] = ss;
  }
}


__device__ void gmlp_item(const Params& p, int l, int item2, unsigned char* smem0) {
  constexpr int GST = 136;
  const int tid512 = otid(), wg = tid512 >> 8;
  const int item = item2 * 2 + wg;
  unsigned char* smem = smem0 + wg * 24576;
  u16* vt = (u16*)smem;
  float* mu = (float*)(smem + 64 * GST * 2);
  float* rstd = mu + 128;
  float* red = rstd + 128;
  const int tid = tid512 & 255, lane = tid & 63, w = tid >> 6, r = lane & 31, h = lane >> 5;
  const int b = item >> 7, ch = item & 127, s0 = ch * 128;
  const u16* gv = p.Vt + (size_t)(1 * 2 + b) * 256 * VTLD + s0;
  const int lr = tid >> 4, lc = tid & 15;
  const int tk = tid & 127, half = tid >> 7;
  float s1 = 0.f, s2 = 0.f;
#pragma unroll 1
  for (int g = 0; g < 4; ++g) {
    __syncthreads();
    {
      uint4 tmp[4];
#pragma unroll
      for (int j = 0; j < 4; ++j) tmp[j] = *(const uint4*)(gv + (size_t)(g * 64 + lr + 16 * j) * VTLD + lc * 8);
#pragma unroll
      for (int j = 0; j < 4; ++j) *(uint4*)(vt + (lr + 16 * j) * GST + lc * 8) = tmp[j];
    }
    __syncthreads();
#pragma unroll 8
    for (int cc = 0; cc < 32; ++cc) { const float v = bf2f(vt[(half * 32 + cc) * GST + tk]); s1 += v; s2 += v * v; }
  }
  red[tid] = s1; red[256 + tid] = s2;
  __syncthreads();
  if (tid < 128) {
    const float a1 = red[tid] + red[tid + 128], a2 = red[256 + tid] + red[256 + tid + 128];
    const float mean = a1 * (1.f / 256.f);
    const float var = a2 * (1.f / 256.f) - mean * mean;
    mu[tid] = mean; rstd[tid] = rsqrtf(fmaxf(var, 0.f) + EPS);
  }
  __syncthreads();
  const float mm = mu[tk], rs = rstd[tk];
  const int t = 32 * w + r;
  const size_t tok = (size_t)b * SEQ + s0 + t;
  const int nks = 2 * (w + 1);
#pragma unroll 1
  for (int g = 0; g < 4; ++g) {
    __syncthreads();
    bf16x8 bw[8];
    {
      const u16* wrow = p.Ws16 + ((size_t)(l * 4 + g) * 128 + t) * 128 + 8 * h;
      uint4 tmp[4];
#pragma unroll
      for (int j = 0; j < 4; ++j) tmp[j] = *(const uint4*)(gv + (size_t)(g * 64 + lr + 16 * j) * VTLD + lc * 8);
#pragma unroll
      for (int ks = 0; ks < 8; ++ks) bw[ks] = *(const bf16x8*)(wrow + 16 * ks);
#pragma unroll
      for (int j = 0; j < 4; ++j) *(uint4*)(vt + (lr + 16 * j) * GST + lc * 8) = tmp[j];
    }
    __syncthreads();
    {
      const float* vg = p.v_gain + l * 256 + g * 64 + half * 32;
#pragma unroll 8
      for (int cc = 0; cc < 32; ++cc) {
        u16* q = vt + (half * 32 + cc) * GST + tk;
        *q = f2bf((bf2f(*q) - mm) * rs * vg[cc]);
      }
    }
    __syncthreads();
    f32x16 acc0, acc1;
#pragma unroll
    for (int i = 0; i < 16; ++i) { acc0[i] = 0.f; acc1[i] = 0.f; }
    uint2 uq[2][4], gq[2][4];
#pragma unroll
    for (int mt = 0; mt < 2; ++mt)
#pragma unroll
      for (int gi = 0; gi < 4; ++gi) {
        const int c = g * 64 + 32 * mt + 8 * gi + 4 * h;
        uq[mt][gi] = *(const uint2*)(p.P + tok * PC + BU + c);
        gq[mt][gi] = *(const uint2*)(p.P + tok * PC + BG + c);
      }
    const u16* a0p = vt + r * GST + 8 * h;
    const u16* a1p = a0p + 32 * GST;
#pragma unroll
    for (int ks = 0; ks < 8; ++ks) {
      const bf16x8 a0 = *(const bf16x8*)(a0p + 16 * ks), a1 = *(const bf16x8*)(a1p + 16 * ks);
      acc0 = MFMA(a0, bw[ks], acc0);
      acc1 = MFMA(a1, bw[ks], acc1);
    }
    const float bs = p.b_s[(size_t)(l * 4 + g) * 128 + t];
    float ss = 0.f;
#pragma unroll
    for (int mt = 0; mt < 2; ++mt)
#pragma unroll
      for (int gi = 0; gi < 4; ++gi) {
        const int c = g * 64 + 32 * mt + 8 * gi + 4 * h;
        const uint2 uu = uq[mt][gi];
        const uint2 gg = gq[mt][gi];
        float y[4];
        y[0] = bflo(uu.x) * ((mt ? acc1[4 * gi] : acc0[4 * gi]) + bs);
        y[1] = bfhi(uu.x) * ((mt ? acc1[4 * gi + 1] : acc0[4 * gi + 1]) + bs);
        y[2] = bflo(uu.y) * ((mt ? acc1[4 * gi + 2] : acc0[4 * gi + 2]) + bs);
        y[3] = bfhi(uu.y) * ((mt ? acc1[4 * gi + 3] : acc0[4 * gi + 3]) + bs);
        ss += y[0] * y[0] + y[1] * y[1] + y[2] * y[2] + y[3] * y[3];
        uint2 z;
        z.x = pk2(y[0] * bflo(gg.x), y[1] * bfhi(gg.x));
        z.y = pk2(y[2] * bflo(gg.y), y[3] * bfhi(gg.y));
        *(uint2*)(p.Z + ((size_t)(4 + g) * TT + tok) * 64 + (c & 63)) = z;
      }
    ss += __shfl_xor(ss, 32);
    if (h == 0) p.ssq[tok * 16 + 4 + g] = ss;
  }
}

#ifndef NAIVE_A
#define NAIVE_A 0
#endif
#ifndef NAIVE_C
#define NAIVE_C 0
#endif
#ifndef NAIVE_D
#define NAIVE_D 0
#endif
__device__ void phase_mix(const Params& p, int l, unsigned char* smem, int ctr_off, int only = -1) {
  __shared__ int s_item;
  unsigned* ctr = p.ctr + (ctr_off + l) * 8;
  constexpr int NITEMS = 512 + 512 + 512 + 128;
  (void)only;
  for (;;) {
    if (threadIdx.x == 0) s_item = (int)atomicAdd(ctr, 1u);
    __syncthreads();
    const int item = s_item;
    __syncthreads();
    if (item >= NITEMS) break;
    if (item < 128) {
      gmlp_item(p, l, item, smem);
    } else if (item < 640) {
      const int j = item - 128;
      attn_item<1>(p, l, j & 7, 63 - (j >> 3), smem);
    } else if (item < 1152) {
      const int j = item - 640;
      attn_item<0>(p, l, j & 7, j >> 3, smem);
    } else {
      const int j = item - 1152;
      attn_item<2>(p, l, j & 7, 63 - (j >> 3), smem);
    }
  }
}

DI void run_phase(const Params& p, int ph, unsigned char* smem) {
  if (ph == 0) { phase_pre(p, smem); return; }
  if (ph == 9) { phase_final(p); return; }
  const int l = (ph - 1) >> 2, s = (ph - 1) & 3;
  if (s == 0) phase_norm(p, l);
  else if (s == 1) phase_gemm_in(p, l, smem);
  else if (s == 2) phase_mix(p, l, smem, 0);
  else phase_gemm_out(p, l, smem);
}

#if !COOP
template <int KIND>
__global__ void __launch_bounds__(256, (KIND == 3) ? 1 : 2) mk_phase(Params p, int l) {
  __shared__ __attribute__((aligned(16))) unsigned char smem[SMEM_BYTES];
  if (KIND == 0) phase_pre(p, smem);
  else if (KIND == 1) phase_norm(p, l);
  else if (KIND == 2) phase_gemm_in(p, l, smem);
  else if (KIND == 3) phase_mix(p, l, smem, 0);
  else if (KIND == 4) phase_gemm_out(p, l, smem);
  else phase_final(p);
}
#endif

#if COOP

#define XB_TMO      128
#define XB_XCNT(j)  (256  + 64 * (j))
#define XB_XSUB(j)  (1280 + 64 * (j))
#define XB_XGEN(j)  (2304 + 64 * (j))
#define XB_TOP      3328
#define XB_TOPGEN   3392
#define XCD_BAR_WORDS 3456
#define XB_SPIN_CAP (1u << 18)
#define LAS __attribute__((address_space(3)))
DI unsigned xb_ld(unsigned* p) { return __hip_atomic_load(p, __ATOMIC_RELAXED, __HIP_MEMORY_SCOPE_AGENT); }
DI unsigned xb_add(unsigned* p, unsigned v) { return __hip_atomic_fetch_add(p, v, __ATOMIC_RELAXED, __HIP_MEMORY_SCOPE_AGENT); }
DI unsigned xb_xcc_id() { return (unsigned)__builtin_amdgcn_s_getreg((3 << 11) | 20) & 0xFu; }
#define XB_SPIN(cond, bar) do { unsigned _sp = 0; while (cond) { __builtin_amdgcn_s_sleep(1); \
    if ((++_sp & 255u) == 0u) { if (xb_ld(&(bar)[XB_TMO])) break; if (_sp > XB_SPIN_CAP) { atomicAdd(&(bar)[XB_TMO], 1u); break; } } } } while (0)
struct XcdBarrier { unsigned* bar; unsigned x; volatile LAS unsigned* st; };
DI XcdBarrier xcd_barrier_post(unsigned* bar, volatile LAS unsigned* st) {
  XcdBarrier b; b.bar = bar; b.x = xb_xcc_id(); b.st = st;
  if (threadIdx.x == 0) (void)xb_add(&bar[XB_XCNT(b.x)], 1u);
  return b;
}
DI void xcd_barrier_complete(unsigned* bar, unsigned x, unsigned& nloc, unsigned& nx) {
  const unsigned G = gridDim.x * gridDim.y * gridDim.z;
  unsigned sum, cnt, mine, sp = 0u;
  for (;;) {
    sum = 0u; cnt = 0u; mine = 0u;
#pragma unroll
    for (unsigned j = 0; j < 16; ++j) { const unsigned c = xb_ld(&bar[XB_XCNT(j)]); sum += c; cnt += (c > 0u) ? 1u : 0u; mine = (j == x) ? c : mine; }
    if (sum == G) break;
    __builtin_amdgcn_s_sleep(1);
    if ((++sp & 255u) == 0u) { if (xb_ld(&bar[XB_TMO])) break; if (sp > XB_SPIN_CAP) { atomicAdd(&bar[XB_TMO], 1u); break; } }
  }
  nloc = mine > 0u ? mine : 1u; nx = cnt > 0u ? cnt : 1u;
}
DI void xcd_barrier(const XcdBarrier& b) {
  asm volatile("s_waitcnt vmcnt(0)" ::: "memory");
  __syncthreads();
  if (threadIdx.x == 0) {
    unsigned* bar = b.bar;
    __builtin_amdgcn_s_waitcnt(0);
    unsigned nloc = b.st[0], nx = b.st[1];
    if (nloc == 0u) { xcd_barrier_complete(bar, b.x, nloc, nx); b.st[0] = nloc; b.st[1] = nx; }
    const unsigned old = xb_add(&bar[XB_XSUB(b.x)], 1u);
    const unsigned gen = old / nloc;
    if (old + 1u == (gen + 1u) * nloc) {
      __builtin_amdgcn_fence(__ATOMIC_RELEASE, "agent");
      asm volatile("s_waitcnt vmcnt(0)" ::: "memory");
      const unsigned og = xb_add(&bar[XB_TOP], 1u);
      const unsigned tg = og / nx;
      if (og + 1u == (tg + 1u) * nx) xb_add(&bar[XB_TOPGEN], 1u);
      else XB_SPIN(xb_ld(&bar[XB_TOPGEN]) == tg, bar);
      __builtin_amdgcn_fence(__ATOMIC_ACQUIRE, "agent");
      xb_add(&bar[XB_XGEN(b.x)], 1u);
      asm volatile("s_waitcnt vmcnt(0)" ::: "memory");
    } else {
      XB_SPIN(xb_ld(&bar[XB_XGEN(b.x)]) == gen, bar);
      __builtin_amdgcn_fence(__ATOMIC_ACQUIRE, "agent");
      asm volatile("s_waitcnt vmcnt(0)" ::: "memory");
    }
  }
  __syncthreads();
}

__global__ void __launch_bounds__(512, COOP_MINB) mk_coop(Params p) {
  __shared__ __attribute__((aligned(16))) unsigned char smem[SMEM_BYTES];
  __shared__ __attribute__((aligned(16))) unsigned xb_words[4];
  cg::grid_group grid = cg::this_grid();
  if (threadIdx.x < 4) xb_words[threadIdx.x] = 0u;
  __syncthreads();
  const XcdBarrier xb = xcd_barrier_post(p.bar, (volatile LAS unsigned*)xb_words);
  phase_pre(p, smem);
  grid.sync();
#pragma unroll 1
  for (int l = 0; l < 2; ++l) {
    phase_norm(p, l);
    xcd_barrier(xb);
#if PROBE_DUP == 3
    phase_norm(p, l);
    xcd_barrier(xb);
#endif
    phase_gemm_in(p, l, smem);
    xcd_barrier(xb);
#if PROBE_DUP == 1
    phase_gemm_in(p, l, smem);
    xcd_barrier(xb);
#endif
    phase_mix(p, l, smem, 0);
    xcd_barrier(xb);
#if PROBE_DUP == 2
    phase_mix(p, l, smem, 2, PROBE_ONLY);
    xcd_barrier(xb);
#endif
#if PROBE_DUP == 4
    if (l == 0) { phase_gemm_out(p, l, smem); xcd_barrier(xb); }
#endif
    phase_gemm_out(p, l, smem);
    xcd_barrier(xb);
  }
#if PROBE_DUP == 5
  for (int i = 0; i < 10; ++i) xcd_barrier(xb);
#endif
  phase_final(p);
}
#endif

extern "C" void kernel_launch(void* const* d_in, const int* in_sizes, int n_in, void* d_out, int out_size, void* d_ws,
                              size_t ws_size, hipStream_t stream) {
  Params p{};
  p.x = (const float*)d_in[0]; p.norm_g = (const float*)d_in[1]; p.w_in = (const float*)d_in[2]; p.b_f = (const float*)d_in[3];
  p.rel_bias = (const float*)d_in[4]; p.w_s = (const float*)d_in[5]; p.b_s = (const float*)d_in[6]; p.v_gain = (const float*)d_in[7];
  p.branch_gain = (const float*)d_in[8]; p.w_out = (const float*)d_in[9]; p.final_g = (const float*)d_in[10];
  p.out = (float*)d_out;
  unsigned char* ws = (unsigned char*)d_ws;
  size_t off = 0;
  auto carve = [&](size_t bytes) { unsigned char* q = ws + off; off += (bytes + 255) & ~(size_t)255; return q; };
  p.WtIn = (u16*)carve((size_t)2 * NW * 1024 * 2);
  p.WtOut = (u16*)carve((size_t)2 * 1024 * 1024 * 2);
  p.Ws16 = (u16*)carve((size_t)2 * 4 * 128 * 128 * 2);
  p.H = (u16*)carve((size_t)TT * 1024 * 2);
  p.P = (u16*)carve((size_t)TT * PC * 2);
  p.Vt = (u16*)carve((size_t)4 * 2 * 256 * VTLD * 2);
  p.Z = (u16*)carve((size_t)TT * 1024 * 2);
  p.lsf = (float*)carve((size_t)TT * 4 * 4);
  p.csum = (float*)carve((size_t)TT * 4 * 4);
  p.ssq = (float*)carve((size_t)TT * 16 * 4);
  p.ctot = (float*)carve(32 * 4 * 4);
  p.Wf = (float*)carve(2 * 1024 * 4 * 4);
  p.ctr = (unsigned*)carve(256);
  p.bar = (unsigned*)carve(XCD_BAR_WORDS * 4);
  static int grid_blocks = 0;
  if (!grid_blocks) {
    int dev = 0, cus = 0, per_cu = 0;
    hipGetDevice(&dev);
    hipDeviceGetAttribute(&cus, hipDeviceAttributeMultiprocessorCount, dev);
#if COOP
    hipOccupancyMaxActiveBlocksPerMultiprocessor(&per_cu, mk_coop, 256, 0);
#else
    hipOccupancyMaxActiveBlocksPerMultiprocessor(&per_cu, mk_phase<3>, 256, 0);
#endif
    (void)per_cu;
    grid_blocks = cus;
  }
#if COOP
  hipMemsetAsync(p.bar, 0, XCD_BAR_WORDS * 4, stream);
  void* args[] = {&p};
  hipError_t e = hipLaunchCooperativeKernel((void*)mk_coop, dim3(grid_blocks), dim3(512), args, 0, stream);
  if (e != hipSuccess) fprintf(stderr, "cooperative launch failed: %s (grid %d)\n", hipGetErrorString(e), grid_blocks);
#else
  mk_phase<0><<<grid_blocks, 256, 0, stream>>>(p, 0);
  for (int l = 0; l < 2; ++l) {
    mk_phase<1><<<grid_blocks, 256, 0, stream>>>(p, l);
    mk_phase<2><<<grid_blocks, 256, 0, stream>>>(p, l);
    mk_phase<3><<<grid_blocks, 256, 0, stream>>>(p, l);
    mk_phase<4><<<grid_blocks, 256, 0, stream>>>(p, l);
  }
  mk_phase<5><<<grid_blocks, 256, 0, stream>>>(p, 0);
#endif
}
```

```cpp
#include <hip/hip_runtime.h>
#include <hip/hip_cooperative_groups.h>
#include <cstdio>
namespace cg = cooperative_groups;

#ifndef COOP
#define COOP 1
#endif
#ifndef PROBE_ONLY
#define PROBE_ONLY 2
#endif
#ifndef PROBE_DUP
#define PROBE_DUP 0
#endif
#ifndef COOP_MINB
#define COOP_MINB 2
#endif

#define DI __device__ __forceinline__
typedef unsigned short u16;
typedef __attribute__((ext_vector_type(8))) short bf16x8;
typedef __attribute__((ext_vector_type(16))) float f32x16;
typedef __attribute__((ext_vector_type(2))) __bf16 bf16v2;
#define MFMA(a, b, c) __builtin_amdgcn_mfma_f32_32x32x16_bf16((a), (b), (c), 0, 0, 0)

constexpr int SEQ = 16384, TT = 32768, DM = 1024, NIN = 3844, NW = 3840, PC = 2816;
constexpr float EPS = 1e-6f, LOG2E = 1.4426950408889634f;
constexpr float QSCALE = 0.125f * LOG2E;
constexpr int AQ = 0, AK = 256, AG = 512, BU = 768, BG = 1024, CQ = 1280, CK = 1536, CG = 1792, DQ = 2048, DK = 2304, DG = 2560;
constexpr int SMEM_BYTES = 131072;
constexpr int NTHR = 512;
constexpr int VTLD = SEQ + 64;

struct Params {
  const float *x, *norm_g, *w_in, *b_f, *rel_bias, *w_s, *b_s, *v_gain, *branch_gain, *w_out, *final_g;
  float* out;
  u16 *WtIn, *WtOut, *Ws16, *H, *P, *Vt, *Z;
  float *lsf, *csum, *ssq, *ctot, *Wf;
  unsigned* ctr;
  unsigned* bar;
};

DI unsigned pk2(float a, float b) { bf16v2 v; v[0] = (__bf16)a; v[1] = (__bf16)b; return __builtin_bit_cast(unsigned, v); }
DI u16 f2bf(float a) { return __builtin_bit_cast(u16, (__bf16)a); }
DI float bf2f(u16 h) { return __uint_as_float(((unsigned)h) << 16); }
DI float bflo(unsigned u) { return __uint_as_float(u << 16); }
DI float bfhi(unsigned u) { return __uint_as_float(u & 0xffff0000u); }
DI int otid() { int t = threadIdx.x; asm volatile("" : "+v"(t)); return t; }
DI float wave_sum(float v) { for (int o = 32; o > 0; o >>= 1) v += __shfl_xor(v, o); return v; }

__device__ void phase_pre(const Params& p, unsigned char* smem) {
  float (*tile)[65] = (float (*)[65])smem;
  const int tid = otid(), tx = tid & 63, ty = tid >> 6;
  const int nA = 2 * 60 * 16, nB = 2 * 16 * 16;
  for (int it = blockIdx.x; it < nA + nB; it += gridDim.x) {
    const float* src; u16* dst; int ld_src, n0, k0, srcoff, nrows;
    if (it < nA) {
      int l = it / 960, rem = it % 960, ntile = rem / 16, ktile = rem % 16;
      n0 = ntile * 64; k0 = ktile * 64;
      src = p.w_in + (size_t)l * 1024 * NIN; ld_src = NIN; dst = p.WtIn + (size_t)l * NW * 1024; srcoff = (n0 >= 2816) ? 4 : 0; nrows = NW;
    } else {
      int j = it - nA; int l = j / 256, rem = j % 256, ntile = rem / 16, ktile = rem % 16;
      n0 = ntile * 64; k0 = ktile * 64;
      src = p.w_out + (size_t)l * 1024 * 1024; ld_src = 1024; dst = p.WtOut + (size_t)l * 1024 * 1024; srcoff = 0; nrows = 1024;
    }
    __syncthreads();
#pragma unroll 4
    for (int i = 0; i < 8; ++i) { int k = ty + 8 * i; tile[k][tx] = src[(size_t)(k0 + k) * ld_src + n0 + srcoff + tx]; }
    __syncthreads();
#pragma unroll 4
    for (int i = 0; i < 8; ++i) { int n = ty + 8 * i; dst[((size_t)(k0 >> 6) * nrows + n0 + n) * 64 + tx] = f2bf(tile[tx][n]); }
  }
  for (int idx = blockIdx.x * NTHR + tid; idx < 2 * 4 * 128 * 128; idx += gridDim.x * NTHR) {
    int t = (idx >> 7) & 127, s = idx & 127;
    p.Ws16[idx] = (s <= t) ? f2bf(p.w_s[idx]) : (u16)0;
  }
  for (int idx = blockIdx.x * NTHR + tid; idx < 2 * 1024; idx += gridDim.x * NTHR) {
    const int l = idx >> 10, k = idx & 1023;
    *(float4*)(p.Wf + (size_t)idx * 4) = *(const float4*)(p.w_in + ((size_t)l * 1024 + k) * NIN + 2816);
  }
  if (blockIdx.x == 0 && tid < 64) p.ctr[tid] = 0u;
}

__device__ void phase_norm(const Params& p, int l) {
  const float* src = (l == 0) ? p.x : p.out;
  const int tid_ = otid();
  const int lane = tid_ & 63;
  const int gw = blockIdx.x * 8 + (tid_ >> 6), nw = gridDim.x * 8;
  const float4* g4 = (const float4*)(p.norm_g + l * 1024);
  const float4* wf4 = (const float4*)(p.Wf + (size_t)l * 4096);
  float4 gr[4], w0[4], w1[4], w2[4], w3[4];
#pragma unroll
  for (int j = 0; j < 4; ++j) {
    const int k = 4 * (lane + 64 * j);
    gr[j] = g4[lane + 64 * j];
    w0[j] = wf4[k]; w1[j] = wf4[k + 1]; w2[j] = wf4[k + 2]; w3[j] = wf4[k + 3];
  }
  const float bf0 = p.b_f[l * 4 + 0], bf1 = p.b_f[l * 4 + 1], bf2 = p.b_f[l * 4 + 2], bf3 = p.b_f[l * 4 + 3];
  for (int row0 = gw * 4; row0 < TT; row0 += nw * 4) {
    float4 v[4][4]; float ss[4] = {0.f, 0.f, 0.f, 0.f};
#pragma unroll
    for (int q = 0; q < 4; ++q) {
      const float4* xr = (const float4*)(src + (size_t)(row0 + q) * 1024);
#pragma unroll
      for (int j = 0; j < 4; ++j) v[q][j] = xr[lane + 64 * j];
    }
#pragma unroll
    for (int q = 0; q < 4; ++q)
#pragma unroll
      for (int j = 0; j < 4; ++j) ss[q] += v[q][j].x * v[q][j].x + v[q][j].y * v[q][j].y + v[q][j].z * v[q][j].z + v[q][j].w * v[q][j].w;
    ss[0] = wave_sum(ss[0]); ss[1] = wave_sum(ss[1]); ss[2] = wave_sum(ss[2]); ss[3] = wave_sum(ss[3]);
#pragma unroll
    for (int q = 0; q < 4; ++q) {
      const int row = row0 + q;
      const float rinv = rsqrtf(ss[q] * (1.f / 1024.f) + EPS);
      float f0 = 0.f, f1 = 0.f, f2 = 0.f, f3 = 0.f;
#pragma unroll
      for (int j = 0; j < 4; ++j) {
        const float h0 = v[q][j].x * rinv * gr[j].x, h1 = v[q][j].y * rinv * gr[j].y, h2 = v[q][j].z * rinv * gr[j].z, h3 = v[q][j].w * rinv * gr[j].w;
        uint2 o; o.x = pk2(h0, h1); o.y = pk2(h2, h3);
        { const int col = 4 * (lane + 64 * j); *(uint2*)(p.H + ((size_t)(col >> 6) * TT + row) * 64 + (col & 63)) = o; }
        f0 += h0 * w0[j].x + h1 * w1[j].x + h2 * w2[j].x + h3 * w3[j].x;
        f1 += h0 * w0[j].y + h1 * w1[j].y + h2 * w2[j].y + h3 * w3[j].y;
        f2 += h0 * w0[j].z + h1 * w1[j].z + h2 * w2[j].z + h3 * w3[j].z;
        f3 += h0 * w0[j].w + h1 * w1[j].w + h2 * w2[j].w + h3 * w3[j].w;
      }
      f0 = wave_sum(f0); f1 = wave_sum(f1); f2 = wave_sum(f2); f3 = wave_sum(f3);
      if (lane == 0) {
        float4 o;
        o.x = f0 + bf0; o.y = f1 + bf1; o.z = f2 + bf2; o.w = f3 + bf3;
        o.x = (fminf(o.x, 0.f) - log1pf(expf(-fabsf(o.x)))) * LOG2E;
        o.y = (fminf(o.y, 0.f) - log1pf(expf(-fabsf(o.y)))) * LOG2E;
        o.z = (fminf(o.z, 0.f) - log1pf(expf(-fabsf(o.z)))) * LOG2E;
        o.w = (fminf(o.w, 0.f) - log1pf(expf(-fabsf(o.w)))) * LOG2E;
        *(float4*)(p.lsf + (size_t)row * 4) = o;
      }
    }
  }
}

__device__ void scan_chunk(const Params& p, int chunk, unsigned char* smem) {
  float4* wtot = (float4*)smem;
  const int tid = otid(), lane = tid & 63, w = tid >> 6;
  const bool act = tid < 256;
  const int ti = act ? tid : 0;
  const float4* in = (const float4*)p.lsf + (size_t)chunk * 1024 + ti * 4;
  float4 v0 = in[0], v1 = in[1], v2 = in[2], v3 = in[3];
  v1.x += v0.x; v1.y += v0.y; v1.z += v0.z; v1.w += v0.w;
  v2.x += v1.x; v2.y += v1.y; v2.z += v1.z; v2.w += v1.w;
  v3.x += v2.x; v3.y += v2.y; v3.z += v2.z; v3.w += v2.w;
  float4 inc = v3;
#pragma unroll
  for (int o = 1; o < 64; o <<= 1) {
    float4 n;
    n.x = __shfl_up(inc.x, o); n.y = __shfl_up(inc.y, o); n.z = __shfl_up(inc.z, o); n.w = __shfl_up(inc.w, o);
    if (lane >= o) { inc.x += n.x; inc.y += n.y; inc.z += n.z; inc.w += n.w; }
  }
  __syncthreads();
  if (act && lane == 63) wtot[w] = inc;
  __syncthreads();
  float4 pre = make_float4(inc.x - v3.x, inc.y - v3.y, inc.z - v3.z, inc.w - v3.w);
  float4 all = make_float4(0.f, 0.f, 0.f, 0.f);
#pragma unroll
  for (int i = 0; i < 4; ++i) {
    float4 t = wtot[i];
    if (i < w) { pre.x += t.x; pre.y += t.y; pre.z += t.z; pre.w += t.w; }
    all.x += t.x; all.y += t.y; all.z += t.z; all.w += t.w;
  }
  if (act) {
    float4* outp = (float4*)p.csum + (size_t)chunk * 1024 + tid * 4;
    outp[0] = make_float4(v0.x + pre.x, v0.y + pre.y, v0.z + pre.z, v0.w + pre.w);
    outp[1] = make_float4(v1.x + pre.x, v1.y + pre.y, v1.z + pre.z, v1.w + pre.w);
    outp[2] = make_float4(v2.x + pre.x, v2.y + pre.y, v2.z + pre.z, v2.w + pre.w);
    outp[3] = make_float4(v3.x + pre.x, v3.y + pre.y, v3.z + pre.z, v3.w + pre.w);
    if (tid == 0) ((float4*)p.ctot)[chunk] = all;
  }
  __syncthreads();
}

typedef u16 (*lds_tile_t)[72];
#define G_LOAD(A_, NR_, m0_, kt_, R_) do { const u16* gp_ = (A_) + ((size_t)(kt_) * (NR_) + (m0_) + (tid >> 3)) * 64 + (tid & 7) * 8; \
    R_##0 = *(const uint4*)gp_; R_##1 = *(const uint4*)(gp_ + 32 * 64); R_##2 = *(const uint4*)(gp_ + 64 * 64); R_##3 = *(const uint4*)(gp_ + 96 * 64); } while (0)
#define S_STORE(S_, R_) do { u16* sp_ = &(S_)[tid >> 3][(tid & 7) * 8]; \
    *(uint4*)sp_ = R_##0; *(uint4*)(sp_ + 32 * 72) = R_##1; *(uint4*)(sp_ + 64 * 72) = R_##2; *(uint4*)(sp_ + 96 * 72) = R_##3; } while (0)
template <bool SWAP>
DI void gemm_ktile(lds_tile_t As, lds_tile_t Bs, f32x16 (&acc)[2][2], int wm, int wn, int r, int h) {
  bf16x8 af[4][2], bfr[4][2];
  const u16* ap = &As[wm * 64 + r][h * 8];
  const u16* bp = &Bs[wn * 64 + r][h * 8];
#pragma unroll
  for (int ks = 0; ks < 4; ++ks) {
    af[ks][0] = *(const bf16x8*)(ap + ks * 16); af[ks][1] = *(const bf16x8*)(ap + 32 * 72 + ks * 16);
    bfr[ks][0] = *(const bf16x8*)(bp + ks * 16); bfr[ks][1] = *(const bf16x8*)(bp + 32 * 72 + ks * 16);
  }
  __builtin_amdgcn_sched_barrier(0);
#pragma unroll
  for (int ks = 0; ks < 4; ++ks)
#pragma unroll
    for (int mi = 0; mi < 2; ++mi)
#pragma unroll
      for (int ni = 0; ni < 2; ++ni)
        acc[mi][ni] = SWAP ? MFMA(bfr[ks][ni], af[ks][mi], acc[mi][ni]) : MFMA(af[ks][mi], bfr[ks][ni], acc[mi][ni]);
}

#define GL_STAGE(GA_, NRA_, m0_, GB_, NRB_, n0_, T32_, SBASE_) do { _Pragma("unroll") for (int j_ = 0; j_ < 2; ++j_) { \
    const int q_ = j_ * 512 + tid, rw_ = q_ >> 2, kc_ = (q_ & 3) ^ ((rw_ >> 2) & 3); \
    __builtin_amdgcn_global_load_lds((const unsigned*)((GA_) + ((size_t)((T32_) >> 1) * (NRA_) + (m0_) + rw_) * 64 + ((T32_) & 1) * 32 + kc_ * 8), \
        (__attribute__((address_space(3))) unsigned*)((SBASE_) + q_ * 16), 16, 0, 0); \
    __builtin_amdgcn_global_load_lds((const unsigned*)((GB_) + ((size_t)((T32_) >> 1) * (NRB_) + (n0_) + rw_) * 64 + ((T32_) & 1) * 32 + kc_ * 8), \
        (__attribute__((address_space(3))) unsigned*)((SBASE_) + 16384 + q_ * 16), 16, 0, 0); } } while (0)
#define GL_WAIT_BAR() do { asm volatile("s_waitcnt vmcnt(8)" ::: "memory"); __builtin_amdgcn_s_barrier(); asm volatile("" ::: "memory"); } while (0)
DI unsigned frag_addr(unsigned base, int row, int kc) { return base + row * 64 + ((kc ^ ((row >> 2) & 3)) << 4); }
template <bool SWAP>
DI void gemm_ktile32(const unsigned char* St, f32x16 (&acc)[4][2], int wm, int wn, int r, int h) {
  const unsigned sa = (unsigned)(size_t)St, sbb = sa + 16384;
  const int ra = wm * 128 + r, rb = wn * 64 + r;
  bf16x8 a0[4], a1[4], b0[2], b1[2];
  asm volatile(
      "ds_read_b128 %0, %6\n\tds_read_b128 %1, %7\n\tds_read_b128 %4, %10\n\tds_read_b128 %5, %11\n\t"
      "ds_read_b128 %2, %8\n\tds_read_b128 %3, %9\n\t"
      "s_waitcnt lgkmcnt(0)"
      : "=&v"(a0[0]), "=&v"(a0[1]), "=&v"(a0[2]), "=&v"(a0[3]), "=&v"(b0[0]), "=&v"(b0[1])
      : "v"(frag_addr(sa, ra, h)), "v"(frag_addr(sa, ra + 32, h)), "v"(frag_addr(sa, ra + 64, h)), "v"(frag_addr(sa, ra + 96, h)),
        "v"(frag_addr(sbb, rb, h)), "v"(frag_addr(sbb, rb + 32, h))
      : "memory");
  asm volatile(
      "ds_read_b128 %0, %6\n\tds_read_b128 %1, %7\n\tds_read_b128 %4, %10\n\tds_read_b128 %5, %11\n\t"
      "ds_read_b128 %2, %8\n\tds_read_b128 %3, %9"
      : "=&v"(a1[0]), "=&v"(a1[1]), "=&v"(a1[2]), "=&v"(a1[3]), "=&v"(b1[0]), "=&v"(b1[1])
      : "v"(frag_addr(sa, ra, 2 + h)), "v"(frag_addr(sa, ra + 32, 2 + h)), "v"(frag_addr(sa, ra + 64, 2 + h)), "v"(frag_addr(sa, ra + 96, 2 + h)),
        "v"(frag_addr(sbb, rb, 2 + h)), "v"(frag_addr(sbb, rb + 32, 2 + h))
      : "memory");
  __builtin_amdgcn_sched_barrier(0);
#pragma unroll
  for (int mi = 0; mi < 4; ++mi)
#pragma unroll
    for (int ni = 0; ni < 2; ++ni) acc[mi][ni] = SWAP ? MFMA(b0[ni], a0[mi], acc[mi][ni]) : MFMA(a0[mi], b0[ni], acc[mi][ni]);
  __builtin_amdgcn_sched_barrier(0);
  asm volatile("s_waitcnt lgkmcnt(0)"
               : "+v"(a1[0]), "+v"(a1[1]), "+v"(a1[2]), "+v"(a1[3]), "+v"(b1[0]), "+v"(b1[1]) : : "memory");
#pragma unroll
  for (int mi = 0; mi < 4; ++mi)
#pragma unroll
    for (int ni = 0; ni < 2; ++ni) acc[mi][ni] = SWAP ? MFMA(b1[ni], a1[mi], acc[mi][ni]) : MFMA(a1[mi], b1[ni], acc[mi][ni]);
}
typedef unsigned u32x2w __attribute__((ext_vector_type(2)));
DI uint4 widen_pair(uint2 ev, uint2 od) {
  const u32x2w a = __builtin_amdgcn_permlane32_swap(ev.x, od.x, false, false);
  const u32x2w b = __builtin_amdgcn_permlane32_swap(ev.y, od.y, false, false);
  return make_uint4(a[0], b[0], a[1], b[1]);
}
DI int sec_pcol(int s) { int nv = (s > 2) + (s > 5) + (s > 9) + (s > 13); return (s - nv) * 256; }
DI int sec_branch(int s) { return (s < 4) ? 0 : (s < 7) ? 1 : (s < 11) ? 2 : 3; }

template <bool SWAP>
DI void gemm_mainloop(const u16* A, const u16* B, int nrb, int m0, int n0, unsigned char* smem, f32x16 (&acc)[4][2]) {
  const int tid = otid(), lane = tid & 63, w = tid >> 6, wm = w >> 2, wn = w & 3, r = lane & 31, h = lane >> 5;
  GL_STAGE(A, TT, m0, B, nrb, n0, 0, smem);
  GL_STAGE(A, TT, m0, B, nrb, n0, 1, smem + 32768);
  GL_STAGE(A, TT, m0, B, nrb, n0, 2, smem + 65536);
#pragma unroll 1
  for (int t = 0; t < 32; ++t) {
    GL_WAIT_BAR();
    { const int t3 = min(t + 3, 31); GL_STAGE(A, TT, m0, B, nrb, n0, t3, smem + ((t + 3) & 3) * 32768); }
    gemm_ktile32<SWAP>(smem + (t & 3) * 32768, acc, wm, wn, r, h);
  }
  asm volatile("s_waitcnt vmcnt(0)" ::: "memory");
  __syncthreads();
}

__device__ void gemm_in_tile(const Params& p, int l, int mt, int sec, unsigned char* smem) {
  const int m0 = mt * 256, n0 = sec * 256;
  const bool is_vt = (sec == 2 || sec == 5 || sec == 9 || sec == 13);
  const bool is_q = (sec == 0 || sec == 7 || sec == 11);
  const bool is_gate = (sec == 3 || sec == 6 || sec == 10 || sec == 14);
  const int br = sec_branch(sec);
  const int tid = otid(), lane = tid & 63, w = tid >> 6, wm = w >> 2, wn = w & 3, r = lane & 31, h = lane >> 5;
  const u16* A = p.H;
  const u16* B = p.WtIn + (size_t)l * NW * 1024;
  f32x16 acc[4][2];
#pragma unroll
  for (int mi = 0; mi < 4; ++mi)
#pragma unroll
    for (int ni = 0; ni < 2; ++ni)
#pragma unroll
      for (int i = 0; i < 16; ++i) acc[mi][ni][i] = 0.f;
  if (is_vt) {
    gemm_mainloop<false>(A, B, NW, m0, n0, smem, acc);
#pragma unroll
    for (int mi = 0; mi < 4; ++mi)
#pragma unroll
      for (int ni = 0; ni < 2; ++ni) {
        const int c = wn * 64 + ni * 32 + r;
#pragma unroll
        for (int gp = 0; gp < 2; ++gp) {
          uint2 ev, od;
          ev.x = pk2(acc[mi][ni][8 * gp], acc[mi][ni][8 * gp + 1]); ev.y = pk2(acc[mi][ni][8 * gp + 2], acc[mi][ni][8 * gp + 3]);
          od.x = pk2(acc[mi][ni][8 * gp + 4], acc[mi][ni][8 * gp + 5]); od.y = pk2(acc[mi][ni][8 * gp + 6], acc[mi][ni][8 * gp + 7]);
          const uint4 o = widen_pair(ev, od);
          const int t0 = m0 + wm * 128 + mi * 32 + 8 * (2 * gp + h);
          const int b = t0 >> 14, sq = t0 & (SEQ - 1);
          *(uint4*)(p.Vt + ((size_t)(br * 2 + b) * 256 + c) * VTLD + sq) = o;
        }
      }
  } else {
    gemm_mainloop<true>(A, B, NW, m0, n0, smem, acc);
    const int pcol = sec_pcol(sec);
    const float* gain = p.branch_gain + (size_t)(l * 4 + br) * 256;
    if (sec == 8) {
      float mx2 = 0.f;
#pragma unroll
      for (int mi = 0; mi < 4; ++mi) {
        float n2 = 0.f;
#pragma unroll
        for (int ni = 0; ni < 2; ++ni)
#pragma unroll
          for (int i = 0; i < 16; ++i) n2 += acc[mi][ni][i] * acc[mi][ni][i];
        n2 += __shfl_xor(n2, 32);
        mx2 = fmaxf(mx2, n2);
      }
#pragma unroll
      for (int o = 16; o > 0; o >>= 1) mx2 = fmaxf(mx2, __shfl_xor(mx2, o));
      if (lane == 0) atomicMax(p.ctr + 48 + l * 8 + (m0 >> 14) * 4 + wn, __float_as_uint(mx2));
    }
#pragma unroll
    for (int mi = 0; mi < 4; ++mi)
#pragma unroll
      for (int ni = 0; ni < 2; ++ni) {
        const int t = m0 + wm * 128 + mi * 32 + r;
        uint2 og[4];
#pragma unroll
        for (int gi = 0; gi < 4; ++gi) {
          const int nl = wn * 64 + ni * 32 + 8 * gi + 4 * h;
          float v[4];
#pragma unroll
          for (int e = 0; e < 4; ++e) v[e] = acc[mi][ni][4 * gi + e];
          if (is_q) {
#pragma unroll
            for (int e = 0; e < 4; ++e) v[e] *= QSCALE;
          } else if (is_gate) {
            float4 gg = *(const float4*)(gain + nl);
            const float* gp = (const float*)&gg;
#pragma unroll
            for (int e = 0; e < 4; ++e) v[e] = gp[e] * v[e] / (1.f + __expf(-v[e]));
          }
          og[gi].x = pk2(v[0], v[1]); og[gi].y = pk2(v[2], v[3]);
        }
#pragma unroll
        for (int gp = 0; gp < 2; ++gp) {
          const uint4 o = widen_pair(og[2 * gp], og[2 * gp + 1]);
          const int nl8 = wn * 64 + ni * 32 + 8 * (2 * gp + h);
          *(uint4*)(p.P + (size_t)t * PC + pcol + nl8) = o;
        }
      }
  }
}

__device__ void phase_gemm_in(const Params& p, int l, unsigned char* smem) {
  for (int c = (int)gridDim.x - 1 - (int)blockIdx.x; c < 32; c += gridDim.x) scan_chunk(p, c, smem);
  const int xcd = blockIdx.x & 7, slot = blockIdx.x >> 3, nslot = gridDim.x >> 3;
  for (int j = slot; j < 240; j += nslot) {
    const int mg = j / 120, rem = j % 120;
    const int ng = (rem >= 96) ? 3 : (rem >> 5), idx = rem - ng * 32;
    const int mt = xcd * 16 + mg * 8 + (idx & 7), sec = ng * 4 + (idx >> 3);
    gemm_in_tile(p, l, mt, sec, smem);
  }
}

__device__ void gemm_out_tile(const Params& p, int l, int mt, int nt, unsigned char* smem) {
  const int m0 = mt * 256, n0 = nt * 256;
  const int tid = otid(), lane = tid & 63, w = tid >> 6, wm = w >> 2, wn = w & 3, r = lane & 31, h = lane >> 5;
  const u16* A = p.Z;
  const u16* B = p.WtOut + (size_t)l * 1024 * 1024;
  const float* resid = (l == 0) ? p.x : p.out;
  float fold[4][4];
#pragma unroll
  for (int mi = 0; mi < 4; ++mi) {
    const int t = m0 + wm * 128 + mi * 32 + r;
    float rv[4];
#pragma unroll
    for (int br = 0; br < 4; ++br) {
      float4 sq = *(const float4*)(p.ssq + (size_t)t * 16 + br * 4);
      rv[br] = rsqrtf((sq.x + sq.y + sq.z + sq.w) * (1.f / 256.f) + EPS);
    }
    fold[mi][0] = rv[0] / rv[1]; fold[mi][1] = rv[1] / rv[2]; fold[mi][2] = rv[2] / rv[3]; fold[mi][3] = rv[3];
  }
  f32x16 acc[4][2];
#pragma unroll
  for (int mi = 0; mi < 4; ++mi)
#pragma unroll
    for (int ni = 0; ni < 2; ++ni)
#pragma unroll
      for (int i = 0; i < 16; ++i) acc[mi][ni][i] = 0.f;
  GL_STAGE(A, TT, m0, B, 1024, n0, 0, smem);
  GL_STAGE(A, TT, m0, B, 1024, n0, 1, smem + 32768);
  GL_STAGE(A, TT, m0, B, 1024, n0, 2, smem + 65536);
#pragma unroll 1
  for (int t = 0; t < 32; ++t) {
    GL_WAIT_BAR();
    { const int t3 = min(t + 3, 31); GL_STAGE(A, TT, m0, B, 1024, n0, t3, smem + ((t + 3) & 3) * 32768); }
    gemm_ktile32<true>(smem + (t & 3) * 32768, acc, wm, wn, r, h);
    if ((t & 7) == 7) {
      const int br = t >> 3;
#pragma unroll
      for (int mi = 0; mi < 4; ++mi) {
        const float f = (br == 0) ? fold[mi][0] : (br == 1) ? fold[mi][1] : (br == 2) ? fold[mi][2] : fold[mi][3];
#pragma unroll
        for (int ni = 0; ni < 2; ++ni)
#pragma unroll
          for (int i = 0; i < 16; ++i) acc[mi][ni][i] *= f;
      }
    }
  }
  asm volatile("s_waitcnt vmcnt(0)" ::: "memory");
  __syncthreads();
#pragma unroll
  for (int mi = 0; mi < 4; ++mi)
#pragma unroll
    for (int ni = 0; ni < 2; ++ni) {
      const int t = m0 + wm * 128 + mi * 32 + r;
#pragma unroll
      for (int gi = 0; gi < 4; ++gi) {
        const int d = n0 + wn * 64 + ni * 32 + 8 * gi + 4 * h;
        float4 rs = *(const float4*)(resid + (size_t)t * 1024 + d);
        rs.x += acc[mi][ni][4 * gi]; rs.y += acc[mi][ni][4 * gi + 1]; rs.z += acc[mi][ni][4 * gi + 2]; rs.w += acc[mi][ni][4 * gi + 3];
        *(float4*)(p.out + (size_t)t * 1024 + d) = rs;
      }
    }
}

__device__ void phase_gemm_out(const Params& p, int l, unsigned char* smem) {
  const int xcd = blockIdx.x & 7, slot = blockIdx.x >> 3, nslot = gridDim.x >> 3;
  for (int j = slot; j < 64; j += nslot) {
    const int mg = j >> 5, idx = j & 31;
    gemm_out_tile(p, l, xcd * 16 + mg * 8 + (idx & 7), idx >> 3, smem);
  }
}

__device__ void phase_final(const Params& p) {
  const int tid_ = otid();
  const int lane = tid_ & 63;
  const int gw = blockIdx.x * 8 + (tid_ >> 6), nw = gridDim.x * 8;
  const float4* g4 = (const float4*)p.final_g;
  float4 gr[4];
#pragma unroll
  for (int j = 0; j < 4; ++j) gr[j] = g4[lane + 64 * j];
  for (int row0 = gw * 4; row0 < TT; row0 += nw * 4) {
    float4 v[4][4]; float ss[4] = {0.f, 0.f, 0.f, 0.f};
#pragma unroll
    for (int q = 0; q < 4; ++q) {
      const float4* xr = (const float4*)(p.out + (size_t)(row0 + q) * 1024);
#pragma unroll
      for (int j = 0; j < 4; ++j) v[q][j] = xr[lane + 64 * j];
    }
#pragma unroll
    for (int q = 0; q < 4; ++q)
#pragma unroll
      for (int j = 0; j < 4; ++j) ss[q] += v[q][j].x * v[q][j].x + v[q][j].y * v[q][j].y + v[q][j].z * v[q][j].z + v[q][j].w * v[q][j].w;
    ss[0] = wave_sum(ss[0]); ss[1] = wave_sum(ss[1]); ss[2] = wave_sum(ss[2]); ss[3] = wave_sum(ss[3]);
#pragma unroll
    for (int q = 0; q < 4; ++q) {
      float4* xr = (float4*)(p.out + (size_t)(row0 + q) * 1024);
      const float rinv = rsqrtf(ss[q] * (1.f / 1024.f) + EPS);
#pragma unroll
      for (int j = 0; j < 4; ++j) {
        float4 o; o.x = v[q][j].x * rinv * gr[j].x; o.y = v[q][j].y * rinv * gr[j].y; o.z = v[q][j].z * rinv * gr[j].z; o.w = v[q][j].w * rinv * gr[j].w;
        xr[lane + 64 * j] = o;
      }
    }
  }
}

template <int MODE>
__device__ void naive_attn_item(const Params& p, int l, int bh, int qb, unsigned char* smem) {
  float (*Ks)[64] = (float (*)[64])smem;
  float (*Vs)[64] = (float (*)[64])(smem + 16384);
  const int tid = otid(), b = bh >> 2, hh = bh & 3;
  const int qcol = MODE == 0 ? AQ : MODE == 1 ? CQ : DQ, kcol = MODE == 0 ? AK : MODE == 1 ? CK : DK, gcol = MODE == 0 ? AG : MODE == 1 ? CG : DG;
  const int br = MODE == 0 ? 0 : MODE == 1 ? 2 : 3;
  const int t = qb * 256 + tid;
  const size_t tok = (size_t)b * SEQ + t;
  unsigned q2[32]; float o[64];
#pragma unroll
  for (int d8 = 0; d8 < 8; ++d8) {
    uint4 u = *(const uint4*)(p.P + tok * PC + qcol + hh * 64 + d8 * 8);
    q2[d8 * 4 + 0] = u.x; q2[d8 * 4 + 1] = u.y; q2[d8 * 4 + 2] = u.z; q2[d8 * 4 + 3] = u.w;
  }
#pragma unroll
  for (int d = 0; d < 64; ++d) o[d] = 0.f;
  float m = -INFINITY, lsum = 0.f, carry = 0.f;
  const int hi = qb * 4 + 3;
  const int lo = (MODE == 0) ? max(0, qb * 4 - 8) : 0;
  const int c = t >> 6;
  const float* bias = p.rel_bias + (size_t)(l * 4 + hh) * 257;
  for (int kt = hi; kt >= lo; --kt) {
    __syncthreads();
#pragma unroll 4
    for (int i = 0; i < 16; ++i) {
      const int idx = tid + 256 * i, a = idx >> 6, bb = idx & 63;
      Ks[a][bb] = bf2f(p.P[((size_t)b * SEQ + kt * 64 + a) * PC + kcol + hh * 64 + bb]);
      Vs[bb][a] = bf2f(p.Vt[((size_t)(br * 2 + b) * 256 + hh * 64 + a) * SEQ + kt * 64 + bb]);
    }
    __syncthreads();
    bool tile_ok = true;
    if (MODE == 0) tile_ok = (kt >= c - 8) && (kt <= c);
    if (MODE != 0) tile_ok = (kt * 64 <= t);
    if (!tile_ok) continue;
    for (int j = 63; j >= 0; --j) {
      const int kpos = kt * 64 + j;
      if (MODE == 1 && kpos > t) continue;
      if (MODE == 2 && kpos >= t) continue;
      float dot = 0.f;
#pragma unroll
      for (int d = 0; d < 32; ++d) dot += bflo(q2[d]) * Ks[j][2 * d] + bfhi(q2[d]) * Ks[j][2 * d + 1];
      float pw;
      if (MODE == 2) {
        const float sp = __log2f(1.f + exp2f(dot));
        pw = exp2f(dot - sp - carry);
        carry += sp;
      } else {
        float u;
        if (MODE == 0) { int rel = min(max(t - kpos, -128), 128) + 128; u = dot + bias[rel] * LOG2E; }
        else u = dot - p.csum[((size_t)b * SEQ + kpos) * 4 + hh];
        if (u > m) {
          const float sc = exp2f(m - u);
          lsum *= sc;
#pragma unroll
          for (int d = 0; d < 64; ++d) o[d] *= sc;
          m = u;
        }
        pw = exp2f(u - m);
        lsum += pw;
      }
#pragma unroll
      for (int d = 0; d < 64; ++d) o[d] += pw * Vs[j][d];
    }
  }
  if (MODE != 2) {
    const float inv = 1.f / lsum;
#pragma unroll
    for (int d = 0; d < 64; ++d) o[d] *= inv;
  }
  float ss = 0.f;
#pragma unroll
  for (int d = 0; d < 64; ++d) ss += o[d] * o[d];
  p.ssq[tok * 16 + br * 4 + hh] = ss;
#pragma unroll
  for (int d8 = 0; d8 < 8; ++d8) {
    uint4 g = *(const uint4*)(p.P + tok * PC + gcol + hh * 64 + d8 * 8);
    uint4 z;
    z.x = pk2(o[d8 * 8 + 0] * bflo(g.x), o[d8 * 8 + 1] * bfhi(g.x));
    z.y = pk2(o[d8 * 8 + 2] * bflo(g.y), o[d8 * 8 + 3] * bfhi(g.y));
    z.z = pk2(o[d8 * 8 + 4] * bflo(g.z), o[d8 * 8 + 5] * bfhi(g.z));
    z.w = pk2(o[d8 * 8 + 6] * bflo(g.w), o[d8 * 8 + 7] * bfhi(g.w));
    *(uint4*)(p.Z + tok * 1024 + br * 256 + hh * 64 + d8 * 8) = z;
  }
}


typedef _Float16 f16x8 __attribute__((ext_vector_type(8)));
typedef _Float16 f16v2 __attribute__((ext_vector_type(2)));
typedef unsigned u32x4 __attribute__((ext_vector_type(4)));
#define MFMA_F16(a, b, c) __builtin_amdgcn_mfma_f32_32x32x16_f16((a), (b), (c), 0, 0, 0)
constexpr int KST = 88, VST = 68;
constexpr int STAGE_BYTES = 64 * KST * 2 + 64 * VST * 2;
constexpr int ATT_TAB_OFF = 2 * STAGE_BYTES;

DI int crow(int i, int h) { return (i & 3) + 8 * (i >> 2) + 4 * h; }
DI unsigned pkh2(float a, float b) { f16v2 v; v[0] = (_Float16)a; v[1] = (_Float16)b; return __builtin_bit_cast(unsigned, v); }
DI float ex2(float x) { return __builtin_amdgcn_exp2f(x); }
DI float lg2(float x) { return __builtin_amdgcn_logf(x); }

template <int MODE>
DI void attn_subtile(const u16* Kt, const u16* Vs, int st, bool diag, int r, int h, const bf16x8 (&qf)[4], bf16x8 qx,
                     const f16x8 (&uf)[2], const float* tab, int dist0, f32x16 (&O)[2], float& m, float& lsum, float& carry) {
  f32x16 s;
#pragma unroll
  for (int i = 0; i < 16; ++i) s[i] = 0.f;
  const u16* kp = Kt + (32 * st + r) * KST + 8 * h;
#pragma unroll
  for (int ks = 0; ks < 4; ++ks) s = MFMA(*(const bf16x8*)(kp + 16 * ks), qf[ks], s);
  if (MODE == 1) s = MFMA(*(const bf16x8*)(kp + 64), qx, s);
  f32x16 pv;
  if (MODE == 2) {
    f32x16 sp;
#pragma unroll
    for (int i = 0; i < 16; ++i) sp[i] = lg2(1.f + ex2(s[i]));
    if (diag) {
#pragma unroll
      for (int i = 0; i < 16; ++i) if (crow(i, h) >= r) sp[i] = 0.f;
    }
    u32x4 a0, a1;
#pragma unroll
    for (int j = 0; j < 4; ++j) { a0[j] = pkh2(sp[2 * j], sp[2 * j + 1]); a1[j] = pkh2(sp[8 + 2 * j], sp[8 + 2 * j + 1]); }
    f32x16 cs;
#pragma unroll
    for (int i = 0; i < 16; ++i) cs[i] = carry;
    cs = MFMA_F16(uf[0], __builtin_bit_cast(f16x8, a0), cs);
    cs = MFMA_F16(uf[1], __builtin_bit_cast(f16x8, a1), cs);
#pragma unroll
    for (int i = 0; i < 16; ++i) pv[i] = ex2(s[i] - cs[i]);
    if (diag) {
#pragma unroll
      for (int i = 0; i < 16; ++i) if (crow(i, h) >= r) pv[i] = 0.f;
    }
    carry = __shfl(cs[0], r);
  } else {
    if (MODE == 0) {
#pragma unroll
      for (int i = 0; i < 16; ++i) { int idx = min(max(dist0 - crow(i, h), -128), 128) + 128; s[i] += tab[idx]; }
    }
    if (MODE == 1 && diag) {
#pragma unroll
      for (int i = 0; i < 16; ++i) if (crow(i, h) > r) s[i] = -1e30f;
    }
    float mx = s[0];
#pragma unroll
    for (int i = 1; i < 16; ++i) mx = fmaxf(mx, s[i]);
    mx = fmaxf(mx, __shfl_xor(mx, 32));
    if (__any(mx > m)) {
      const float mn = fmaxf(m, mx);
      const float al = ex2(m - mn);
      m = mn; lsum *= al;
#pragma unroll
      for (int i = 0; i < 16; ++i) { O[0][i] *= al; O[1][i] *= al; }
    }
    float rs = 0.f;
#pragma unroll
    for (int i = 0; i < 16; ++i) { pv[i] = ex2(s[i] - m); rs += pv[i]; }
    lsum += rs;
  }
#pragma unroll
  for (int s2 = 0; s2 < 2; ++s2) {
    u32x4 pp;
#pragma unroll
    for (int j = 0; j < 4; ++j) pp[j] = pk2(pv[8 * s2 + 2 * j], pv[8 * s2 + 2 * j + 1]);
    const bf16x8 pf = __builtin_bit_cast(bf16x8, pp);
#pragma unroll
    for (int mt = 0; mt < 2; ++mt) {
      const u16* vp = Vs + (32 * mt + r) * VST + 32 * st + 16 * s2 + 4 * h;
      const uint2 v0 = *(const uint2*)vp, v1 = *(const uint2*)(vp + 8);
      u32x4 vv; vv[0] = v0.x; vv[1] = v0.y; vv[2] = v1.x; vv[3] = v1.y;
      O[mt] = MFMA(__builtin_bit_cast(bf16x8, vv), pf, O[mt]);
    }
  }
}


template <int MODE>
DI void attn_tile2(const u16* Kt, const u16* Vs, bool diag1, int r, int h, const bf16x8 (&qf)[4], bf16x8 qx,
                   const f16x8 (&uf)[2], const float* tab, int dist0, f32x16 (&O)[2], float& m, float& lsum, float& carry) {
  f32x16 s1, s0;
#pragma unroll
  for (int i = 0; i < 16; ++i) { s1[i] = 0.f; s0[i] = 0.f; }
  const u16* kp0 = Kt + r * KST + 8 * h;
  const u16* kp1 = kp0 + 32 * KST;
#pragma unroll
  for (int ks = 0; ks < 4; ++ks) {
    s1 = MFMA(*(const bf16x8*)(kp1 + 16 * ks), qf[ks], s1);
    s0 = MFMA(*(const bf16x8*)(kp0 + 16 * ks), qf[ks], s0);
  }
  if (MODE == 1) { s1 = MFMA(*(const bf16x8*)(kp1 + 64), qx, s1); s0 = MFMA(*(const bf16x8*)(kp0 + 64), qx, s0); }
  u32x4 vf1[2][2];
#pragma unroll
  for (int s2 = 0; s2 < 2; ++s2)
#pragma unroll
    for (int mt = 0; mt < 2; ++mt) {
      const u16* vp = Vs + (32 * mt + r) * VST + 32 + 16 * s2 + 4 * h;
      const uint2 v0 = *(const uint2*)vp, v1 = *(const uint2*)(vp + 8);
      vf1[s2][mt][0] = v0.x; vf1[s2][mt][1] = v0.y; vf1[s2][mt][2] = v1.x; vf1[s2][mt][3] = v1.y;
    }
  __builtin_amdgcn_sched_barrier(0);
  f32x16 p1, p0;
  if (MODE == 2) {
    f32x16 sp1, sp0;
#pragma unroll
    for (int i = 0; i < 16; ++i) { sp1[i] = lg2(1.f + ex2(s1[i])); sp0[i] = lg2(1.f + ex2(s0[i])); }
    if (diag1) {
#pragma unroll
      for (int i = 0; i < 16; ++i) if (crow(i, h) >= r) sp1[i] = 0.f;
    }
    u32x4 a10, a11, a00, a01;
#pragma unroll
    for (int j = 0; j < 4; ++j) {
      a10[j] = pkh2(sp1[2 * j], sp1[2 * j + 1]); a11[j] = pkh2(sp1[8 + 2 * j], sp1[8 + 2 * j + 1]);
      a00[j] = pkh2(sp0[2 * j], sp0[2 * j + 1]); a01[j] = pkh2(sp0[8 + 2 * j], sp0[8 + 2 * j + 1]);
    }
    f32x16 cs1, cs0;
#pragma unroll
    for (int i = 0; i < 16; ++i) { cs1[i] = carry; cs0[i] = carry; }
    cs1 = MFMA_F16(uf[0], __builtin_bit_cast(f16x8, a10), cs1);
    cs0 = MFMA_F16(uf[0], __builtin_bit_cast(f16x8, a00), cs0);
    cs1 = MFMA_F16(uf[1], __builtin_bit_cast(f16x8, a11), cs1);
    cs0 = MFMA_F16(uf[1], __builtin_bit_cast(f16x8, a01), cs0);
#pragma unroll
    for (int i = 0; i < 16; ++i) p1[i] = ex2(s1[i] - cs1[i]);
    if (diag1) {
#pragma unroll
      for (int i = 0; i < 16; ++i) if (crow(i, h) >= r) p1[i] = 0.f;
    }
    const float tot1 = __shfl(cs1[0], r) - carry;
#pragma unroll
    for (int i = 0; i < 16; ++i) p0[i] = ex2(s0[i] - tot1 - cs0[i]);
    carry = __shfl(cs0[0], r) + tot1;
  } else {
    if (MODE == 0) {
      if (diag1) {
        const float cb = tab[256];
#pragma unroll
        for (int i = 0; i < 16; ++i) { s1[i] += cb; s0[i] += cb; }
      } else {
#pragma unroll
        for (int i = 0; i < 16; ++i) {
          const int d0 = dist0 - crow(i, h);
          s1[i] += tab[min(max(d0 - 32, -128), 128) + 128];
          s0[i] += tab[min(max(d0, -128), 128) + 128];
        }
      }
    }
    if (MODE == 1 && diag1) {
#pragma unroll
      for (int i = 0; i < 16; ++i) if (crow(i, h) > r) s1[i] = -1e30f;
    }
    float mx = fmaxf(s1[0], s0[0]);
#pragma unroll
    for (int i = 1; i < 16; ++i) mx = fmaxf(mx, fmaxf(s1[i], s0[i]));
    mx = fmaxf(mx, __shfl_xor(mx, 32));
    if (__any(mx > m)) {
      const float mn = fmaxf(m, mx);
      const float al = ex2(m - mn);
      m = mn; lsum *= al;
#pragma unroll
      for (int i = 0; i < 16; ++i) { O[0][i] *= al; O[1][i] *= al; }
    }
    float rs1 = 0.f, rs0 = 0.f;
#pragma unroll
    for (int i = 0; i < 16; ++i) { p1[i] = ex2(s1[i] - m); rs1 += p1[i]; p0[i] = ex2(s0[i] - m); rs0 += p0[i]; }
    lsum += rs1 + rs0;
  }
  __builtin_amdgcn_sched_barrier(0);
  u32x4 vf0[2][2];
#pragma unroll
  for (int s2 = 0; s2 < 2; ++s2)
#pragma unroll
    for (int mt = 0; mt < 2; ++mt) {
      const u16* vp = Vs + (32 * mt + r) * VST + 16 * s2 + 4 * h;
      const uint2 v0 = *(const uint2*)vp, v1 = *(const uint2*)(vp + 8);
      vf0[s2][mt][0] = v0.x; vf0[s2][mt][1] = v0.y; vf0[s2][mt][2] = v1.x; vf0[s2][mt][3] = v1.y;
    }
#pragma unroll
  for (int s2 = 0; s2 < 2; ++s2) {
    u32x4 pp;
#pragma unroll
    for (int j = 0; j < 4; ++j) pp[j] = pk2(p1[8 * s2 + 2 * j], p1[8 * s2 + 2 * j + 1]);
    const bf16x8 pf = __builtin_bit_cast(bf16x8, pp);
    O[0] = MFMA(__builtin_bit_cast(bf16x8, vf1[s2][0]), pf, O[0]);
    O[1] = MFMA(__builtin_bit_cast(bf16x8, vf1[s2][1]), pf, O[1]);
  }
#pragma unroll
  for (int s2 = 0; s2 < 2; ++s2) {
    u32x4 pp;
#pragma unroll
    for (int j = 0; j < 4; ++j) pp[j] = pk2(p0[8 * s2 + 2 * j], p0[8 * s2 + 2 * j + 1]);
    const bf16x8 pf = __builtin_bit_cast(bf16x8, pp);
    O[0] = MFMA(__builtin_bit_cast(bf16x8, vf0[s2][0]), pf, O[0]);
    O[1] = MFMA(__builtin_bit_cast(bf16x8, vf0[s2][1]), pf, O[1]);
  }
}

template <int MODE>
__device__ void attn_item(const Params& p, int l, int bh, int qb, unsigned char* smem) {
  const int tid = otid(), lane = tid & 63, w = tid >> 6, r = lane & 31, h = lane >> 5;
  const int b = bh >> 2, hh = bh & 3;
  const int qcol = MODE == 0 ? AQ : MODE == 1 ? CQ : DQ, kcol = MODE == 0 ? AK : MODE == 1 ? CK : DK, gcol = MODE == 0 ? AG : MODE == 1 ? CG : DG;
  const int br = MODE == 0 ? 0 : MODE == 1 ? 2 : 3;
  const int q0 = qb * 256, qs0 = q0 + 32 * w, t = qs0 + r;
  const size_t tok = (size_t)b * SEQ + t;
  const int hi = 4 * qb + 3, lo = (MODE == 0) ? max(0, 4 * qb - 8) : 0;
  float* tab = (float*)(smem + ATT_TAB_OFF);

  bf16x8 qf[4];
#pragma unroll
  for (int ks = 0; ks < 4; ++ks) qf[ks] = *(const bf16x8*)(p.P + tok * PC + qcol + hh * 64 + 16 * ks + 8 * h);
  bf16x8 qx;
#pragma unroll
  for (int j = 0; j < 8; ++j) qx[j] = (h == 0 && j < 3) ? (short)0x3F80 : (short)0;
  f16x8 uf[2];
#pragma unroll
  for (int s2 = 0; s2 < 2; ++s2)
#pragma unroll
    for (int j = 0; j < 8; ++j) uf[s2][j] = ((16 * s2 + 8 * (j >> 2) + 4 * h + (j & 3)) >= r) ? (_Float16)1.f : (_Float16)0.f;
  float* coff = (float*)(smem + ATT_TAB_OFF + 1040);
  float cref = 0.f;
  float qk_bound = 0.f, cbn = 0.f, cbc = 0.f;
  if (MODE == 1) {
    float n2 = 0.f;
#pragma unroll
    for (int ks = 0; ks < 4; ++ks)
#pragma unroll
      for (int j = 0; j < 8; ++j) { const float v = bf2f((u16)qf[ks][j]); n2 += v * v; }
    n2 += __shfl_xor(n2, 32);
    const float k2 = __uint_as_float(__hip_atomic_load(p.ctr + 48 + l * 8 + bh, __ATOMIC_RELAXED, __HIP_MEMORY_SCOPE_AGENT));
    qk_bound = sqrtf(n2) * sqrtf(k2) * 1.02f + 1e-3f;
  }

  const int lrow = tid >> 3, lch = tid & 7;
  const u16* kbase = p.P + ((size_t)b * SEQ + lrow) * PC + kcol + hh * 64 + lch * 8;
  const u16* vbase = p.Vt + ((size_t)(br * 2 + b) * 256 + hh * 64 + lrow) * VTLD + lch * 8;
  constexpr int STG2 = 2 * STAGE_BYTES;
  float* tab2 = (float*)(smem + 2 * STG2);
  float* coff2 = tab2 + 260;
  const int csub = (tid >> 6) & 1, ckey = tid & 63;
  uint4 kr0, kr1, vr0, vr1; float cval = 0.f, coffv = 0.f;
#define ATT_LOAD(KT_) do { const int k0_ = (KT_) * 64; \
    kr0 = *(const uint4*)(kbase + (size_t)k0_ * PC); kr1 = *(const uint4*)(kbase + (size_t)(k0_ - 64) * PC); \
    vr0 = *(const uint4*)(vbase + k0_); vr1 = *(const uint4*)(vbase + k0_ - 64); \
    if (MODE == 1) { cbn = p.csum[((size_t)b * SEQ + k0_ - 64) * 4 + hh] + coff2[(k0_ - 64) >> 10]; } \
    if (MODE == 1 && tid < 128) { const int kk_ = k0_ - 64 * csub; cval = p.csum[((size_t)b * SEQ + kk_ + ckey) * 4 + hh]; coffv = coff2[kk_ >> 10]; } } while (0)
#define ATT_STORE(STG_) do { u16* Kt_ = (u16*)(smem + (STG_) * STG2); u16* Vs_ = Kt_ + 64 * KST; \
    u16* Kt1_ = (u16*)(smem + (STG_) * STG2 + STAGE_BYTES); u16* Vs1_ = Kt1_ + 64 * KST; \
    *(uint4*)(Kt_ + lrow * KST + lch * 8) = kr0; *(uint4*)(Kt1_ + lrow * KST + lch * 8) = kr1; \
    *(uint2*)(Vs_ + lrow * VST + lch * 8) = make_uint2(vr0.x, vr0.y); *(uint2*)(Vs_ + lrow * VST + lch * 8 + 4) = make_uint2(vr0.z, vr0.w); \
    *(uint2*)(Vs1_ + lrow * VST + lch * 8) = make_uint2(vr1.x, vr1.y); *(uint2*)(Vs1_ + lrow * VST + lch * 8 + 4) = make_uint2(vr1.z, vr1.w); \
    if (MODE == 1 && tid < 128) { const float val_ = cref - (cval + coffv); const u16 c1_ = f2bf(val_); const float r1_ = val_ - bf2f(c1_); \
      const u16 c2_ = f2bf(r1_); const u16 c3_ = f2bf(r1_ - bf2f(c2_)); \
      uint4 e0_; e0_.x = (unsigned)c1_ | ((unsigned)c2_ << 16); e0_.y = (unsigned)c3_; e0_.z = 0u; e0_.w = 0u; \
      u16* ke_ = (csub ? Kt1_ : Kt_) + ckey * KST + 64; \
      *(uint4*)ke_ = e0_; *(uint4*)(ke_ + 8) = make_uint4(0u, 0u, 0u, 0u); } } while (0)

  __syncthreads();
  if (MODE == 0) { for (int i = tid; i < 257; i += NTHR) tab2[i] = p.rel_bias[(size_t)(l * 4 + hh) * 257 + i] * LOG2E; }
  if (MODE == 1) {
    if (tid < 16) { float a = 0.f; for (int c = 0; c < tid; ++c) a += p.ctot[(b * 16 + c) * 4 + hh]; coff2[tid] = a; }
    __syncthreads();
    cref = p.csum[((size_t)b * SEQ + q0) * 4 + hh] + coff2[q0 >> 10];
  }
  ATT_LOAD(hi);
  ATT_STORE(0);
  cbc = cbn;
  ATT_LOAD(max(hi - 2, lo + 1));
  __syncthreads();

  f32x16 O[2];
#pragma unroll
  for (int i = 0; i < 16; ++i) { O[0][i] = 0.f; O[1][i] = 0.f; }
  float m = -1e30f, lsum = 0.f, carry = 0.f;
  int stage = 0;
  bool wdone = false;
  const int cw = qs0 >> 6;
#pragma unroll 1
  for (int kp = hi; kp > lo; kp -= 2) {
    const float cb_next = cbn;
    ATT_STORE(stage ^ 1);
    __builtin_amdgcn_sched_barrier(0);
    ATT_LOAD(max(kp - 4, lo + 1));
    __builtin_amdgcn_sched_barrier(0);
    if (!(MODE == 2 && wdone)) {
#pragma unroll
    for (int sub = 0; sub < 2; ++sub) {
      const int kt = kp - sub;
      const u16* Kt = (const u16*)(smem + stage * STG2 + sub * STAGE_BYTES);
      const u16* Vs = Kt + 64 * KST;
      const int k0 = kt * 64;
      if (MODE == 0) {
        if (kt <= cw && kt >= cw - 8) attn_tile2<0>(Kt, Vs, (qs0 - k0 - 63 >= 128), r, h, qf, qx, uf, tab2, t - k0, O, m, lsum, carry);
      } else {
        if (k0 + 32 <= qs0) attn_tile2<MODE>(Kt, Vs, (k0 + 32 == qs0), r, h, qf, qx, uf, tab2, 0, O, m, lsum, carry);
        else if (k0 <= qs0) attn_subtile<MODE>(Kt, Vs, 0, (k0 == qs0), r, h, qf, qx, uf, tab2, 0, O, m, lsum, carry);
      }
    }
    }
    if (MODE == 2) {
      wdone = __all(carry > 160.f) != 0;
      if (__syncthreads_and(wdone ? 1 : 0)) break;
    } else if (MODE == 1) {
      const bool z = (m > -1e29f) && (qk_bound + (cref - cbc) - m < -165.f);
      if (__syncthreads_and(__all(z) ? 1 : 0)) break;
      cbc = cb_next;
    } else {
      __syncthreads();
    }
    stage ^= 1;
  }
#undef ATT_LOAD
#undef ATT_STORE
  if (MODE != 2) {
    const float lt = lsum + __shfl_xor(lsum, 32);
    const float inv = 1.f / lt;
#pragma unroll
    for (int i = 0; i < 16; ++i) { O[0][i] *= inv; O[1][i] *= inv; }
  }
  float ss = 0.f;
#pragma unroll
  for (int i = 0; i < 16; ++i) ss += O[0][i] * O[0][i] + O[1][i] * O[1][i];
  ss += __shfl_xor(ss, 32);
  if (h == 0) p.ssq[tok * 16 + br * 4 + hh] = ss;
  uint4 gw4[2][2];
#pragma unroll
  for (int mt = 0; mt < 2; ++mt)
#pragma unroll
    for (int gp = 0; gp < 2; ++gp) gw4[mt][gp] = *(const uint4*)(p.P + tok * PC + gcol + hh * 64 + 32 * mt + 8 * (2 * gp + h));
#pragma unroll
  for (int mt = 0; mt < 2; ++mt)
#pragma unroll
    for (int gp = 0; gp < 2; ++gp) {
      const u32x2w gx = __builtin_amdgcn_permlane32_swap(gw4[mt][gp].x, gw4[mt][gp].z, false, false);
      const u32x2w gy = __builtin_amdgcn_permlane32_swap(gw4[mt][gp].y, gw4[mt][gp].w, false, false);
      const int ie = 8 * gp, io = 8 * gp + 4;
      uint2 ze, zo;
      ze.x = pk2(O[mt][ie] * bflo(gx[0]), O[mt][ie + 1] * bfhi(gx[0])); ze.y = pk2(O[mt][ie + 2] * bflo(gy[0]), O[mt][ie + 3] * bfhi(gy[0]));
      zo.x = pk2(O[mt][io] * bflo(gx[1]), O[mt][io + 1] * bfhi(gx[1])); zo.y = pk2(O[mt][io + 2] * bflo(gy[1]), O[mt][io + 3] * bfhi(gy[1]));
      *(uint4*)(p.Z + ((size_t)(br * 4 + hh) * TT + tok) * 64 + 32 * mt + 8 * (2 * gp + h)) = widen_pair(ze, zo);
    }
}

__device__ void naive_gmlp_item(const Params& p, int l, int item, unsigned char* smem) {
  float (*vn)[64] = (float (*)[64])smem;
  float* mu = (float*)(smem + 32768);
  float* rstd = mu + 128;
  float* red = rstd + 128;
  const int tid = otid(), b = item >> 7, ch = item & 127, s0 = ch * 128;
  const u16* vt = p.Vt + (size_t)(1 * 2 + b) * 256 * SEQ;
  {
    const int tkn = tid & 127, half = tid >> 7;
    float s1 = 0.f, s2 = 0.f;
    for (int cc = 0; cc < 128; ++cc) { float v = bf2f(vt[(size_t)(half * 128 + cc) * SEQ + s0 + tkn]); s1 += v; s2 += v * v; }
    __syncthreads();
    red[tid] = s1; red[256 + tid] = s2;
    __syncthreads();
    if (tid < 128) {
      float a1 = red[tid] + red[tid + 128], a2 = red[256 + tid] + red[256 + tid + 128];
      float mean = a1 * (1.f / 256.f);
      float var = a2 * (1.f / 256.f) - mean * mean;
      mu[tid] = mean; rstd[tid] = rsqrtf(fmaxf(var, 0.f) + EPS);
    }
    __syncthreads();
  }
  const int tkn = tid >> 1, c0 = (tid & 1) * 32;
  const size_t tok = (size_t)b * SEQ + s0 + tkn;
  for (int g = 0; g < 4; ++g) {
    __syncthreads();
    for (int i = 0; i < 32; ++i) {
      const int idx = tid + 256 * i, cc = idx >> 7, s = idx & 127;
      float v = bf2f(vt[(size_t)(g * 64 + cc) * SEQ + s0 + s]);
      vn[s][cc] = (v - mu[s]) * rstd[s] * p.v_gain[l * 256 + g * 64 + cc];
    }
    __syncthreads();
    float acc[32];
#pragma unroll
    for (int i = 0; i < 32; ++i) acc[i] = 0.f;
    const float* wrow = p.w_s + ((size_t)(l * 4 + g) * 128 + tkn) * 128;
    for (int s = 0; s <= tkn; ++s) {
      const float wv = wrow[s];
#pragma unroll
      for (int i = 0; i < 32; ++i) acc[i] += wv * vn[s][c0 + i];
    }
    const float bs = p.b_s[(size_t)(l * 4 + g) * 128 + tkn];
    float ss = 0.f;
#pragma unroll
    for (int i8 = 0; i8 < 4; ++i8) {
      uint4 uu = *(const uint4*)(p.P + tok * PC + BU + g * 64 + c0 + i8 * 8);
      uint4 gg = *(const uint4*)(p.P + tok * PC + BG + g * 64 + c0 + i8 * 8);
      float y[8];
      y[0] = bflo(uu.x) * (acc[i8 * 8 + 0] + bs); y[1] = bfhi(uu.x) * (acc[i8 * 8 + 1] + bs);
      y[2] = bflo(uu.y) * (acc[i8 * 8 + 2] + bs); y[3] = bfhi(uu.y) * (acc[i8 * 8 + 3] + bs);
      y[4] = bflo(uu.z) * (acc[i8 * 8 + 4] + bs); y[5] = bfhi(uu.z) * (acc[i8 * 8 + 5] + bs);
      y[6] = bflo(uu.w) * (acc[i8 * 8 + 6] + bs); y[7] = bfhi(uu.w) * (acc[i8 * 8 + 7] + bs);
#pragma unroll
      for (int e = 0; e < 8; ++e) ss += y[e] * y[e];
      uint4 z;
      z.x = pk2(y[0] * bflo(gg.x), y[1] * bfhi(gg.x)); z.y = pk2(y[2] * bflo(gg.y), y[3] * bfhi(gg.y));
      z.z = pk2(y[4] * bflo(gg.z), y[5] * bfhi(gg.z)); z.w = pk2(y[6] * bflo(gg.w), y[7] * bfhi(gg.w));
      *(uint4*)(p.Z + tok * 1024 + 256 + g * 64 + c0 + i8 * 8) = z;
    }
    ss += __shfl_xor(ss, 1);
    if ((tid & 1) == 0) p.ssq[tok * 16 + 4 + g] = ss;
  }
}


__device__ void gmlp_item(const Params& p, int l, int item2, unsigned char* smem0) {
  constexpr int GST = 136;
  const int tid512 = otid(), wg = tid512 >> 8;
  const int item = item2 * 2 + wg;
  unsigned char* smem = smem0 + wg * 24576;
  u16* vt = (u16*)smem;
  float* mu = (float*)(smem + 64 * GST * 2);
  float* rstd = mu + 128;
  float* red = rstd + 128;
  const int tid = tid512 & 255, lane = tid & 63, w = tid >> 6, r = lane & 31, h = lane >> 5;
  const int b = item >> 7, ch = item & 127, s0 = ch * 128;
  const u16* gv = p.Vt + (size_t)(1 * 2 + b) * 256 * VTLD + s0;
  const int lr = tid >> 4, lc = tid & 15;
  const int tk = tid & 127, half = tid >> 7;
  float s1 = 0.f, s2 = 0.f;
#pragma unroll 1
  for (int g = 0; g < 4; ++g) {
    __syncthreads();
    {
      uint4 tmp[4];
#pragma unroll
      for (int j = 0; j < 4; ++j) tmp[j] = *(const uint4*)(gv + (size_t)(g * 64 + lr + 16 * j) * VTLD + lc * 8);
#pragma unroll
      for (int j = 0; j < 4; ++j) *(uint4*)(vt + (lr + 16 * j) * GST + lc * 8) = tmp[j];
    }
    __syncthreads();
#pragma unroll 8
    for (int cc = 0; cc < 32; ++cc) { const float v = bf2f(vt[(half * 32 + cc) * GST + tk]); s1 += v; s2 += v * v; }
  }
  red[tid] = s1; red[256 + tid] = s2;
  __syncthreads();
  if (tid < 128) {
    const float a1 = red[tid] + red[tid + 128], a2 = red[256 + tid] + red[256 + tid + 128];
    const float mean = a1 * (1.f / 256.f);
    const float var = a2 * (1.f / 256.f) - mean * mean;
    mu[tid] = mean; rstd[tid] = rsqrtf(fmaxf(var, 0.f) + EPS);
  }
  __syncthreads();
  const float mm = mu[tk], rs = rstd[tk];
  const int t = 32 * w + r;
  const size_t tok = (size_t)b * SEQ + s0 + t;
  const int nks = 2 * (w + 1);
#pragma unroll 1
  for (int g = 0; g < 4; ++g) {
    __syncthreads();
    bf16x8 bw[8];
    {
      const u16* wrow = p.Ws16 + ((size_t)(l * 4 + g) * 128 + t) * 128 + 8 * h;
      uint4 tmp[4];
#pragma unroll
      for (int j = 0; j < 4; ++j) tmp[j] = *(const uint4*)(gv + (size_t)(g * 64 + lr + 16 * j) * VTLD + lc * 8);
#pragma unroll
      for (int ks = 0; ks < 8; ++ks) bw[ks] = *(const bf16x8*)(wrow + 16 * ks);
#pragma unroll
      for (int j = 0; j < 4; ++j) *(uint4*)(vt + (lr + 16 * j) * GST + lc * 8) = tmp[j];
    }
    __syncthreads();
    {
      const float* vg = p.v_gain + l * 256 + g * 64 + half * 32;
#pragma unroll 8
      for (int cc = 0; cc < 32; ++cc) {
        u16* q = vt + (half * 32 + cc) * GST + tk;
        *q = f2bf((bf2f(*q) - mm) * rs * vg[cc]);
      }
    }
    __syncthreads();
    f32x16 acc0, acc1;
#pragma unroll
    for (int i = 0; i < 16; ++i) { acc0[i] = 0.f; acc1[i] = 0.f; }
    uint2 uq[2][4], gq[2][4];
#pragma unroll
    for (int mt = 0; mt < 2; ++mt)
#pragma unroll
      for (int gi = 0; gi < 4; ++gi) {
        const int c = g * 64 + 32 * mt + 8 * gi + 4 * h;
        uq[mt][gi] = *(const uint2*)(p.P + tok * PC + BU + c);
        gq[mt][gi] = *(const uint2*)(p.P + tok * PC + BG + c);
      }
    const u16* a0p = vt + r * GST + 8 * h;
    const u16* a1p = a0p + 32 * GST;
#pragma unroll
    for (int ks = 0; ks < 8; ++ks) {
      const bf16x8 a0 = *(const bf16x8*)(a0p + 16 * ks), a1 = *(const bf16x8*)(a1p + 16 * ks);
      acc0 = MFMA(a0, bw[ks], acc0);
      acc1 = MFMA(a1, bw[ks], acc1);
    }
    const float bs = p.b_s[(size_t)(l * 4 + g) * 128 + t];
    float ss = 0.f;
#pragma unroll
    for (int mt = 0; mt < 2; ++mt)
#pragma unroll
      for (int gi = 0; gi < 4; ++gi) {
        const int c = g * 64 + 32 * mt + 8 * gi + 4 * h;
        const uint2 uu = uq[mt][gi];
        const uint2 gg = gq[mt][gi];
        float y[4];
        y[0] = bflo(uu.x) * ((mt ? acc1[4 * gi] : acc0[4 * gi]) + bs);
        y[1] = bfhi(uu.x) * ((mt ? acc1[4 * gi + 1] : acc0[4 * gi + 1]) + bs);
        y[2] = bflo(uu.y) * ((mt ? acc1[4 * gi + 2] : acc0[4 * gi + 2]) + bs);
        y[3] = bfhi(uu.y) * ((mt ? acc1[4 * gi + 3] : acc0[4 * gi + 3]) + bs);
        ss += y[0] * y[0] + y[1] * y[1] + y[2] * y[2] + y[3] * y[3];
        uint2 z;
        z.x = pk2(y[0] * bflo(gg.x), y[1] * bfhi(gg.x));
        z.y = pk2(y[2] * bflo(gg.y), y[3] * bfhi(gg.y));
        *(uint2*)(p.Z + ((size_t)(4 + g) * TT + tok) * 64 + (c & 63)) = z;
      }
    ss += __shfl_xor(ss, 32);
    if (h == 0) p.ssq[tok * 16 + 4 + g] = ss;
  }
}

#ifndef NAIVE_A
#define NAIVE_A 0
#endif
#ifndef NAIVE_C
#define NAIVE_C 0
#endif
#ifndef NAIVE_D
#define NAIVE_D 0
#endif
__device__ void phase_mix(const Params& p, int l, unsigned char* smem, int ctr_off, int only = -1) {
  __shared__ int s_item;
  unsigned* ctr = p.ctr + (ctr_off + l) * 8;
  constexpr int NITEMS = 512 + 512 + 512 + 128;
  (void)only;
  for (;;) {
    if (threadIdx.x == 0) s_item = (int)atomicAdd(ctr, 1u);
    __syncthreads();
    const int item = s_item;
    __syncthreads();
    if (item >= NITEMS) break;
    if (item < 128) {
      gmlp_item(p, l, item, smem);
    } else if (item < 640) {
      const int j = item - 128;
      attn_item<1>(p, l, j & 7, 63 - (j >> 3), smem);
    } else if (item < 1152) {
      const int j = item - 640;
      attn_item<0>(p, l, j & 7, j >> 3, smem);
    } else {
      const int j = item - 1152;
      attn_item<2>(p, l, j & 7, 63 - (j >> 3), smem);
    }
  }
}

DI void run_phase(const Params& p, int ph, unsigned char* smem) {
  if (ph == 0) { phase_pre(p, smem); return; }
  if (ph == 9) { phase_final(p); return; }
  const int l = (ph - 1) >> 2, s = (ph - 1) & 3;
  if (s == 0) phase_norm(p, l);
  else if (s == 1) phase_gemm_in(p, l, smem);
  else if (s == 2) phase_mix(p, l, smem, 0);
  else phase_gemm_out(p, l, smem);
}

#if !COOP
template <int KIND>
__global__ void __launch_bounds__(256, (KIND == 3) ? 1 : 2) mk_phase(Params p, int l) {
  __shared__ __attribute__((aligned(16))) unsigned char smem[SMEM_BYTES];
  if (KIND == 0) phase_pre(p, smem);
  else if (KIND == 1) phase_norm(p, l);
  else if (KIND == 2) phase_gemm_in(p, l, smem);
  else if (KIND == 3) phase_mix(p, l, smem, 0);
  else if (KIND == 4) phase_gemm_out(p, l, smem);
  else phase_final(p);
}
#endif

#if COOP

#define XB_TMO      128
#define XB_XCNT(j)  (256  + 64 * (j))
#define XB_XSUB(j)  (1280 + 64 * (j))
#define XB_XGEN(j)  (2304 + 64 * (j))
#define XB_TOP      3328
#define XB_TOPGEN   3392
#define XCD_BAR_WORDS 3456
#define XB_SPIN_CAP (1u << 18)
#define LAS __attribute__((address_space(3)))
DI unsigned xb_ld(unsigned* p) { return __hip_atomic_load(p, __ATOMIC_RELAXED, __HIP_MEMORY_SCOPE_AGENT); }
DI unsigned xb_add(unsigned* p, unsigned v) { return __hip_atomic_fetch_add(p, v, __ATOMIC_RELAXED, __HIP_MEMORY_SCOPE_AGENT); }
DI unsigned xb_xcc_id() { return (unsigned)__builtin_amdgcn_s_getreg((3 << 11) | 20) & 0xFu; }
#define XB_SPIN(cond, bar) do { unsigned _sp = 0; while (cond) { __builtin_amdgcn_s_sleep(1); \
    if ((++_sp & 255u) == 0u) { if (xb_ld(&(bar)[XB_TMO])) break; if (_sp > XB_SPIN_CAP) { atomicAdd(&(bar)[XB_TMO], 1u); break; } } } } while (0)
struct XcdBarrier { unsigned* bar; unsigned x; volatile LAS unsigned* st; };
DI XcdBarrier xcd_barrier_post(unsigned* bar, volatile LAS unsigned* st) {
  XcdBarrier b; b.bar = bar; b.x = xb_xcc_id(); b.st = st;
  if (threadIdx.x == 0) (void)xb_add(&bar[XB_XCNT(b.x)], 1u);
  return b;
}
DI void xcd_barrier_complete(unsigned* bar, unsigned x, unsigned& nloc, unsigned& nx) {
  const unsigned G = gridDim.x * gridDim.y * gridDim.z;
  unsigned sum, cnt, mine, sp = 0u;
  for (;;) {
    sum = 0u; cnt = 0u; mine = 0u;
#pragma unroll
    for (unsigned j = 0; j < 16; ++j) { const unsigned c = xb_ld(&bar[XB_XCNT(j)]); sum += c; cnt += (c > 0u) ? 1u : 0u; mine = (j == x) ? c : mine; }
    if (sum == G) break;
    __builtin_amdgcn_s_sleep(1);
    if ((++sp & 255u) == 0u) { if (xb_ld(&bar[XB_TMO])) break; if (sp > XB_SPIN_CAP) { atomicAdd(&bar[XB_TMO], 1u); break; } }
  }
  nloc = mine > 0u ? mine : 1u; nx = cnt > 0u ? cnt : 1u;
}
DI void xcd_barrier(const XcdBarrier& b) {
  asm volatile("s_waitcnt vmcnt(0)" ::: "memory");
  __syncthreads();
  if (threadIdx.x == 0) {
    unsigned* bar = b.bar;
    __builtin_amdgcn_s_waitcnt(0);
    unsigned nloc = b.st[0], nx = b.st[1];
    if (nloc == 0u) { xcd_barrier_complete(bar, b.x, nloc, nx); b.st[0] = nloc; b.st[1] = nx; }
    const unsigned old = xb_add(&bar[XB_XSUB(b.x)], 1u);
    const unsigned gen = old / nloc;
    if (old + 1u == (gen + 1u) * nloc) {
      __builtin_amdgcn_fence(__ATOMIC_RELEASE, "agent");
      asm volatile("s_waitcnt vmcnt(0)" ::: "memory");
      const unsigned og = xb_add(&bar[XB_TOP], 1u);
      const unsigned tg = og / nx;
      if (og + 1u == (tg + 1u) * nx) xb_add(&bar[XB_TOPGEN], 1u);
      else XB_SPIN(xb_ld(&bar[XB_TOPGEN]) == tg, bar);
      __builtin_amdgcn_fence(__ATOMIC_ACQUIRE, "agent");
      xb_add(&bar[XB_XGEN(b.x)], 1u);
      asm volatile("s_waitcnt vmcnt(0)" ::: "memory");
    } else {
      XB_SPIN(xb_ld(&bar[XB_XGEN(b.x)]) == gen, bar);
      __builtin_amdgcn_fence(__ATOMIC_ACQUIRE, "agent");
      asm volatile("s_waitcnt vmcnt(0)" ::: "memory");
    }
  }
  __syncthreads();
}

__global__ void __launch_bounds__(512, COOP_MINB) mk_coop(Params p) {
  __shared__ __attribute__((aligned(16))) unsigned char smem[SMEM_BYTES];
  __shared__ __attribute__((aligned(16))) unsigned xb_words[4];
  cg::grid_group grid = cg::this_grid();
  if (threadIdx.x < 4) xb_words[threadIdx.x] = 0u;
  __syncthreads();
  const XcdBarrier xb = xcd_barrier_post(p.bar, (volatile LAS unsigned*)xb_words);
  phase_pre(p, smem);
  grid.sync();
#pragma unroll 1
  for (int l = 0; l < 2; ++l) {
    phase_norm(p, l);
    xcd_barrier(xb);
#if PROBE_DUP == 3
    phase_norm(p, l);
    xcd_barrier(xb);
#endif
    phase_gemm_in(p, l, smem);
    xcd_barrier(xb);
#if PROBE_DUP == 1
    phase_gemm_in(p, l, smem);
    xcd_barrier(xb);
#endif
    phase_mix(p, l, smem, 0);
    xcd_barrier(xb);
#if PROBE_DUP == 2
    phase_mix(p, l, smem, 2, PROBE_ONLY);
    xcd_barrier(xb);
#endif
#if PROBE_DUP == 4
    if (l == 0) { phase_gemm_out(p, l, smem); xcd_barrier(xb); }
#endif
    phase_gemm_out(p, l, smem);
    xcd_barrier(xb);
  }
#if PROBE_DUP == 5
  for (int i = 0; i < 10; ++i) xcd_barrier(xb);
#endif
  phase_final(p);
}
#endif

extern "C" void kernel_launch(void* const* d_in, const int* in_sizes, int n_in, void* d_out, int out_size, void* d_ws,
                              size_t ws_size, hipStream_t stream) {
  Params p{};
  p.x = (const float*)d_in[0]; p.norm_g = (const float*)d_in[1]; p.w_in = (const float*)d_in[2]; p.b_f = (const float*)d_in[3];
  p.rel_bias = (const float*)d_in[4]; p.w_s = (const float*)d_in[5]; p.b_s = (const float*)d_in[6]; p.v_gain = (const float*)d_in[7];
  p.branch_gain = (const float*)d_in[8]; p.w_out = (const float*)d_in[9]; p.final_g = (const float*)d_in[10];
  p.out = (float*)d_out;
  unsigned char* ws = (unsigned char*)d_ws;
  size_t off = 0;
  auto carve = [&](size_t bytes) { unsigned char* q = ws + off; off += (bytes + 255) & ~(size_t)255; return q; };
  p.WtIn = (u16*)carve((size_t)2 * NW * 1024 * 2);
  p.WtOut = (u16*)carve((size_t)2 * 1024 * 1024 * 2);
  p.Ws16 = (u16*)carve((size_t)2 * 4 * 128 * 128 * 2);
  p.H = (u16*)carve((size_t)TT * 1024 * 2);
  p.P = (u16*)carve((size_t)TT * PC * 2);
  p.Vt = (u16*)carve((size_t)4 * 2 * 256 * VTLD * 2);
  p.Z = (u16*)carve((size_t)TT * 1024 * 2);
  p.lsf = (float*)carve((size_t)TT * 4 * 4);
  p.csum = (float*)carve((size_t)TT * 4 * 4);
  p.ssq = (float*)carve((size_t)TT * 16 * 4);
  p.ctot = (float*)carve(32 * 4 * 4);
  p.Wf = (float*)carve(2 * 1024 * 4 * 4);
  p.ctr = (unsigned*)carve(256);
  p.bar = (unsigned*)carve(XCD_BAR_WORDS * 4);
  static int grid_blocks = 0;
  if (!grid_blocks) {
    int dev = 0, cus = 0, per_cu = 0;
    hipGetDevice(&dev);
    hipDeviceGetAttribute(&cus, hipDeviceAttributeMultiprocessorCount, dev);
#if COOP
    hipOccupancyMaxActiveBlocksPerMultiprocessor(&per_cu, mk_coop, 256, 0);
#else
    hipOccupancyMaxActiveBlocksPerMultiprocessor(&per_cu, mk_phase<3>, 256, 0);
#endif
    (void)per_cu;
    grid_blocks = cus;
  }
#if COOP
  hipMemsetAsync(p.bar, 0, XCD_BAR_WORDS * 4, stream);
  void* args[] = {&p};
  hipError_t e = hipLaunchCooperativeKernel((void*)mk_coop, dim3(grid_blocks), dim3(512), args, 0, stream);
  if (e != hipSuccess) fprintf(stderr, "cooperative launch failed: %s (grid %d)\n", hipGetErrorString(e), grid_blocks);
#else
  mk_phase<0><<<grid_blocks, 256, 0, stream>>>(p, 0);
  for (int l = 0; l < 2; ++l) {
    mk_phase<1><<<grid_blocks, 256, 0, stream>>>(p, l);
    mk_phase<2><<<grid_blocks, 256, 0, stream>>>(p, l);
    mk_phase<3><<<grid_blocks, 256, 0, stream>>>(p, l);
    mk_phase<4><<<grid_blocks, 256, 0, stream>>>(p, l);
  }
  mk_phase<5><<<grid_blocks, 256, 0, stream>>>(p, 0);
#endif
}
```

```cpp
#include <hip/hip_runtime.h>
#include <hip/hip_cooperative_groups.h>
#include <cstdio>
namespace cg = cooperative_groups;

#ifndef COOP
#define COOP 1
#endif
#ifndef PROBE_ONLY
#define PROBE_ONLY 2
#endif
#ifndef PROBE_DUP
#define PROBE_DUP 0
#endif
#ifndef COOP_MINB
#define COOP_MINB 2
#endif

#define DI __device__ __forceinline__
typedef unsigned short u16;
typedef __attribute__((ext_vector_type(8))) short bf16x8;
typedef __attribute__((ext_vector_type(16))) float f32x16;
typedef __attribute__((ext_vector_type(2))) __bf16 bf16v2;
#define MFMA(a, b, c) __builtin_amdgcn_mfma_f32_32x32x16_bf16((a), (b), (c), 0, 0, 0)

constexpr int SEQ = 16384, TT = 32768, DM = 1024, NIN = 3844, NW = 3840, PC = 2816;
constexpr float EPS = 1e-6f, LOG2E = 1.4426950408889634f;
constexpr float QSCALE = 0.125f * LOG2E;
constexpr int AQ = 0, AK = 256, AG = 512, BU = 768, BG = 1024, CQ = 1280, CK = 1536, CG = 1792, DQ = 2048, DK = 2304, DG = 2560;
constexpr int SMEM_BYTES = 131072;
constexpr int NTHR = 512;
constexpr int VTLD = SEQ + 64;

struct Params {
  const float *x, *norm_g, *w_in, *b_f, *rel_bias, *w_s, *b_s, *v_gain, *branch_gain, *w_out, *final_g;
  float* out;
  u16 *WtIn, *WtOut, *Ws16, *H, *P, *Vt, *Z;
  float *lsf, *csum, *ssq, *ctot, *Wf;
  unsigned* ctr;
  unsigned* bar;
};

DI unsigned pk2(float a, float b) { bf16v2 v; v[0] = (__bf16)a; v[1] = (__bf16)b; return __builtin_bit_cast(unsigned, v); }
DI u16 f2bf(float a) { return __builtin_bit_cast(u16, (__bf16)a); }
DI float bf2f(u16 h) { return __uint_as_float(((unsigned)h) << 16); }
DI float bflo(unsigned u) { return __uint_as_float(u << 16); }
DI float bfhi(unsigned u) { return __uint_as_float(u & 0xffff0000u); }
DI int otid() { int t = threadIdx.x; asm volatile("" : "+v"(t)); return t; }
DI float wave_sum(float v) { for (int o = 32; o > 0; o >>= 1) v += __shfl_xor(v, o); return v; }

__device__ void phase_pre(const Params& p, unsigned char* smem) {
  float (*tile)[65] = (float (*)[65])smem;
  const int tid = otid(), tx = tid & 63, ty = tid >> 6;
  const int nA = 2 * 60 * 16, nB = 2 * 16 * 16;
  for (int it = blockIdx.x; it < nA + nB; it += gridDim.x) {
    const float* src; u16* dst; int ld_src, n0, k0, srcoff, nrows;
    if (it < nA) {
      int l = it / 960, rem = it % 960, ntile = rem / 16, ktile = rem % 16;
      n0 = ntile * 64; k0 = ktile * 64;
      src = p.w_in + (size_t)l * 1024 * NIN; ld_src = NIN; dst = p.WtIn + (size_t)l * NW * 1024; srcoff = (n0 >= 2816) ? 4 : 0; nrows = NW;
    } else {
      int j = it - nA; int l = j / 256, rem = j % 256, ntile = rem / 16, ktile = rem % 16;
      n0 = ntile * 64; k0 = ktile * 64;
      src = p.w_out + (size_t)l * 1024 * 1024; ld_src = 1024; dst = p.WtOut + (size_t)l * 1024 * 1024; srcoff = 0; nrows = 1024;
    }
    __syncthreads();
#pragma unroll 4
    for (int i = 0; i < 8; ++i) { int k = ty + 8 * i; tile[k][tx] = src[(size_t)(k0 + k) * ld_src + n0 + srcoff + tx]; }
    __syncthreads();
#pragma unroll 4
    for (int i = 0; i < 8; ++i) { int n = ty + 8 * i; dst[((size_t)(k0 >> 6) * nrows + n0 + n) * 64 + tx] = f2bf(tile[tx][n]); }
  }
  for (int idx = blockIdx.x * NTHR + tid; idx < 2 * 4 * 128 * 128; idx += gridDim.x * NTHR) {
    int t = (idx >> 7) & 127, s = idx & 127;
    p.Ws16[idx] = (s <= t) ? f2bf(p.w_s[idx]) : (u16)0;
  }
  for (int idx = blockIdx.x * NTHR + tid; idx < 2 * 1024; idx += gridDim.x * NTHR) {
    const int l = idx >> 10, k = idx & 1023;
    *(float4*)(p.Wf + (size_t)idx * 4) = *(const float4*)(p.w_in + ((size_t)l * 1024 + k) * NIN + 2816);
  }
  if (blockIdx.x == 0 && tid < 64) p.ctr[tid] = 0u;
}

__device__ void phase_norm(const Params& p, int l) {
  const float* src = (l == 0) ? p.x : p.out;
  const int tid_ = otid();
  const int lane = tid_ & 63;
  const int gw = blockIdx.x * 8 + (tid_ >> 6), nw = gridDim.x * 8;
  const float4* g4 = (const float4*)(p.norm_g + l * 1024);
  const float4* wf4 = (const float4*)(p.Wf + (size_t)l * 4096);
  float4 gr[4], w0[4], w1[4], w2[4], w3[4];
#pragma unroll
  for (int j = 0; j < 4; ++j) {
    const int k = 4 * (lane + 64 * j);
    gr[j] = g4[lane + 64 * j];
    w0[j] = wf4[k]; w1[j] = wf4[k + 1]; w2[j] = wf4[k + 2]; w3[j] = wf4[k + 3];
  }
  const float bf0 = p.b_f[l * 4 + 0], bf1 = p.b_f[l * 4 + 1], bf2 = p.b_f[l * 4 + 2], bf3 = p.b_f[l * 4 + 3];
  for (int row0 = gw * 4; row0 < TT; row0 += nw * 4) {
    float4 v[4][4]; float ss[4] = {0.f, 0.f, 0.f, 0.f};
#pragma unroll
    for (int q = 0; q < 4; ++q) {
      const float4* xr = (const float4*)(src + (size_t)(row0 + q) * 1024);
#pragma unroll
      for (int j = 0; j < 4; ++j) v[q][j] = xr[lane + 64 * j];
    }
#pragma unroll
    for (int q = 0; q < 4; ++q)
#pragma unroll
      for (int j = 0; j < 4; ++j) ss[q] += v[q][j].x * v[q][j].x + v[q][j].y * v[q][j].y + v[q][j].z * v[q][j].z + v[q][j].w * v[q][j].w;
    ss[0] = wave_sum(ss[0]); ss[1] = wave_sum(ss[1]); ss[2] = wave_sum(ss[2]); ss[3] = wave_sum(ss[3]);
#pragma unroll
    for (int q = 0; q < 4; ++q) {
      const int row = row0 + q;
      const float rinv = rsqrtf(ss[q] * (1.f / 1024.f) + EPS);
      float f0 = 0.f, f1 = 0.f, f2 = 0.f, f3 = 0.f;
#pragma unroll
      for (int j = 0; j < 4; ++j) {
        const float h0 = v[q][j].x * rinv * gr[j].x, h1 = v[q][j].y * rinv * gr[j].y, h2 = v[q][j].z * rinv * gr[j].z, h3 = v[q][j].w * rinv * gr[j].w;
        uint2 o; o.x = pk2(h0, h1); o.y = pk2(h2, h3);
        { const int col = 4 * (lane + 64 * j); *(uint2*)(p.H + ((size_t)(col >> 6) * TT + row) * 64 + (col & 63)) = o; }
        f0 += h0 * w0[j].x + h1 * w1[j].x + h2 * w2[j].x + h3 * w3[j].x;
        f1 += h0 * w0[j].y + h1 * w1[j].y + h2 * w2[j].y + h3 * w3[j].y;
        f2 += h0 * w0[j].z + h1 * w1[j].z + h2 * w2[j].z + h3 * w3[j].z;
        f3 += h0 * w0[j].w + h1 * w1[j].w + h2 * w2[j].w + h3 * w3[j].w;
      }
      f0 = wave_sum(f0); f1 = wave_sum(f1); f2 = wave_sum(f2); f3 = wave_sum(f3);
      if (lane == 0) {
        float4 o;
        o.x = f0 + bf0; o.y = f1 + bf1; o.z = f2 + bf2; o.w = f3 + bf3;
        o.x = (fminf(o.x, 0.f) - log1pf(expf(-fabsf(o.x)))) * LOG2E;
        o.y = (fminf(o.y, 0.f) - log1pf(expf(-fabsf(o.y)))) * LOG2E;
        o.z = (fminf(o.z, 0.f) - log1pf(expf(-fabsf(o.z)))) * LOG2E;
        o.w = (fminf(o.w, 0.f) - log1pf(expf(-fabsf(o.w)))) * LOG2E;
        *(float4*)(p.lsf + (size_t)row * 4) = o;
      }
    }
  }
}

__device__ void scan_chunk(const Params& p, int chunk, unsigned char* smem) {
  float4* wtot = (float4*)smem;
  const int tid = otid(), lane = tid & 63, w = tid >> 6;
  const bool act = tid < 256;
  const int ti = act ? tid : 0;
  const float4* in = (const float4*)p.lsf + (size_t)chunk * 1024 + ti * 4;
  float4 v0 = in[0], v1 = in[1], v2 = in[2], v3 = in[3];
  v1.x += v0.x; v1.y += v0.y; v1.z += v0.z; v1.w += v0.w;
  v2.x += v1.x; v2.y += v1.y; v2.z += v1.z; v2.w += v1.w;
  v3.x += v2.x; v3.y += v2.y; v3.z += v2.z; v3.w += v2.w;
  float4 inc = v3;
#pragma unroll
  for (int o = 1; o < 64; o <<= 1) {
    float4 n;
    n.x = __shfl_up(inc.x, o); n.y = __shfl_up(inc.y, o); n.z = __shfl_up(inc.z, o); n.w = __shfl_up(inc.w, o);
    if (lane >= o) { inc.x += n.x; inc.y += n.y; inc.z += n.z; inc.w += n.w; }
  }
  __syncthreads();
  if (act && lane == 63) wtot[w] = inc;
  __syncthreads();
  float4 pre = make_float4(inc.x - v3.x, inc.y - v3.y, inc.z - v3.z, inc.w - v3.w);
  float4 all = make_float4(0.f, 0.f, 0.f, 0.f);
#pragma unroll
  for (int i = 0; i < 4; ++i) {
    float4 t = wtot[i];
    if (i < w) { pre.x += t.x; pre.y += t.y; pre.z += t.z; pre.w += t.w; }
    all.x += t.x; all.y += t.y; all.z += t.z; all.w += t.w;
  }
  if (act) {
    float4* outp = (float4*)p.csum + (size_t)chunk * 1024 + tid * 4;
    outp[0] = make_float4(v0.x + pre.x, v0.y + pre.y, v0.z + pre.z, v0.w + pre.w);
    outp[1] = make_float4(v1.x + pre.x, v1.y + pre.y, v1.z + pre.z, v1.w + pre.w);
    outp[2] = make_float4(v2.x + pre.x, v2.y + pre.y, v2.z + pre.z, v2.w + pre.w);
    outp[3] = make_float4(v3.x + pre.x, v3.y + pre.y, v3.z + pre.z, v3.w + pre.w);
    if (tid == 0) ((float4*)p.ctot)[chunk] = all;
  }
  __syncthreads();
}

typedef u16 (*lds_tile_t)[72];
#define G_LOAD(A_, NR_, m0_, kt_, R_) do { const u16* gp_ = (A_) + ((size_t)(kt_) * (NR_) + (m0_) + (tid >> 3)) * 64 + (tid & 7) * 8; \
    R_##0 = *(const uint4*)gp_; R_##1 = *(const uint4*)(gp_ + 32 * 64); R_##2 = *(const uint4*)(gp_ + 64 * 64); R_##3 = *(const uint4*)(gp_ + 96 * 64); } while (0)
#define S_STORE(S_, R_) do { u16* sp_ = &(S_)[tid >> 3][(tid & 7) * 8]; \
    *(uint4*)sp_ = R_##0; *(uint4*)(sp_ + 32 * 72) = R_##1; *(uint4*)(sp_ + 64 * 72) = R_##2; *(uint4*)(sp_ + 96 * 72) = R_##3; } while (0)
template <bool SWAP>
DI void gemm_ktile(lds_tile_t As, lds_tile_t Bs, f32x16 (&acc)[2][2], int wm, int wn, int r, int h) {
  bf16x8 af[4][2], bfr[4][2];
  const u16* ap = &As[wm * 64 + r][h * 8];
  const u16* bp = &Bs[wn * 64 + r][h * 8];
#pragma unroll
  for (int ks = 0; ks < 4; ++ks) {
    af[ks][0] = *(const bf16x8*)(ap + ks * 16); af[ks][1] = *(const bf16x8*)(ap + 32 * 72 + ks * 16);
    bfr[ks][0] = *(const bf16x8*)(bp + ks * 16); bfr[ks][1] = *(const bf16x8*)(bp + 32 * 72 + ks * 16);
  }
  __builtin_amdgcn_sched_barrier(0);
#pragma unroll
  for (int ks = 0; ks < 4; ++ks)
#pragma unroll
    for (int mi = 0; mi < 2; ++mi)
#pragma unroll
      for (int ni = 0; ni < 2; ++ni)
        acc[mi][ni] = SWAP ? MFMA(bfr[ks][ni], af[ks][mi], acc[mi][ni]) : MFMA(af[ks][mi], bfr[ks][ni], acc[mi][ni]);
}

#define GL_STAGE(GA_, NRA_, m0_, GB_, NRB_, n0_, T32_, SBASE_) do { _Pragma("unroll") for (int j_ = 0; j_ < 2; ++j_) { \
    const int q_ = j_ * 512 + tid, rw_ = q_ >> 2, kc_ = (q_ & 3) ^ ((rw_ >> 2) & 3); \
    __builtin_amdgcn_global_load_lds((const unsigned*)((GA_) + ((size_t)((T32_) >> 1) * (NRA_) + (m0_) + rw_) * 64 + ((T32_) & 1) * 32 + kc_ * 8), \
        (__attribute__((address_space(3))) unsigned*)((SBASE_) + q_ * 16), 16, 0, 0); \
    __builtin_amdgcn_global_load_lds((const unsigned*)((GB_) + ((size_t)((T32_) >> 1) * (NRB_) + (n0_) + rw_) * 64 + ((T32_) & 1) * 32 + kc_ * 8), \
        (__attribute__((address_space(3))) unsigned*)((SBASE_) + 16384 + q_ * 16), 16, 0, 0); } } while (0)
#define GL_WAIT_BAR() do { asm volatile("s_waitcnt vmcnt(8)" ::: "memory"); __builtin_amdgcn_s_barrier(); asm volatile("" ::: "memory"); } while (0)
DI unsigned frag_addr(unsigned base, int row, int kc) { return base + row * 64 + ((kc ^ ((row >> 2) & 3)) << 4); }
template <bool SWAP>
DI void gemm_ktile32(const unsigned char* St, f32x16 (&acc)[4][2], int wm, int wn, int r, int h) {
  const unsigned sa = (unsigned)(size_t)St, sbb = sa + 16384;
  const int ra = wm * 128 + r, rb = wn * 64 + r;
  bf16x8 a0[4], a1[4], b0[2], b1[2];
  asm volatile(
      "ds_read_b128 %0, %6\n\tds_read_b128 %1, %7\n\tds_read_b128 %4, %10\n\tds_read_b128 %5, %11\n\t"
      "ds_read_b128 %2, %8\n\tds_read_b128 %3, %9\n\t"
      "s_waitcnt lgkmcnt(0)"
      : "=&v"(a0[0]), "=&v"(a0[1]), "=&v"(a0[2]), "=&v"(a0[3]), "=&v"(b0[0]), "=&v"(b0[1])
      : "v"(frag_addr(sa, ra, h)), "v"(frag_addr(sa, ra + 32, h)), "v"(frag_addr(sa, ra + 64, h)), "v"(frag_addr(sa, ra + 96, h)),
        "v"(frag_addr(sbb, rb, h)), "v"(frag_addr(sbb, rb + 32, h))
      : "memory");
  asm volatile(
      "ds_read_b128 %0, %6\n\tds_read_b128 %1, %7\n\tds_read_b128 %4, %10\n\tds_read_b128 %5, %11\n\t"
      "ds_read_b128 %2, %8\n\tds_read_b128 %3, %9"
      : "=&v"(a1[0]), "=&v"(a1[1]), "=&v"(a1[2]), "=&v"(a1[3]), "=&v"(b1[0]), "=&v"(b1[1])
      : "v"(frag_addr(sa, ra, 2 + h)), "v"(frag_addr(sa, ra + 32, 2 + h)), "v"(frag_addr(sa, ra + 64, 2 + h)), "v"(frag_addr(sa, ra + 96, 2 + h)),
        "v"(frag_addr(sbb, rb, 2 + h)), "v"(frag_addr(sbb, rb + 32, 2 + h))
      : "memory");
  __builtin_amdgcn_sched_barrier(0);
#pragma unroll
  for (int mi = 0; mi < 4; ++mi)
#pragma unroll
    for (int ni = 0; ni < 2; ++ni) acc[mi][ni] = SWAP ? MFMA(b0[ni], a0[mi], acc[mi][ni]) : MFMA(a0[mi], b0[ni], acc[mi][ni]);
  __builtin_amdgcn_sched_barrier(0);
  asm volatile("s_waitcnt lgkmcnt(0)"
               : "+v"(a1[0]), "+v"(a1[1]), "+v"(a1[2]), "+v"(a1[3]), "+v"(b1[0]), "+v"(b1[1]) : : "memory");
#pragma unroll
  for (int mi = 0; mi < 4; ++mi)
#pragma unroll
    for (int ni = 0; ni < 2; ++ni) acc[mi][ni] = SWAP ? MFMA(b1[ni], a1[mi], acc[mi][ni]) : MFMA(a1[mi], b1[ni], acc[mi][ni]);
}
typedef unsigned u32x2w __attribute__((ext_vector_type(2)));
DI uint4 widen_pair(uint2 ev, uint2 od) {
  const u32x2w a = __builtin_amdgcn_permlane32_swap(ev.x, od.x, false, false);
  const u32x2w b = __builtin_amdgcn_permlane32_swap(ev.y, od.y, false, false);
  return make_uint4(a[0], b[0], a[1], b[1]);
}
DI int sec_pcol(int s) { int nv = (s > 2) + (s > 5) + (s > 9) + (s > 13); return (s - nv) * 256; }
DI int sec_branch(int s) { return (s < 4) ? 0 : (s < 7) ? 1 : (s < 11) ? 2 : 3; }

template <bool SWAP>
DI void gemm_mainloop(const u16* A, const u16* B, int nrb, int m0, int n0, unsigned char* smem, f32x16 (&acc)[4][2]) {
  const int tid = otid(), lane = tid & 63, w = tid >> 6, wm = w >> 2, wn = w & 3, r = lane & 31, h = lane >> 5;
  GL_STAGE(A, TT, m0, B, nrb, n0, 0, smem);
  GL_STAGE(A, TT, m0, B, nrb, n0, 1, smem + 32768);
  GL_STAGE(A, TT, m0, B, nrb, n0, 2, smem + 65536);
#pragma unroll 1
  for (int t = 0; t < 32; ++t) {
    GL_WAIT_BAR();
    { const int t3 = min(t + 3, 31); GL_STAGE(A, TT, m0, B, nrb, n0, t3, smem + ((t + 3) & 3) * 32768); }
    gemm_ktile32<SWAP>(smem + (t & 3) * 32768, acc, wm, wn, r, h);
  }
  asm volatile("s_waitcnt vmcnt(0)" ::: "memory");
  __syncthreads();
}

__device__ void gemm_in_tile(const Params& p, int l, int mt, int sec, unsigned char* smem) {
  const int m0 = mt * 256, n0 = sec * 256;
  const bool is_vt = (sec == 2 || sec == 5 || sec == 9 || sec == 13);
  const bool is_q = (sec == 0 || sec == 7 || sec == 11);
  const bool is_gate = (sec == 3 || sec == 6 || sec == 10 || sec == 14);
  const int br = sec_branch(sec);
  const int tid = otid(), lane = tid & 63, w = tid >> 6, wm = w >> 2, wn = w & 3, r = lane & 31, h = lane >> 5;
  const u16* A = p.H;
  const u16* B = p.WtIn + (size_t)l * NW * 1024;
  f32x16 acc[4][2];
#pragma unroll
  for (int mi = 0; mi < 4; ++mi)
#pragma unroll
    for (int ni = 0; ni < 2; ++ni)
#pragma unroll
      for (int i = 0; i < 16; ++i) acc[mi][ni][i] = 0.f;
  if (is_vt) {
    gemm_mainloop<false>(A, B, NW, m0, n0, smem, acc);
#pragma unroll
    for (int mi = 0; mi < 4; ++mi)
#pragma unroll
      for (int ni = 0; ni < 2; ++ni) {
        const int c = wn * 64 + ni * 32 + r;
#pragma unroll
        for (int gp = 0; gp < 2; ++gp) {
          uint2 ev, od;
          ev.x = pk2(acc[mi][ni][8 * gp], acc[mi][ni][8 * gp + 1]); ev.y = pk2(acc[mi][ni][8 * gp + 2], acc[mi][ni][8 * gp + 3]);
          od.x = pk2(acc[mi][ni][8 * gp + 4], acc[mi][ni][8 * gp + 5]); od.y = pk2(acc[mi][ni][8 * gp + 6], acc[mi][ni][8 * gp + 7]);
          const uint4 o = widen_pair(ev, od);
          const int t0 = m0 + wm * 128 + mi * 32 + 8 * (2 * gp + h);
          const int b = t0 >> 14, sq = t0 & (SEQ - 1);
          *(uint4*)(p.Vt + ((size_t)(br * 2 + b) * 256 + c) * VTLD + sq) = o;
        }
      }
  } else {
    gemm_mainloop<true>(A, B, NW, m0, n0, smem, acc);
    const int pcol = sec_pcol(sec);
    const float* gain = p.branch_gain + (size_t)(l * 4 + br) * 256;
    if (sec == 8) {
      float mx2 = 0.f;
#pragma unroll
      for (int mi = 0; mi < 4; ++mi) {
        float n2 = 0.f;
#pragma unroll
        for (int ni = 0; ni < 2; ++ni)
#pragma unroll
          for (int i = 0; i < 16; ++i) n2 += acc[mi][ni][i] * acc[mi][ni][i];
        n2 += __shfl_xor(n2, 32);
        mx2 = fmaxf(mx2, n2);
      }
#pragma unroll
      for (int o = 16; o > 0; o >>= 1) mx2 = fmaxf(mx2, __shfl_xor(mx2, o));
      if (lane == 0) atomicMax(p.ctr + 48 + l * 8 + (m0 >> 14) * 4 + wn, __float_as_uint(mx2));
    }
#pragma unroll
    for (int mi = 0; mi < 4; ++mi)
#pragma unroll
      for (int ni = 0; ni < 2; ++ni) {
        const int t = m0 + wm * 128 + mi * 32 + r;
        uint2 og[4];
#pragma unroll
        for (int gi = 0; gi < 4; ++gi) {
          const int nl = wn * 64 + ni * 32 + 8 * gi + 4 * h;
          float v[4];
#pragma unroll
          for (int e = 0; e < 4; ++e) v[e] = acc[mi][ni][4 * gi + e];
          if (is_q) {
#pragma unroll
            for (int e = 0; e < 4; ++e) v[e] *= QSCALE;
          } else if (is_gate) {
            float4 gg = *(const float4*)(gain + nl);
            const float* gp = (const float*)&gg;
#pragma unroll
            for (int e = 0; e < 4; ++e) v[e] = gp[e] * v[e] / (1.f + __expf(-v[e]));
          }
          og[gi].x = pk2(v[0], v[1]); og[gi].y = pk2(v[2], v[3]);
        }
#pragma unroll
        for (int gp = 0; gp < 2; ++gp) {
          const uint4 o = widen_pair(og[2 * gp], og[2 * gp + 1]);
          const int nl8 = wn * 64 + ni * 32 + 8 * (2 * gp + h);
          *(uint4*)(p.P + (size_t)t * PC + pcol + nl8) = o;
        }
      }
  }
}

__device__ void phase_gemm_in(const Params& p, int l, unsigned char* smem) {
  for (int c = (int)gridDim.x - 1 - (int)blockIdx.x; c < 32; c += gridDim.x) scan_chunk(p, c, smem);
  const int xcd = blockIdx.x & 7, slot = blockIdx.x >> 3, nslot = gridDim.x >> 3;
  for (int j = slot; j < 240; j += nslot) {
    const int mg = j / 120, rem = j % 120;
    const int ng = (rem >= 96) ? 3 : (rem >> 5), idx = rem - ng * 32;
    const int mt = xcd * 16 + mg * 8 + (idx & 7), sec = ng * 4 + (idx >> 3);
    gemm_in_tile(p, l, mt, sec, smem);
  }
}

__device__ void gemm_out_tile(const Params& p, int l, int mt, int nt, unsigned char* smem) {
  const int m0 = mt * 256, n0 = nt * 256;
  const int tid = otid(), lane = tid & 63, w = tid >> 6, wm = w >> 2, wn = w & 3, r = lane & 31, h = lane >> 5;
  const u16* A = p.Z;
  const u16* B = p.WtOut + (size_t)l * 1024 * 1024;
  const float* resid = (l == 0) ? p.x : p.out;
  float fold[4][4];
#pragma unroll
  for (int mi = 0; mi < 4; ++mi) {
    const int t = m0 + wm * 128 + mi * 32 + r;
    float rv[4];
#pragma unroll
    for (int br = 0; br < 4; ++br) {
      float4 sq = *(const float4*)(p.ssq + (size_t)t * 16 + br * 4);
      rv[br] = rsqrtf((sq.x + sq.y + sq.z + sq.w) * (1.f / 256.f) + EPS);
    }
    fold[mi][0] = rv[0] / rv[1]; fold[mi][1] = rv[1] / rv[2]; fold[mi][2] = rv[2] / rv[3]; fold[mi][3] = rv[3];
  }
  f32x16 acc[4][2];
#pragma unroll
  for (int mi = 0; mi < 4; ++mi)
#pragma unroll
    for (int ni = 0; ni < 2; ++ni)
#pragma unroll
      for (int i = 0; i < 16; ++i) acc[mi][ni][i] = 0.f;
  GL_STAGE(A, TT, m0, B, 1024, n0, 0, smem);
  GL_STAGE(A, TT, m0, B, 1024, n0, 1, smem + 32768);
  GL_STAGE(A, TT, m0, B, 1024, n0, 2, smem + 65536);
#pragma unroll 1
  for (int t = 0; t < 32; ++t) {
    GL_WAIT_BAR();
    { const int t3 = min(t + 3, 31); GL_STAGE(A, TT, m0, B, 1024, n0, t3, smem + ((t + 3) & 3) * 32768); }
    gemm_ktile32<true>(smem + (t & 3) * 32768, acc, wm, wn, r, h);
    if ((t & 7) == 7) {
      const int br = t >> 3;
#pragma unroll
      for (int mi = 0; mi < 4; ++mi) {
        const float f = (br == 0) ? fold[mi][0] : (br == 1) ? fold[mi][1] : (br == 2) ? fold[mi][2] : fold[mi][3];
#pragma unroll
        for (int ni = 0; ni < 2; ++ni)
#pragma unroll
          for (int i = 0; i < 16; ++i) acc[mi][ni][i] *= f;
      }
    }
  }
  asm volatile("s_waitcnt vmcnt(0)" ::: "memory");
  __syncthreads();
#pragma unroll
  for (int mi = 0; mi < 4; ++mi)
#pragma unroll
    for (int ni = 0; ni < 2; ++ni) {
      const int t = m0 + wm * 128 + mi * 32 + r;
#pragma unroll
      for (int gi = 0; gi < 4; ++gi) {
        const int d = n0 + wn * 64 + ni * 32 + 8 * gi + 4 * h;
        float4 rs = *(const float4*)(resid + (size_t)t * 1024 + d);
        rs.x += acc[mi][ni][4 * gi]; rs.y += acc[mi][ni][4 * gi + 1]; rs.z += acc[mi][ni][4 * gi + 2]; rs.w += acc[mi][ni][4 * gi + 3];
        *(float4*)(p.out + (size_t)t * 1024 + d) = rs;
      }
    }
}

__device__ void phase_gemm_out(const Params& p, int l, unsigned char* smem) {
  const int xcd = blockIdx.x & 7, slot = blockIdx.x >> 3, nslot = gridDim.x >> 3;
  for (int j = slot; j < 64; j += nslot) {
    const int mg = j >> 5, idx = j & 31;
    gemm_out_tile(p, l, xcd * 16 + mg * 8 + (idx & 7), idx >> 3, smem);
  }
}

__device__ void phase_final(const Params& p) {
  const int tid_ = otid();
  const int lane = tid_ & 63;
  const int gw = blockIdx.x * 8 + (tid_ >> 6), nw = gridDim.x * 8;
  const float4* g4 = (const float4*)p.final_g;
  float4 gr[4];
#pragma unroll
  for (int j = 0; j < 4; ++j) gr[j] = g4[lane + 64 * j];
  for (int row0 = gw * 4; row0 < TT; row0 += nw * 4) {
    float4 v[4][4]; float ss[4] = {0.f, 0.f, 0.f, 0.f};
#pragma unroll
    for (int q = 0; q < 4; ++q) {
      const float4* xr = (const float4*)(p.out + (size_t)(row0 + q) * 1024);
#pragma unroll
      for (int j = 0; j < 4; ++j) v[q][j] = xr[lane + 64 * j];
    }
#pragma unroll
    for (int q = 0; q < 4; ++q)
#pragma unroll
      for (int j = 0; j < 4; ++j) ss[q] += v[q][j].x * v[q][j].x + v[q][j].y * v[q][j].y + v[q][j].z * v[q][j].z + v[q][j].w * v[q][j].w;
    ss[0] = wave_sum(ss[0]); ss[1] = wave_sum(ss[1]); ss[2] = wave_sum(ss[2]); ss[3] = wave_sum(ss[3]);
#pragma unroll
    for (int q = 0; q < 4; ++q) {
      float4* xr = (float4*)(p.out + (size_t)(row0 + q) * 1024);
      const float rinv = rsqrtf(ss[q] * (1.f / 1024.f) + EPS);
#pragma unroll
      for (int j = 0; j < 4; ++j) {
        float4 o; o.x = v[q][j].x * rinv * gr[j].x; o.y = v[q][j].y * rinv * gr[j].y; o.z = v[q][j].z * rinv * gr[j].z; o.w = v[q][j].w * rinv * gr[j].w;
        xr[lane + 64 * j] = o;
      }
    }
  }
}

template <int MODE>
__device__ void naive_attn_item(const Params& p, int l, int bh, int qb, unsigned char* smem) {
  float (*Ks)[64] = (float (*)[64])smem;
  float (*Vs)[64] = (float (*)[64])(smem + 16384);
  const int tid = otid(), b = bh >> 2, hh = bh & 3;
  const int qcol = MODE == 0 ? AQ : MODE == 1 ? CQ : DQ, kcol = MODE == 0 ? AK : MODE == 1 ? CK : DK, gcol = MODE == 0 ? AG : MODE == 1 ? CG : DG;
  const int br = MODE == 0 ? 0 : MODE == 1 ? 2 : 3;
  const int t = qb * 256 + tid;
  const size_t tok = (size_t)b * SEQ + t;
  unsigned q2[32]; float o[64];
#pragma unroll
  for (int d8 = 0; d8 < 8; ++d8) {
    uint4 u = *(const uint4*)(p.P + tok * PC + qcol + hh * 64 + d8 * 8);
    q2[d8 * 4 + 0] = u.x; q2[d8 * 4 + 1] = u.y; q2[d8 * 4 + 2] = u.z; q2[d8 * 4 + 3] = u.w;
  }
#pragma unroll
  for (int d = 0; d < 64; ++d) o[d] = 0.f;
  float m = -INFINITY, lsum = 0.f, carry = 0.f;
  const int hi = qb * 4 + 3;
  const int lo = (MODE == 0) ? max(0, qb * 4 - 8) : 0;
  const int c = t >> 6;
  const float* bias = p.rel_bias + (size_t)(l * 4 + hh) * 257;
  for (int kt = hi; kt >= lo; --kt) {
    __syncthreads();
#pragma unroll 4
    for (int i = 0; i < 16; ++i) {
      const int idx = tid + 256 * i, a = idx >> 6, bb = idx & 63;
      Ks[a][bb] = bf2f(p.P[((size_t)b * SEQ + kt * 64 + a) * PC + kcol + hh * 64 + bb]);
      Vs[bb][a] = bf2f(p.Vt[((size_t)(br * 2 + b) * 256 + hh * 64 + a) * SEQ + kt * 64 + bb]);
    }
    __syncthreads();
    bool tile_ok = true;
    if (MODE == 0) tile_ok = (kt >= c - 8) && (kt <= c);
    if (MODE != 0) tile_ok = (kt * 64 <= t);
    if (!tile_ok) continue;
    for (int j = 63; j >= 0; --j) {
      const int kpos = kt * 64 + j;
      if (MODE == 1 && kpos > t) continue;
      if (MODE == 2 && kpos >= t) continue;
      float dot = 0.f;
#pragma unroll
      for (int d = 0; d < 32; ++d) dot += bflo(q2[d]) * Ks[j][2 * d] + bfhi(q2[d]) * Ks[j][2 * d + 1];
      float pw;
      if (MODE == 2) {
        const float sp = __log2f(1.f + exp2f(dot));
        pw = exp2f(dot - sp - carry);
        carry += sp;
      } else {
        float u;
        if (MODE == 0) { int rel = min(max(t - kpos, -128), 128) + 128; u = dot + bias[rel] * LOG2E; }
        else u = dot - p.csum[((size_t)b * SEQ + kpos) * 4 + hh];
        if (u > m) {
          const float sc = exp2f(m - u);
          lsum *= sc;
#pragma unroll
          for (int d = 0; d < 64; ++d) o[d] *= sc;
          m = u;
        }
        pw = exp2f(u - m);
        lsum += pw;
      }
#pragma unroll
      for (int d = 0; d < 64; ++d) o[d] += pw * Vs[j][d];
    }
  }
  if (MODE != 2) {
    const float inv = 1.f / lsum;
#pragma unroll
    for (int d = 0; d < 64; ++d) o[d] *= inv;
  }
  float ss = 0.f;
#pragma unroll
  for (int d = 0; d < 64; ++d) ss += o[d] * o[d];
  p.ssq[tok * 16 + br * 4 + hh] = ss;
#pragma unroll
  for (int d8 = 0; d8 < 8; ++d8) {
    uint4 g = *(const uint4*)(p.P + tok * PC + gcol + hh * 64 + d8 * 8);
    uint4 z;
    z.x = pk2(o[d8 * 8 + 0] * bflo(g.x), o[d8 * 8 + 1] * bfhi(g.x));
    z.y = pk2(o[d8 * 8 + 2] * bflo(g.y), o[d8 * 8 + 3] * bfhi(g.y));
    z.z = pk2(o[d8 * 8 + 4] * bflo(g.z), o[d8 * 8 + 5] * bfhi(g.z));
    z.w = pk2(o[d8 * 8 + 6] * bflo(g.w), o[d8 * 8 + 7] * bfhi(g.w));
    *(uint4*)(p.Z + tok * 1024 + br * 256 + hh * 64 + d8 * 8) = z;
  }
}


typedef _Float16 f16x8 __attribute__((ext_vector_type(8)));
typedef _Float16 f16v2 __attribute__((ext_vector_type(2)));
typedef unsigned u32x4 __attribute__((ext_vector_type(4)));
#define MFMA_F16(a, b, c) __builtin_amdgcn_mfma_f32_32x32x16_f16((a), (b), (c), 0, 0, 0)
constexpr int KST = 88, VST = 68;
constexpr int STAGE_BYTES = 64 * KST * 2 + 64 * VST * 2;
constexpr int ATT_TAB_OFF = 2 * STAGE_BYTES;

DI int crow(int i, int h) { return (i & 3) + 8 * (i >> 2) + 4 * h; }
DI unsigned pkh2(float a, float b) { f16v2 v; v[0] = (_Float16)a; v[1] = (_Float16)b; return __builtin_bit_cast(unsigned, v); }
DI float ex2(float x) { return __builtin_amdgcn_exp2f(x); }
DI float lg2(float x) { return __builtin_amdgcn_logf(x); }

template <int MODE>
DI void attn_subtile(const u16* Kt, const u16* Vs, int st, bool diag, int r, int h, const bf16x8 (&qf)[4], bf16x8 qx,
                     const f16x8 (&uf)[2], const float* tab, int dist0, f32x16 (&O)[2], float& m, float& lsum, float& carry) {
  f32x16 s;
#pragma unroll
  for (int i = 0; i < 16; ++i) s[i] = 0.f;
  const u16* kp = Kt + (32 * st + r) * KST + 8 * h;
#pragma unroll
  for (int ks = 0; ks < 4; ++ks) s = MFMA(*(const bf16x8*)(kp + 16 * ks), qf[ks], s);
  if (MODE == 1) s = MFMA(*(const bf16x8*)(kp + 64), qx, s);
  f32x16 pv;
  if (MODE == 2) {
    f32x16 sp;
#pragma unroll
    for (int i = 0; i < 16; ++i) sp[i] = lg2(1.f + ex2(s[i]));
    if (diag) {
#pragma unroll
      for (int i = 0; i < 16; ++i) if (crow(i, h) >= r) sp[i] = 0.f;
    }
    u32x4 a0, a1;
#pragma unroll
    for (int j = 0; j < 4; ++j) { a0[j] = pkh2(sp[2 * j], sp[2 * j + 1]); a1[j] = pkh2(sp[8 + 2 * j], sp[8 + 2 * j + 1]); }
    f32x16 cs;
#pragma unroll
    for (int i = 0; i < 16; ++i) cs[i] = carry;
    cs = MFMA_F16(uf[0], __builtin_bit_cast(f16x8, a0), cs);
    cs = MFMA_F16(uf[1], __builtin_bit_cast(f16x8, a1), cs);
#pragma unroll
    for (int i = 0; i < 16; ++i) pv[i] = ex2(s[i] - cs[i]);
    if (diag) {
#pragma unroll
      for (int i = 0; i < 16; ++i) if (crow(i, h) >= r) pv[i] = 0.f;
    }
    carry = __shfl(cs[0], r);
  } else {
    if (MODE == 0) {
#pragma unroll
      for (int i = 0; i < 16; ++i) { int idx = min(max(dist0 - crow(i, h), -128), 128) + 128; s[i] += tab[idx]; }
    }
    if (MODE == 1 && diag) {
#pragma unroll
      for (int i = 0; i < 16; ++i) if (crow(i, h) > r) s[i] = -1e30f;
    }
    float mx = s[0];
#pragma unroll
    for (int i = 1; i < 16; ++i) mx = fmaxf(mx, s[i]);
    mx = fmaxf(mx, __shfl_xor(mx, 32));
    if (__any(mx > m)) {
      const float mn = fmaxf(m, mx);
      const float al = ex2(m - mn);
      m = mn; lsum *= al;
#pragma unroll
      for (int i = 0; i < 16; ++i) { O[0][i] *= al; O[1][i] *= al; }
    }
    float rs = 0.f;
#pragma unroll
    for (int i = 0; i < 16; ++i) { pv[i] = ex2(s[i] - m); rs += pv[i]; }
    lsum += rs;
  }
#pragma unroll
  for (int s2 = 0; s2 < 2; ++s2) {
    u32x4 pp;
#pragma unroll
    for (int j = 0; j < 4; ++j) pp[j] = pk2(pv[8 * s2 + 2 * j], pv[8 * s2 + 2 * j + 1]);
    const bf16x8 pf = __builtin_bit_cast(bf16x8, pp);
#pragma unroll
    for (int mt = 0; mt < 2; ++mt) {
      const u16* vp = Vs + (32 * mt + r) * VST + 32 * st + 16 * s2 + 4 * h;
      const uint2 v0 = *(const uint2*)vp, v1 = *(const uint2*)(vp + 8);
      u32x4 vv; vv[0] = v0.x; vv[1] = v0.y; vv[2] = v1.x; vv[3] = v1.y;
      O[mt] = MFMA(__builtin_bit_cast(bf16x8, vv), pf, O[mt]);
    }
  }
}


template <int MODE>
DI void attn_tile2(const u16* Kt, const u16* Vs, bool diag1, int r, int h, const bf16x8 (&qf)[4], bf16x8 qx,
                   const f16x8 (&uf)[2], const float* tab, int dist0, f32x16 (&O)[2], float& m, float& lsum, float& carry) {
  f32x16 s1, s0;
#pragma unroll
  for (int i = 0; i < 16; ++i) { s1[i] = 0.f; s0[i] = 0.f; }
  const u16* kp0 = Kt + r * KST + 8 * h;
  const u16* kp1 = kp0 + 32 * KST;
#pragma unroll
  for (int ks = 0; ks < 4; ++ks) {
    s1 = MFMA(*(const bf16x8*)(kp1 + 16 * ks), qf[ks], s1);
    s0 = MFMA(*(const bf16x8*)(kp0 + 16 * ks), qf[ks], s0);
  }
  if (MODE == 1) { s1 = MFMA(*(const bf16x8*)(kp1 + 64), qx, s1); s0 = MFMA(*(const bf16x8*)(kp0 + 64), qx, s0); }
  u32x4 vf1[2][2];
#pragma unroll
  for (int s2 = 0; s2 < 2; ++s2)
#pragma unroll
    for (int mt = 0; mt < 2; ++mt) {
      const u16* vp = Vs + (32 * mt + r) * VST + 32 + 16 * s2 + 4 * h;
      const uint2 v0 = *(const uint2*)vp, v1 = *(const uint2*)(vp + 8);
      vf1[s2][mt][0] = v0.x; vf1[s2][mt][1] = v0.y; vf1[s2][mt][2] = v1.x; vf1[s2][mt][3] = v1.y;
    }
  __builtin_amdgcn_sched_barrier(0);
  f32x16 p1, p0;
  if (MODE == 2) {
    f32x16 sp1, sp0;
#pragma unroll
    for (int i = 0; i < 16; ++i) { sp1[i] = lg2(1.f + ex2(s1[i])); sp0[i] = lg2(1.f + ex2(s0[i])); }
    if (diag1) {
#pragma unroll
      for (int i = 0; i < 16; ++i) if (crow(i, h) >= r) sp1[i] = 0.f;
    }
    u32x4 a10, a11, a00, a01;
#pragma unroll
    for (int j = 0; j < 4; ++j) {
      a10[j] = pkh2(sp1[2 * j], sp1[2 * j + 1]); a11[j] = pkh2(sp1[8 + 2 * j], sp1[8 + 2 * j + 1]);
      a00[j] = pkh2(sp0[2 * j], sp0[2 * j + 1]); a01[j] = pkh2(sp0[8 + 2 * j], sp0[8 + 2 * j + 1]);
    }
    f32x16 cs1, cs0;
#pragma unroll
    for (int i = 0; i < 16; ++i) { cs1[i] = carry; cs0[i] = carry; }
    cs1 = MFMA_F16(uf[0], __builtin_bit_cast(f16x8, a10), cs1);
    cs0 = MFMA_F16(uf[0], __builtin_bit_cast(f16x8, a00), cs0);
    cs1 = MFMA_F16(uf[1], __builtin_bit_cast(f16x8, a11), cs1);
    cs0 = MFMA_F16(uf[1], __builtin_bit_cast(f16x8, a01), cs0);
#pragma unroll
    for (int i = 0; i < 16; ++i) p1[i] = ex2(s1[i] - cs1[i]);
    if (diag1) {
#pragma unroll
      for (int i = 0; i < 16; ++i) if (crow(i, h) >= r) p1[i] = 0.f;
    }
    const float tot1 = __shfl(cs1[0], r) - carry;
#pragma unroll
    for (int i = 0; i < 16; ++i) p0[i] = ex2(s0[i] - tot1 - cs0[i]);
    carry = __shfl(cs0[0], r) + tot1;
  } else {
    if (MODE == 0) {
      if (diag1) {
        const float cb = tab[256];
#pragma unroll
        for (int i = 0; i < 16; ++i) { s1[i] += cb; s0[i] += cb; }
      } else {
#pragma unroll
        for (int i = 0; i < 16; ++i) {
          const int d0 = dist0 - crow(i, h);
          s1[i] += tab[min(max(d0 - 32, -128), 128) + 128];
          s0[i] += tab[min(max(d0, -128), 128) + 128];
        }
      }
    }
    if (MODE == 1 && diag1) {
#pragma unroll
      for (int i = 0; i < 16; ++i) if (crow(i, h) > r) s1[i] = -1e30f;
    }
    float mx = fmaxf(s1[0], s0[0]);
#pragma unroll
    for (int i = 1; i < 16; ++i) mx = fmaxf(mx, fmaxf(s1[i], s0[i]));
    mx = fmaxf(mx, __shfl_xor(mx, 32));
    if (__any(mx > m)) {
      const float mn = fmaxf(m, mx);
      const float al = ex2(m - mn);
      m = mn; lsum *= al;
#pragma unroll
      for (int i = 0; i < 16; ++i) { O[0][i] *= al; O[1][i] *= al; }
    }
    float rs1 = 0.f, rs0 = 0.f;
#pragma unroll
    for (int i = 0; i < 16; ++i) { p1[i] = ex2(s1[i] - m); rs1 += p1[i]; p0[i] = ex2(s0[i] - m); rs0 += p0[i]; }
    lsum += rs1 + rs0;
  }
  __builtin_amdgcn_sched_barrier(0);
  u32x4 vf0[2][2];
#pragma unroll
  for (int s2 = 0; s2 < 2; ++s2)
#pragma unroll
    for (int mt = 0; mt < 2; ++mt) {
      const u16* vp = Vs + (32 * mt + r) * VST + 16 * s2 + 4 * h;
      const uint2 v0 = *(const uint2*)vp, v1 = *(const uint2*)(vp + 8);
      vf0[s2][mt][0] = v0.x; vf0[s2][mt][1] = v0.y; vf0[s2][mt][2] = v1.x; vf0[s2][mt][3] = v1.y;
    }
#pragma unroll
  for (int s2 = 0; s2 < 2; ++s2) {
    u32x4 pp;
#pragma unroll
    for (int j = 0; j < 4; ++j) pp[j] = pk2(p1[8 * s2 + 2 * j], p1[8 * s2 + 2 * j + 1]);
    const bf16x8 pf = __builtin_bit_cast(bf16x8, pp);
    O[0] = MFMA(__builtin_bit_cast(bf16x8, vf1[s2][0]), pf, O[0]);
    O[1] = MFMA(__builtin_bit_cast(bf16x8, vf1[s2][1]), pf, O[1]);
  }
#pragma unroll
  for (int s2 = 0; s2 < 2; ++s2) {
    u32x4 pp;
#pragma unroll
    for (int j = 0; j < 4; ++j) pp[j] = pk2(p0[8 * s2 + 2 * j], p0[8 * s2 + 2 * j + 1]);
    const bf16x8 pf = __builtin_bit_cast(bf16x8, pp);
    O[0] = MFMA(__builtin_bit_cast(bf16x8, vf0[s2][0]), pf, O[0]);
    O[1] = MFMA(__builtin_bit_cast(bf16x8, vf0[s2][1]), pf, O[1]);
  }
}

template <int MODE>
__device__ void attn_item(const Params& p, int l, int bh, int qb, unsigned char* smem) {
  const int tid = otid(), lane = tid & 63, w = tid >> 6, r = lane & 31, h = lane >> 5;
  const int b = bh >> 2, hh = bh & 3;
  const int qcol = MODE == 0 ? AQ : MODE == 1 ? CQ : DQ, kcol = MODE == 0 ? AK : MODE == 1 ? CK : DK, gcol = MODE == 0 ? AG : MODE == 1 ? CG : DG;
  const int br = MODE == 0 ? 0 : MODE == 1 ? 2 : 3;
  const int q0 = qb * 256, qs0 = q0 + 32 * w, t = qs0 + r;
  const size_t tok = (size_t)b * SEQ + t;
  const int hi = 4 * qb + 3, lo = (MODE == 0) ? max(0, 4 * qb - 8) : 0;
  float* tab = (float*)(smem + ATT_TAB_OFF);

  bf16x8 qf[4];
#pragma unroll
  for (int ks = 0; ks < 4; ++ks) qf[ks] = *(const bf16x8*)(p.P + tok * PC + qcol + hh * 64 + 16 * ks + 8 * h);
  bf16x8 qx;
#pragma unroll
  for (int j = 0; j < 8; ++j) qx[j] = (h == 0 && j < 3) ? (short)0x3F80 : (short)0;
  f16x8 uf[2];
#pragma unroll
  for (int s2 = 0; s2 < 2; ++s2)
#pragma unroll
    for (int j = 0; j < 8; ++j) uf[s2][j] = ((16 * s2 + 8 * (j >> 2) + 4 * h + (j & 3)) >= r) ? (_Float16)1.f : (_Float16)0.f;
  float* coff = (float*)(smem + ATT_TAB_OFF + 1040);
  float cref = 0.f;
  float qk_bound = 0.f, cbn = 0.f, cbc = 0.f;
  if (MODE == 1) {
    float n2 = 0.f;
#pragma unroll
    for (int ks = 0; ks < 4; ++ks)
#pragma unroll
      for (int j = 0; j < 8; ++j) { const float v = bf2f((u16)qf[ks][j]); n2 += v * v; }
    n2 += __shfl_xor(n2, 32);
    const float k2 = __uint_as_float(__hip_atomic_load(p.ctr + 48 + l * 8 + bh, __ATOMIC_RELAXED, __HIP_MEMORY_SCOPE_AGENT));
    qk_bound = sqrtf(n2) * sqrtf(k2) * 1.02f + 1e-3f;
  }

  const int lrow = tid >> 3, lch = tid & 7;
  const u16* kbase = p.P + ((size_t)b * SEQ + lrow) * PC + kcol + hh * 64 + lch * 8;
  const u16* vbase = p.Vt + ((size_t)(br * 2 + b) * 256 + hh * 64 + lrow) * VTLD + lch * 8;
  constexpr int STG2 = 2 * STAGE_BYTES;
  float* tab2 = (float*)(smem + 2 * STG2);
  float* coff2 = tab2 + 260;
  const int csub = (tid >> 6) & 1, ckey = tid & 63;
  uint4 kr0, kr1, vr0, vr1; float cval = 0.f, coffv = 0.f;
#define ATT_LOAD(KT_) do { const int k0_ = (KT_) * 64; \
    kr0 = *(const uint4*)(kbase + (size_t)k0_ * PC); kr1 = *(const uint4*)(kbase + (size_t)(k0_ - 64) * PC); \
    vr0 = *(const uint4*)(vbase + k0_); vr1 = *(const uint4*)(vbase + k0_ - 64); \
    if (MODE == 1) { cbn = p.csum[((size_t)b * SEQ + k0_ - 64) * 4 + hh] + coff2[(k0_ - 64) >> 10]; } \
    if (MODE == 1 && tid < 128) { const int kk_ = k0_ - 64 * csub; cval = p.csum[((size_t)b * SEQ + kk_ + ckey) * 4 + hh]; coffv = coff2[kk_ >> 10]; } } while (0)
#define ATT_STORE(STG_) do { u16* Kt_ = (u16*)(smem + (STG_) * STG2); u16* Vs_ = Kt_ + 64 * KST; \
    u16* Kt1_ = (u16*)(smem + (STG_) * STG2 + STAGE_BYTES); u16* Vs1_ = Kt1_ + 64 * KST; \
    *(uint4*)(Kt_ + lrow * KST + lch * 8) = kr0; *(uint4*)(Kt1_ + lrow * KST + lch * 8) = kr1; \
    *(uint2*)(Vs_ + lrow * VST + lch * 8) = make_uint2(vr0.x, vr0.y); *(uint2*)(Vs_ + lrow * VST + lch * 8 + 4) = make_uint2(vr0.z, vr0.w); \
    *(uint2*)(Vs1_ + lrow * VST + lch * 8) = make_uint2(vr1.x, vr1.y); *(uint2*)(Vs1_ + lrow * VST + lch * 8 + 4) = make_uint2(vr1.z, vr1.w); \
    if (MODE == 1 && tid < 128) { const float val_ = cref - (cval + coffv); const u16 c1_ = f2bf(val_); const float r1_ = val_ - bf2f(c1_); \
      const u16 c2_ = f2bf(r1_); const u16 c3_ = f2bf(r1_ - bf2f(c2_)); \
      uint4 e0_; e0_.x = (unsigned)c1_ | ((unsigned)c2_ << 16); e0_.y = (unsigned)c3_; e0_.z = 0u; e0_.w = 0u; \
      u16* ke_ = (csub ? Kt1_ : Kt_) + ckey * KST + 64; \
      *(uint4*)ke_ = e0_; *(uint4*)(ke_ + 8) = make_uint4(0u, 0u, 0u, 0u); } } while (0)

  __syncthreads();
  if (MODE == 0) { for (int i = tid; i < 257; i += NTHR) tab2[i] = p.rel_bias[(size_t)(l * 4 + hh) * 257 + i] * LOG2E; }
  if (MODE == 1) {
    if (tid < 16) { float a = 0.f; for (int c = 0; c < tid; ++c) a += p.ctot[(b * 16 + c) * 4 + hh]; coff2[tid] = a; }
    __syncthreads();
    cref = p.csum[((size_t)b * SEQ + q0) * 4 + hh] + coff2[q0 >> 10];
  }
  ATT_LOAD(hi);
  ATT_STORE(0);
  cbc = cbn;
  ATT_LOAD(max(hi - 2, lo + 1));
  __syncthreads();

  f32x16 O[2];
#pragma unroll
  for (int i = 0; i < 16; ++i) { O[0][i] = 0.f; O[1][i] = 0.f; }
  float m = -1e30f, lsum = 0.f, carry = 0.f;
  int stage = 0;
  bool wdone = false;
  const int cw = qs0 >> 6;
#pragma unroll 1
  for (int kp = hi; kp > lo; kp -= 2) {
    const float cb_next = cbn;
    ATT_STORE(stage ^ 1);
    __builtin_amdgcn_sched_barrier(0);
    ATT_LOAD(max(kp - 4, lo + 1));
    __builtin_amdgcn_sched_barrier(0);
    if (!(MODE == 2 && wdone)) {
#pragma unroll
    for (int sub = 0; sub < 2; ++sub) {
      const int kt = kp - sub;
      const u16* Kt = (const u16*)(smem + stage * STG2 + sub * STAGE_BYTES);
      const u16* Vs = Kt + 64 * KST;
      const int k0 = kt * 64;
      if (MODE == 0) {
        if (kt <= cw && kt >= cw - 8) attn_tile2<0>(Kt, Vs, (qs0 - k0 - 63 >= 128), r, h, qf, qx, uf, tab2, t - k0, O, m, lsum, carry);
      } else {
        if (k0 + 32 <= qs0) attn_tile2<MODE>(Kt, Vs, (k0 + 32 == qs0), r, h, qf, qx, uf, tab2, 0, O, m, lsum, carry);
        else if (k0 <= qs0) attn_subtile<MODE>(Kt, Vs, 0, (k0 == qs0), r, h, qf, qx, uf, tab2, 0, O, m, lsum, carry);
      }
    }
    }
    if (MODE == 2) {
      wdone = __all(carry > 160.f) != 0;
      if (__syncthreads_and(wdone ? 1 : 0)) break;
    } else if (MODE == 1) {
      const bool z = (m > -1e29f) && (qk_bound + (cref - cbc) - m < -165.f);
      if (__syncthreads_and(__all(z) ? 1 : 0)) break;
      cbc = cb_next;
    } else {
      __syncthreads();
    }
    stage ^= 1;
  }
#undef ATT_LOAD
#undef ATT_STORE
  if (MODE != 2) {
    const float lt = lsum + __shfl_xor(lsum, 32);
    const float inv = 1.f / lt;
#pragma unroll
    for (int i = 0; i < 16; ++i) { O[0][i] *= inv; O[1][i] *= inv; }
  }
  float ss = 0.f;
#pragma unroll
  for (int i = 0; i < 16; ++i) ss += O[0][i] * O[0][i] + O[1][i] * O[1][i];
  ss += __shfl_xor(ss, 32);
  if (h == 0) p.ssq[tok * 16 + br * 4 + hh] = ss;
  uint4 gw4[2][2];
#pragma unroll
  for (int mt = 0; mt < 2; ++mt)
#pragma unroll
    for (int gp = 0; gp < 2; ++gp) gw4[mt][gp] = *(const uint4*)(p.P + tok * PC + gcol + hh * 64 + 32 * mt + 8 * (2 * gp + h));
#pragma unroll
  for (int mt = 0; mt < 2; ++mt)
#pragma unroll
    for (int gp = 0; gp < 2; ++gp) {
      const u32x2w gx = __builtin_amdgcn_permlane32_swap(gw4[mt][gp].x, gw4[mt][gp].z, false, false);
      const u32x2w gy = __builtin_amdgcn_permlane32_swap(gw4[mt][gp].y, gw4[mt][gp].w, false, false);
      const int ie = 8 * gp, io = 8 * gp + 4;
      uint2 ze, zo;
      ze.x = pk2(O[mt][ie] * bflo(gx[0]), O[mt][ie + 1] * bfhi(gx[0])); ze.y = pk2(O[mt][ie + 2] * bflo(gy[0]), O[mt][ie + 3] * bfhi(gy[0]));
      zo.x = pk2(O[mt][io] * bflo(gx[1]), O[mt][io + 1] * bfhi(gx[1])); zo.y = pk2(O[mt][io + 2] * bflo(gy[1]), O[mt][io + 3] * bfhi(gy[1]));
      *(uint4*)(p.Z + ((size_t)(br * 4 + hh) * TT + tok) * 64 + 32 * mt + 8 * (2 * gp + h)) = widen_pair(ze, zo);
    }
}

__device__ void naive_gmlp_item(const Params& p, int l, int item, unsigned char* smem) {
  float (*vn)[64] = (float (*)[64])smem;
  float* mu = (float*)(smem + 32768);
  float* rstd = mu + 128;
  float* red = rstd + 128;
  const int tid = otid(), b = item >> 7, ch = item & 127, s0 = ch * 128;
  const u16* vt = p.Vt + (size_t)(1 * 2 + b) * 256 * SEQ;
  {
    const int tkn = tid & 127, half = tid >> 7;
    float s1 = 0.f, s2 = 0.f;
    for (int cc = 0; cc < 128; ++cc) { float v = bf2f(vt[(size_t)(half * 128 + cc) * SEQ + s0 + tkn]); s1 += v; s2 += v * v; }
    __syncthreads();
    red[tid] = s1; red[256 + tid] = s2;
    __syncthreads();
    if (tid < 128) {
      float a1 = red[tid] + red[tid + 128], a2 = red[256 + tid] + red[256 + tid + 128];
      float mean = a1 * (1.f / 256.f);
      float var = a2 * (1.f / 256.f) - mean * mean;
      mu[tid] = mean; rstd[tid] = rsqrtf(fmaxf(var, 0.f) + EPS);
    }
    __syncthreads();
  }
  const int tkn = tid >> 1, c0 = (tid & 1) * 32;
  const size_t tok = (size_t)b * SEQ + s0 + tkn;
  for (int g = 0; g < 4; ++g) {
    __syncthreads();
    for (int i = 0; i < 32; ++i) {
      const int idx = tid + 256 * i, cc = idx >> 7, s = idx & 127;
      float v = bf2f(vt[(size_t)(g * 64 + cc) * SEQ + s0 + s]);
      vn[s][cc] = (v - mu[s]) * rstd[s] * p.v_gain[l * 256 + g * 64 + cc];
    }
    __syncthreads();
    float acc[32];
#pragma unroll
    for (int i = 0; i < 32; ++i) acc[i] = 0.f;
    const float* wrow = p.w_s + ((size_t)(l * 4 + g) * 128 + tkn) * 128;
    for (int s = 0; s <= tkn; ++s) {
      const float wv = wrow[s];
#pragma unroll
      for (int i = 0; i < 32; ++i) acc[i] += wv * vn[s][c0 + i];
    }
    const float bs = p.b_s[(size_t)(l * 4 + g) * 128 + tkn];
    float ss = 0.f;
#pragma unroll
    for (int i8 = 0; i8 < 4; ++i8) {
      uint4 uu = *(const uint4*)(p.P + tok * PC + BU + g * 64 + c0 + i8 * 8);
      uint4 gg = *(const uint4*)(p.P + tok * PC + BG + g * 64 + c0 + i8 * 8);
      float y[8];
      y[0] = bflo(uu.x) * (acc[i8 * 8 + 0] + bs); y[1] = bfhi(uu.x) * (acc[i8 * 8 + 1] + bs);
      y[2] = bflo(uu.y) * (acc[i8 * 8 + 2] + bs); y[3] = bfhi(uu.y) * (acc[i8 * 8 + 3] + bs);
      y[4] = bflo(uu.z) * (acc[i8 * 8 + 4] + bs); y[5] = bfhi(uu.z) * (acc[i8 * 8 + 5] + bs);
      y[6] = bflo(uu.w) * (acc[i8 * 8 + 6] + bs); y[7] = bfhi(uu.w) * (acc[i8 * 8 + 7] + bs);
#pragma unroll
      for (int e = 0; e < 8; ++e) ss += y[e] * y[e];
      uint4 z;
      z.x = pk2(y[0] * bflo(gg.x), y[1] * bfhi(gg.x)); z.y = pk2(y[2] * bflo(gg.y), y[3] * bfhi(gg.y));
      z.z = pk2(y[4] * bflo(gg.z), y[5] * bfhi(gg.z)); z.w = pk2(y[6] * bflo(gg.w), y[7] * bfhi(gg.w));
      *(uint4*)(p.Z + tok * 1024 + 256 + g * 64 + c0 + i8 * 8) = z;
    }
    ss += __shfl_xor(ss, 1);
    if ((tid & 1) == 0) p.ssq[tok * 16 + 4 + g] = ss;
  }
}


__device__ void gmlp_item(const Params& p, int l, int item2, unsigned char* smem0) {
  constexpr int GST = 136;
  const int tid512 = otid(), wg = tid512 >> 8;
  const int item = item2 * 2 + wg;
  unsigned char* smem = smem0 + wg * 24576;
  u16* vt = (u16*)smem;
  float* mu = (float*)(smem + 64 * GST * 2);
  float* rstd = mu + 128;
  float* red = rstd + 128;
  const int tid = tid512 & 255, lane = tid & 63, w = tid >> 6, r = lane & 31, h = lane >> 5;
  const int b = item >> 7, ch = item & 127, s0 = ch * 128;
  const u16* gv = p.Vt + (size_t)(1 * 2 + b) * 256 * VTLD + s0;
  const int lr = tid >> 4, lc = tid & 15;
  const int tk = tid & 127, half = tid >> 7;
  float s1 = 0.f, s2 = 0.f;
#pragma unroll 1
  for (int g = 0; g < 4; ++g) {
    __syncthreads();
    {
      uint4 tmp[4];
#pragma unroll
      for (int j = 0; j < 4; ++j) tmp[j] = *(const uint4*)(gv + (size_t)(g * 64 + lr + 16 * j) * VTLD + lc * 8);
#pragma unroll
      for (int j = 0; j < 4; ++j) *(uint4*)(vt + (lr + 16 * j) * GST + lc * 8) = tmp[j];
    }
    __syncthreads();
#pragma unroll 8
    for (int cc = 0; cc < 32; ++cc) { const float v = bf2f(vt[(half * 32 + cc) * GST + tk]); s1 += v; s2 += v * v; }
  }
  red[tid] = s1; red[256 + tid] = s2;
  __syncthreads();
  if (tid < 128) {
    const float a1 = red[tid] + red[tid + 128], a2 = red[256 + tid] + red[256 + tid + 128];
    const float mean = a1 * (1.f / 256.f);
    const float var = a2 * (1.f / 256.f) - mean * mean;
    mu[tid] = mean; rstd[tid] = rsqrtf(fmaxf(var, 0.f) + EPS);
  }
  __syncthreads();
  const float mm = mu[tk], rs = rstd[tk];
  const int t = 32 * w + r;
  const size_t tok = (size_t)b * SEQ + s0 + t;
  const int nks = 2 * (w + 1);
#pragma unroll 1
  for (int g = 0; g < 4; ++g) {
    __syncthreads();
    bf16x8 bw[8];
    {
      const u16* wrow = p.Ws16 + ((size_t)(l * 4 + g) * 128 + t) * 128 + 8 * h;
      uint4 tmp[4];
#pragma unroll
      for (int j = 0; j < 4; ++j) tmp[j] = *(const uint4*)(gv + (size_t)(g * 64 + lr + 16 * j) * VTLD + lc * 8);
#pragma unroll
      for (int ks = 0; ks < 8; ++ks) bw[ks] = *(const bf16x8*)(wrow + 16 * ks);
#pragma unroll
      for (int j = 0; j < 4; ++j) *(uint4*)(vt + (lr + 16 * j) * GST + lc * 8) = tmp[j];
    }
    __syncthreads();
    {
      const float* vg = p.v_gain + l * 256 + g * 64 + half * 32;
#pragma unroll 8
      for (int cc = 0; cc < 32; ++cc) {
        u16* q = vt + (half * 32 + cc) * GST + tk;
        *q = f2bf((bf2f(*q) - mm) * rs * vg[cc]);
      }
    }
    __syncthreads();
    f32x16 acc0, acc1;
#pragma unroll
    for (int i = 0; i < 16; ++i) { acc0[i] = 0.f; acc1[i] = 0.f; }
    uint4 uq4[2][2], gq4[2][2];
#pragma unroll
    for (int mt = 0; mt < 2; ++mt)
#pragma unroll
      for (int gp = 0; gp < 2; ++gp) {
        const int c8 = g * 64 + 32 * mt + 8 * (2 * gp + h);
        uq4[mt][gp] = *(const uint4*)(p.P + tok * PC + BU + c8);
        gq4[mt][gp] = *(const uint4*)(p.P + tok * PC + BG + c8);
      }
    const u16* a0p = vt + r * GST + 8 * h;
    const u16* a1p = a0p + 32 * GST;
#pragma unroll
    for (int ks = 0; ks < 8; ++ks) {
      const bf16x8 a0 = *(const bf16x8*)(a0p + 16 * ks), a1 = *(const bf16x8*)(a1p + 16 * ks);
      acc0 = MFMA(a0, bw[ks], acc0);
      acc1 = MFMA(a1, bw[ks], acc1);
    }
    const float bs = p.b_s[(size_t)(l * 4 + g) * 128 + t];
    float ss = 0.f;
#pragma unroll
    for (int mt = 0; mt < 2; ++mt)
#pragma unroll
      for (int gp = 0; gp < 2; ++gp) {
        const u32x2w ux = __builtin_amdgcn_permlane32_swap(uq4[mt][gp].x, uq4[mt][gp].z, false, false);
        const u32x2w uy = __builtin_amdgcn_permlane32_swap(uq4[mt][gp].y, uq4[mt][gp].w, false, false);
        const u32x2w gx = __builtin_amdgcn_permlane32_swap(gq4[mt][gp].x, gq4[mt][gp].z, false, false);
        const u32x2w gy = __builtin_amdgcn_permlane32_swap(gq4[mt][gp].y, gq4[mt][gp].w, false, false);
        uint2 zz[2];
#pragma unroll
        for (int eo = 0; eo < 2; ++eo) {
          const int i0 = 8 * gp + 4 * eo;
          float y[4];
          y[0] = bflo(ux[eo]) * ((mt ? acc1[i0] : acc0[i0]) + bs);
          y[1] = bfhi(ux[eo]) * ((mt ? acc1[i0 + 1] : acc0[i0 + 1]) + bs);
          y[2] = bflo(uy[eo]) * ((mt ? acc1[i0 + 2] : acc0[i0 + 2]) + bs);
          y[3] = bfhi(uy[eo]) * ((mt ? acc1[i0 + 3] : acc0[i0 + 3]) + bs);
          ss += y[0] * y[0] + y[1] * y[1] + y[2] * y[2] + y[3] * y[3];
          zz[eo].x = pk2(y[0] * bflo(gx[eo]), y[1] * bfhi(gx[eo]));
          zz[eo].y = pk2(y[2] * bflo(gy[eo]), y[3] * bfhi(gy[eo]));
        }
        *(uint4*)(p.Z + ((size_t)(4 + g) * TT + tok) * 64 + 32 * mt + 8 * (2 * gp + h)) = widen_pair(zz[0], zz[1]);
      }
    ss += __shfl_xor(ss, 32);
    if (h == 0) p.ssq[tok * 16 + 4 + g] = ss;
  }
}

#ifndef NAIVE_A
#define NAIVE_A 0
#endif
#ifndef NAIVE_C
#define NAIVE_C 0
#endif
#ifndef NAIVE_D
#define NAIVE_D 0
#endif
__device__ void phase_mix(const Params& p, int l, unsigned char* smem, int ctr_off, int only = -1) {
  __shared__ int s_item;
  unsigned* ctr = p.ctr + (ctr_off + l) * 8;
  constexpr int NITEMS = 512 + 512 + 512 + 128;
  (void)only;
  for (;;) {
    if (threadIdx.x == 0) s_item = (int)atomicAdd(ctr, 1u);
    __syncthreads();
    const int item = s_item;
    __syncthreads();
    if (item >= NITEMS) break;
    if (item < 128) {
      gmlp_item(p, l, item, smem);
    } else if (item < 640) {
      const int j = item - 128;
      attn_item<1>(p, l, j & 7, 63 - (j >> 3), smem);
    } else if (item < 1152) {
      const int j = item - 640;
      attn_item<0>(p, l, j & 7, j >> 3, smem);
    } else {
      const int j = item - 1152;
      attn_item<2>(p, l, j & 7, 63 - (j >> 3), smem);
    }
  }
}

DI void run_phase(const Params& p, int ph, unsigned char* smem) {
  if (ph == 0) { phase_pre(p, smem); return; }
  if (ph == 9) { phase_final(p); return; }
  const int l = (ph - 1) >> 2, s = (ph - 1) & 3;
  if (s == 0) phase_norm(p, l);
  else if (s == 1) phase_gemm_in(p, l, smem);
  else if (s == 2) phase_mix(p, l, smem, 0);
  else phase_gemm_out(p, l, smem);
}

#if !COOP
template <int KIND>
__global__ void __launch_bounds__(256, (KIND == 3) ? 1 : 2) mk_phase(Params p, int l) {
  __shared__ __attribute__((aligned(16))) unsigned char smem[SMEM_BYTES];
  if (KIND == 0) phase_pre(p, smem);
  else if (KIND == 1) phase_norm(p, l);
  else if (KIND == 2) phase_gemm_in(p, l, smem);
  else if (KIND == 3) phase_mix(p, l, smem, 0);
  else if (KIND == 4) phase_gemm_out(p, l, smem);
  else phase_final(p);
}
#endif

#if COOP

#define XB_TMO      128
#define XB_XCNT(j)  (256  + 64 * (j))
#define XB_XSUB(j)  (1280 + 64 * (j))
#define XB_XGEN(j)  (2304 + 64 * (j))
#define XB_TOP      3328
#define XB_TOPGEN   3392
#define XCD_BAR_WORDS 3456
#define XB_SPIN_CAP (1u << 18)
#define LAS __attribute__((address_space(3)))
DI unsigned xb_ld(unsigned* p) { return __hip_atomic_load(p, __ATOMIC_RELAXED, __HIP_MEMORY_SCOPE_AGENT); }
DI unsigned xb_add(unsigned* p, unsigned v) { return __hip_atomic_fetch_add(p, v, __ATOMIC_RELAXED, __HIP_MEMORY_SCOPE_AGENT); }
DI unsigned xb_xcc_id() { return (unsigned)__builtin_amdgcn_s_getreg((3 << 11) | 20) & 0xFu; }
#define XB_SPIN(cond, bar) do { unsigned _sp = 0; while (cond) { __builtin_amdgcn_s_sleep(1); \
    if ((++_sp & 255u) == 0u) { if (xb_ld(&(bar)[XB_TMO])) break; if (_sp > XB_SPIN_CAP) { atomicAdd(&(bar)[XB_TMO], 1u); break; } } } } while (0)
struct XcdBarrier { unsigned* bar; unsigned x; volatile LAS unsigned* st; };
DI XcdBarrier xcd_barrier_post(unsigned* bar, volatile LAS unsigned* st) {
  XcdBarrier b; b.bar = bar; b.x = xb_xcc_id(); b.st = st;
  if (threadIdx.x == 0) (void)xb_add(&bar[XB_XCNT(b.x)], 1u);
  return b;
}
DI void xcd_barrier_complete(unsigned* bar, unsigned x, unsigned& nloc, unsigned& nx) {
  const unsigned G = gridDim.x * gridDim.y * gridDim.z;
  unsigned sum, cnt, mine, sp = 0u;
  for (;;) {
    sum = 0u; cnt = 0u; mine = 0u;
#pragma unroll
    for (unsigned j = 0; j < 16; ++j) { const unsigned c = xb_ld(&bar[XB_XCNT(j)]); sum += c; cnt += (c > 0u) ? 1u : 0u; mine = (j == x) ? c : mine; }
    if (sum == G) break;
    __builtin_amdgcn_s_sleep(1);
    if ((++sp & 255u) == 0u) { if (xb_ld(&bar[XB_TMO])) break; if (sp > XB_SPIN_CAP) { atomicAdd(&bar[XB_TMO], 1u); break; } }
  }
  nloc = mine > 0u ? mine : 1u; nx = cnt > 0u ? cnt : 1u;
}
DI void xcd_barrier(const XcdBarrier& b) {
  asm volatile("s_waitcnt vmcnt(0)" ::: "memory");
  __syncthreads();
  if (threadIdx.x == 0) {
    unsigned* bar = b.bar;
    __builtin_amdgcn_s_waitcnt(0);
    unsigned nloc = b.st[0], nx = b.st[1];
    if (nloc == 0u) { xcd_barrier_complete(bar, b.x, nloc, nx); b.st[0] = nloc; b.st[1] = nx; }
    const unsigned old = xb_add(&bar[XB_XSUB(b.x)], 1u);
    const unsigned gen = old / nloc;
    if (old + 1u == (gen + 1u) * nloc) {
      __builtin_amdgcn_fence(__ATOMIC_RELEASE, "agent");
      asm volatile("s_waitcnt vmcnt(0)" ::: "memory");
      const unsigned og = xb_add(&bar[XB_TOP], 1u);
      const unsigned tg = og / nx;
      if (og + 1u == (tg + 1u) * nx) xb_add(&bar[XB_TOPGEN], 1u);
      else XB_SPIN(xb_ld(&bar[XB_TOPGEN]) == tg, bar);
      __builtin_amdgcn_fence(__ATOMIC_ACQUIRE, "agent");
      xb_add(&bar[XB_XGEN(b.x)], 1u);
      asm volatile("s_waitcnt vmcnt(0)" ::: "memory");
    } else {
      XB_SPIN(xb_ld(&bar[XB_XGEN(b.x)]) == gen, bar);
      __builtin_amdgcn_fence(__ATOMIC_ACQUIRE, "agent");
      asm volatile("s_waitcnt vmcnt(0)" ::: "memory");
    }
  }
  __syncthreads();
}

__global__ void __launch_bounds__(512, COOP_MINB) mk_coop(Params p) {
  __shared__ __attribute__((aligned(16))) unsigned char smem[SMEM_BYTES];
  __shared__ __attribute__((aligned(16))) unsigned xb_words[4];
  cg::grid_group grid = cg::this_grid();
  if (threadIdx.x < 4) xb_words[threadIdx.x] = 0u;
  __syncthreads();
  const XcdBarrier xb = xcd_barrier_post(p.bar, (volatile LAS unsigned*)xb_words);
  phase_pre(p, smem);
  grid.sync();
#pragma unroll 1
  for (int l = 0; l < 2; ++l) {
    phase_norm(p, l);
    xcd_barrier(xb);
#if PROBE_DUP == 3
    phase_norm(p, l);
    xcd_barrier(xb);
#endif
    phase_gemm_in(p, l, smem);
    xcd_barrier(xb);
#if PROBE_DUP == 1
    phase_gemm_in(p, l, smem);
    xcd_barrier(xb);
#endif
    phase_mix(p, l, smem, 0);
    xcd_barrier(xb);
#if PROBE_DUP == 2
    phase_mix(p, l, smem, 2, PROBE_ONLY);
    xcd_barrier(xb);
#endif
#if PROBE_DUP == 4
    if (l == 0) { phase_gemm_out(p, l, smem); xcd_barrier(xb); }
#endif
    phase_gemm_out(p, l, smem);
    xcd_barrier(xb);
  }
#if PROBE_DUP == 5
  for (int i = 0; i < 10; ++i) xcd_barrier(xb);
#endif
  phase_final(p);
}
#endif

extern "C" void kernel_launch(void* const* d_in, const int* in_sizes, int n_in, void* d_out, int out_size, void* d_ws,
                              size_t ws_size, hipStream_t stream) {
  Params p{};
  p.x = (const float*)d_in[0]; p.norm_g = (const float*)d_in[1]; p.w_in = (const float*)d_in[2]; p.b_f = (const float*)d_in[3];
  p.rel_bias = (const float*)d_in[4]; p.w_s = (const float*)d_in[5]; p.b_s = (const float*)d_in[6]; p.v_gain = (const float*)d_in[7];
  p.branch_gain = (const float*)d_in[8]; p.w_out = (const float*)d_in[9]; p.final_g = (const float*)d_in[10];
  p.out = (float*)d_out;
  unsigned char* ws = (unsigned char*)d_ws;
  size_t off = 0;
  auto carve = [&](size_t bytes) { unsigned char* q = ws + off; off += (bytes + 255) & ~(size_t)255; return q; };
  p.WtIn = (u16*)carve((size_t)2 * NW * 1024 * 2);
  p.WtOut = (u16*)carve((size_t)2 * 1024 * 1024 * 2);
  p.Ws16 = (u16*)carve((size_t)2 * 4 * 128 * 128 * 2);
  p.H = (u16*)carve((size_t)TT * 1024 * 2);
  p.P = (u16*)carve((size_t)TT * PC * 2);
  p.Vt = (u16*)carve((size_t)4 * 2 * 256 * VTLD * 2);
  p.Z = (u16*)carve((size_t)TT * 1024 * 2);
  p.lsf = (float*)carve((size_t)TT * 4 * 4);
  p.csum = (float*)carve((size_t)TT * 4 * 4);
  p.ssq = (float*)carve((size_t)TT * 16 * 4);
  p.ctot = (float*)carve(32 * 4 * 4);
  p.Wf = (float*)carve(2 * 1024 * 4 * 4);
  p.ctr = (unsigned*)carve(256);
  p.bar = (unsigned*)carve(XCD_BAR_WORDS * 4);
  static int grid_blocks = 0;
  if (!grid_blocks) {
    int dev = 0, cus = 0, per_cu = 0;
    hipGetDevice(&dev);
    hipDeviceGetAttribute(&cus, hipDeviceAttributeMultiprocessorCount, dev);
#if COOP
    hipOccupancyMaxActiveBlocksPerMultiprocessor(&per_cu, mk_coop, 256, 0);
#else
    hipOccupancyMaxActiveBlocksPerMultiprocessor(&per_cu, mk_phase<3>, 256, 0);
#endif
    (void)per_cu;
    grid_blocks = cus;
  }
#if COOP
  hipMemsetAsync(p.bar, 0, XCD_BAR_WORDS * 4, stream);
  void* args[] = {&p};
  hipError_t e = hipLaunchCooperativeKernel((void*)mk_coop, dim3(grid_blocks), dim3(512), args, 0, stream);
  if (e != hipSuccess) fprintf(stderr, "cooperative launch failed: %s (grid %d)\n", hipGetErrorString(e), grid_blocks);
#else
  mk_phase<0><<<grid_blocks, 256, 0, stream>>>(p, 0);
  for (int l = 0; l < 2; ++l) {
    mk_phase<1><<<grid_blocks, 256, 0, stream>>>(p, l);
    mk_phase<2><<<grid_blocks, 256, 0, stream>>>(p, l);
    mk_phase<3><<<grid_blocks, 256, 0, stream>>>(p, l);
    mk_phase<4><<<grid_blocks, 256, 0, stream>>>(p, l);
  }
  mk_phase<5><<<grid_blocks, 256, 0, stream>>>(p, 0);
#endif
}
```
